# Optimizing an MI355X kernel written in HIP

```python
import math
import jax, jax.numpy as jnp
from jax import lax
import numpy as np

D_MODEL = 2048
BATCH = 1
SEQ = 16384
DEPTH = 4
DEC_BATCH = 2
DEC_SEQ = 4096
PAST_LEN = 128

A_HEADS = 16
A_KV_HEADS = 2
A_HEAD_DIM = 64
A_WIDTH = A_HEADS * A_HEAD_DIM
A_KV_WIDTH = A_KV_HEADS * A_HEAD_DIM
A_RADIUS = 128
B_CH = D_MODEL - A_WIDTH
B_ORDER = 2
B_SHORT = 3
B_EMB = 33
B_BANDS = (B_EMB - 1) // 2
B_FILTER_HIDDEN = 64
B_DECAY_TARGET = 1e-2
B_FAST_DECAY_PCT = 0.3
B_SLOW_DECAY_PCT = 1.5
B_N_DIR = 2
C_HEADS = 16
C_HEAD_DIM = D_MODEL // C_HEADS
C_PATTERNS = ((128, 1), (512, 4), (2048, 16))
C_GROUPS = len(C_PATTERNS)
E_PROJ = A_WIDTH + 2 * A_KV_WIDTH + 3 * B_CH
O_PROJ = 3 * C_GROUPS * C_HEADS * C_HEAD_DIM
D_FF = -(-8 * D_MODEL // 768) * 256
ROPE_THETA = 500000.0
ROPE_FRACTION = 4
ALPHA = (2 * DEPTH) ** 0.25
BETA = (8 * DEPTH) ** -0.25
LN_EPS = 1e-5
BLOCK = 128
N_EVEN = (DEPTH + 1) // 2
N_ODD = DEPTH // 2

kernel_name = "hybrid_bidir_swa_hyena_dilated_encoder"


def layer_norm(x, g, b):
    xf = x.astype(jnp.float32)
    mu = xf.mean(-1, keepdims=True)
    var = jnp.square(xf - mu).mean(-1, keepdims=True)
    y = (xf - mu) * lax.rsqrt(var + LN_EPS) * g.astype(jnp.float32) + b.astype(jnp.float32)
    return y.astype(x.dtype)


def partial_rope(x):
    L, hd = x.shape[1], x.shape[-1]
    rot = hd // ROPE_FRACTION
    half = rot // 2
    inv = ROPE_THETA ** (-(jnp.arange(half, dtype=jnp.float32) * 2.0 / rot))
    ang = jnp.arange(L, dtype=jnp.float32)[:, None] * inv[None, :]
    cos = jnp.cos(ang)[None, :, None, :]
    sin = jnp.sin(ang)[None, :, None, :]
    xf = x.astype(jnp.float32)
    x1, x2, xp = xf[..., :half], xf[..., half:rot], xf[..., rot:]
    out = jnp.concatenate([x1 * cos - x2 * sin, x2 * cos + x1 * sin, xp], axis=-1)
    return out.astype(x.dtype)


def banded_attention(q, k, v, radius, sink=None):
    n, L, hq, hd = q.shape
    hkv = k.shape[2]
    g = hq // hkv
    qb = math.gcd(L, BLOCK)
    nb = L // qb
    span = qb + 2 * radius
    pad = ((0, 0), (radius, radius), (0, 0), (0, 0))
    kp = jnp.pad(k, pad)
    vp = jnp.pad(v, pad)
    idx = jnp.arange(nb)[:, None] * qb + jnp.arange(span)[None, :]
    kb = kp[:, idx]
    vb = vp[:, idx]
    qr = q.reshape(n, nb, qb, hkv, g, hd)
    s = jnp.einsum('nbqhgd,nbkhd->nbhgqk', qr, kb, preferred_element_type=jnp.float32) * (hd ** -0.5)
    qpos = jnp.arange(nb)[:, None] * qb + jnp.arange(qb)[None, :]
    kpos = idx - radius
    rel = kpos[:, None, :] - qpos[:, :, None]
    valid = (jnp.abs(rel) <= radius) & (kpos[:, None, :] >= 0) & (kpos[:, None, :] < L)
    s = jnp.where(valid[None, :, None, None], s, -jnp.inf)
    m = s.max(-1)
    if sink is not None:
        sk = sink.astype(jnp.float32).reshape(hkv, g)[None, None, :, :, None]
        m = jnp.maximum(m, sk)
    p = jnp.exp(s - m[..., None])
    den = p.sum(-1)
    if sink is not None:
        den = den + jnp.exp(sk - m)
    o = jnp.einsum('nbhgqk,nbkhd->nbqhgd', p.astype(v.dtype), vb, preferred_element_type=jnp.float32)
    den_t = jnp.transpose(den, (0, 1, 4, 2, 3))
    o = o / den_t[..., None]
    lse = jnp.transpose(m + jnp.log(den), (0, 1, 4, 2, 3)).reshape(n, L, hq)
    return o.reshape(n, L, hq, hd).astype(q.dtype), lse


def dilated_attention(q, k, v, window, dilation):
    b, L, h, hd = q.shape
    radius = window // (2 * dilation)
    ls = L // dilation

    def split(t):
        return t.reshape(b, ls, dilation, h, hd).transpose(0, 2, 1, 3, 4).reshape(b * dilation, ls, h, hd)

    o, lse = banded_attention(split(q), split(k), split(v), radius)
    o = o.reshape(b, dilation, ls, h, hd).transpose(0, 2, 1, 3, 4).reshape(b, L, h, hd)
    lse = lse.reshape(b, dilation, ls, h).transpose(0, 2, 1, 3).reshape(b, L, h)
    return o, lse


def hyena_filters(L, w1, b1, f1, w2, b2, f2, w3, b3):
    f32 = jnp.float32
    t = jnp.linspace(0.0, 1.0, L, dtype=f32)[:, None]
    bands = jnp.linspace(1e-4, B_BANDS - 1, B_BANDS, dtype=f32)[None, :]
    w = 2.0 * math.pi * jnp.arange(L, dtype=f32)[:, None] / L
    z = jnp.concatenate([t, jnp.cos(bands * w), -jnp.sin(bands * w)], axis=-1)
    h = jnp.sin(f1.astype(f32) * (z @ w1.astype(f32) + b1.astype(f32)))
    h = jnp.sin(f2.astype(f32) * (h @ w2.astype(f32) + b2.astype(f32)))
    h = (h @ w3.astype(f32) + b3.astype(f32)).reshape(L, B_N_DIR, B_ORDER, B_CH)
    max_decay = math.log(B_DECAY_TARGET) / B_FAST_DECAY_PCT
    min_decay = math.log(B_DECAY_TARGET) / B_SLOW_DECAY_PCT
    deltas = jnp.abs(jnp.linspace(min_decay, max_decay, B_CH, dtype=f32))
    decay = jnp.exp(-t * deltas[None, :])
    h = h * decay[:, None, None, :]
    fwd, bwd = h[:, 0], h[:, 1]
    kern = jnp.concatenate([fwd, jnp.zeros_like(fwd[:1]), bwd[:0:-1]], axis=0)
    kern = kern / jnp.sum(jnp.abs(kern), axis=0, keepdims=True)
    return jnp.fft.rfft(kern, axis=0)


def fft_long_conv(u, kf, bias):
    L = u.shape[1]
    uf32 = u.astype(jnp.float32)
    uf = jnp.fft.rfft(uf32, n=2 * L, axis=1)
    y = jnp.fft.irfft(uf * kf[None], n=2 * L, axis=1)[:, :L]
    return (y + uf32 * bias.astype(jnp.float32)).astype(u.dtype)


def short_conv(x, w, b):
    L = x.shape[1]
    r = B_SHORT // 2
    xp = jnp.pad(x, ((0, 0), (r, r), (0, 0)))
    y = b
    for j in range(B_SHORT):
        y = y + xp[:, j:j + L] * w[j]
    return y


def hyena_mixer(u, conv_w, conv_b, w1, b1, f1, w2, b2, f2, w3, b3, hy_bias):
    L = u.shape[1]
    u = short_conv(u, conv_w, conv_b)
    v, x1, x2 = jnp.split(u, 3, axis=-1)
    kf = hyena_filters(L, w1, b1, f1, w2, b2, f2, w3, b3)
    z = x1 * fft_long_conv(v, kf[:, 0], hy_bias[0])
    z = x2 * fft_long_conv(z, kf[:, 1], hy_bias[1])
    return z


def even_mixer(x, w_in, sink, conv_w, conv_b, w1, b1, f1, w2, b2, f2, w3, b3, hy_bias, w_out):
    b, L, _ = x.shape
    proj = x @ w_in
    q, k, v, hy = jnp.split(proj, [A_WIDTH, A_WIDTH + A_KV_WIDTH, A_WIDTH + 2 * A_KV_WIDTH], axis=-1)
    q = partial_rope(q.reshape(b, L, A_HEADS, A_HEAD_DIM))
    k = partial_rope(k.reshape(b, L, A_KV_HEADS, A_HEAD_DIM))
    v = v.reshape(b, L, A_KV_HEADS, A_HEAD_DIM)
    a_out, _ = banded_attention(q, k, v, A_RADIUS, sink)
    h_out = hyena_mixer(hy, conv_w, conv_b, w1, b1, f1, w2, b2, f2, w3, b3, hy_bias)
    return jnp.concatenate([a_out.reshape(b, L, A_WIDTH), h_out.astype(x.dtype)], axis=-1) @ w_out


def odd_mixer(x, w_in, w_out):
    b, L, _ = x.shape
    proj = (x @ w_in).reshape(b, L, 3, C_GROUPS, C_HEADS, C_HEAD_DIM)
    outs, lses = [], []
    for gi, (win, dil) in enumerate(C_PATTERNS):
        q = partial_rope(proj[:, :, 0, gi])
        k = partial_rope(proj[:, :, 1, gi])
        v = proj[:, :, 2, gi]
        o, lse = dilated_attention(q, k, v, win, dil)
        outs.append(o)
        lses.append(lse)
    wts = jax.nn.softmax(jnp.stack(lses, 0), axis=0)
    o = jnp.einsum('gblh,gblhd->blhd', wts, jnp.stack(outs, 0).astype(jnp.float32))
    return o.reshape(b, L, C_HEADS * C_HEAD_DIM).astype(x.dtype) @ w_out


def swiglu(x, wg, wu, wd):
    return (jax.nn.silu(x @ wg) * (x @ wu)) @ wd


def trunk(x, p):
    for i in range(DEPTH):
        if i % 2 == 0:
            j = i // 2
            mix = even_mixer(x, p['mix_e_w_in'][j], p['a_sink'][j], p['hy_conv_w'][j], p['hy_conv_b'][j],
                             p['hy_w1'][j], p['hy_b1'][j], p['hy_f1'][j], p['hy_w2'][j], p['hy_b2'][j],
                             p['hy_f2'][j], p['hy_w3'][j], p['hy_b3'][j], p['hy_bias'][j], p['mix_e_w_out'][j])
        else:
            j = i // 2
            mix = odd_mixer(x, p['mix_o_w_in'][j], p['mix_o_w_out'][j])
        x = layer_norm(ALPHA * x + mix, p['ln1_g'][i], p['ln1_b'][i])
        f = swiglu(x, p['ffn_w_gate'][i], p['ffn_w_up'][i], p['ffn_w_down'][i])
        x = layer_norm(ALPHA * x + f, p['ln2_g'][i], p['ln2_b'][i])
    return x


def setup_inputs(seed: int = 0) -> dict:
    key = jax.random.key(seed)
    ks = iter(jax.random.split(key, 32))
    f32 = jnp.float32

    def nrm(shape, scale):
        return jax.random.normal(next(ks), shape, f32) * scale

    D, H = D_MODEL, B_FILTER_HIDDEN
    return {
        'x_prompt': nrm((BATCH, SEQ, D), 1.0),
        'x_sample': nrm((DEC_BATCH, DEC_SEQ, D), 1.0),
        'mix_e_w_in': nrm((N_EVEN, D, E_PROJ), D ** -0.5),
        'a_sink': nrm((N_EVEN, A_HEADS), 0.5),
        'hy_conv_w': nrm((N_EVEN, B_SHORT, 3 * B_CH), B_SHORT ** -0.5),
        'hy_conv_b': nrm((N_EVEN, 3 * B_CH), 0.02),
        'hy_w1': nrm((N_EVEN, B_EMB, H), B_EMB ** -0.5),
        'hy_b1': nrm((N_EVEN, H), 0.02),
        'hy_f1': 1.0 + nrm((N_EVEN, H), 0.02),
        'hy_w2': nrm((N_EVEN, H, H), H ** -0.5),
        'hy_b2': nrm((N_EVEN, H), 0.02),
        'hy_f2': 1.0 + nrm((N_EVEN, H), 0.02),
        'hy_w3': nrm((N_EVEN, H, B_N_DIR * B_ORDER * B_CH), H ** -0.5),
        'hy_b3': nrm((N_EVEN, B_N_DIR * B_ORDER * B_CH), 0.02),
        'hy_bias': nrm((N_EVEN, B_ORDER, B_CH), 0.5),
        'mix_e_w_out': nrm((N_EVEN, D, D), D ** -0.5 * BETA),
        'mix_o_w_in': nrm((N_ODD, D, O_PROJ), D ** -0.5),
        'mix_o_w_out': nrm((N_ODD, C_HEADS * C_HEAD_DIM, D), (C_HEADS * C_HEAD_DIM) ** -0.5 * BETA),
        'ffn_w_gate': nrm((DEPTH, D, D_FF), D ** -0.5),
        'ffn_w_up': nrm((DEPTH, D, D_FF), D ** -0.5),
        'ffn_w_down': nrm((DEPTH, D_FF, D), D_FF ** -0.5 * BETA),
        'ln1_g': 1.0 + nrm((DEPTH, D), 0.02),
        'ln1_b': nrm((DEPTH, D), 0.02),
        'ln2_g': 1.0 + nrm((DEPTH, D), 0.02),
        'ln2_b': nrm((DEPTH, D), 0.02),
    }


def reference(x_prompt, x_sample, mix_e_w_in, a_sink, hy_conv_w, hy_conv_b, hy_w1, hy_b1, hy_f1,
              hy_w2, hy_b2, hy_f2, hy_w3, hy_b3, hy_bias, mix_e_w_out, mix_o_w_in, mix_o_w_out,
              ffn_w_gate, ffn_w_up, ffn_w_down, ln1_g, ln1_b, ln2_g, ln2_b):
    params = dict(mix_e_w_in=mix_e_w_in, a_sink=a_sink, hy_conv_w=hy_conv_w, hy_conv_b=hy_conv_b,
                  hy_w1=hy_w1, hy_b1=hy_b1, hy_f1=hy_f1, hy_w2=hy_w2, hy_b2=hy_b2, hy_f2=hy_f2,
                  hy_w3=hy_w3, hy_b3=hy_b3, hy_bias=hy_bias, mix_e_w_out=mix_e_w_out,
                  mix_o_w_in=mix_o_w_in, mix_o_w_out=mix_o_w_out, ffn_w_gate=ffn_w_gate,
                  ffn_w_up=ffn_w_up, ffn_w_down=ffn_w_down, ln1_g=ln1_g, ln1_b=ln1_b,
                  ln2_g=ln2_g, ln2_b=ln2_b)
    y_prompt = trunk(x_prompt, params)
    y_sample = trunk(x_sample, params)
    return (y_prompt, y_sample)
```

```cpp
#include <hip/hip_runtime.h>
#include <cstdio>
#include <cstdint>
#include <cmath>
namespace pg8 {
#define PG8_LAS __attribute__((address_space(3)))
typedef unsigned short bf16_t;
typedef short bf16x8 __attribute__((ext_vector_type(8)));
typedef float f32x4 __attribute__((ext_vector_type(4)));
typedef unsigned u32x4 __attribute__((ext_vector_type(4)));
constexpr int BM = 256, BK = 64, HALF = 128, HTB = HALF * BK * 2  , STAGE_BYTES = 8 * HTB, NXCD = 8, WGM = 8;

__host__ __device__ __forceinline__ int lds_byte(int r, int c) { const int st = (r >> 4) * 2 + (c >> 5), rr = r & 15, cc = c & 31, ob = rr * 64 + cc * 2; return st * 1024 + (ob ^ (((ob >> 9) & 1) << 5)); }
__host__ __device__ __forceinline__ void stage_rc(int b, int& R, int& C) { const int st = b / 1024, sb = b % 1024, swz = sb ^ (((sb >> 9) & 1) << 5); R = (st >> 1) * 16 + swz / 64; C = (st & 1) * 32 + (swz % 64) / 2; }
__host__ __device__ __forceinline__ int perm32(int rho) { const int n = rho >> 4, i = rho & 15; return 8 * (i >> 2) + 4 * n + (i & 3); }

struct Unit { int pm, pn; };
struct Gemm { const bf16_t* A; const bf16_t* Bt; int M, N, K; };

struct StaticOrder {
    int nM, nN, nwg, G, c;
    __host__ __device__ void init(int M, int N, int G_, int c_) { nM = M / BM; nN = N / BM; nwg = nM * nN; G = G_; c = c_; }
    __host__ __device__ bool next(int i, Unit& u) const {
        const long L = (long)i * G + c; if (L >= nwg) return false;
        int wgid = (int)L; { const int q = nwg / NXCD, r = nwg % NXCD, xcd = wgid % NXCD, off = wgid / NXCD; wgid = (xcd < r ? xcd * (q + 1) : r * (q + 1) + (xcd - r) * q) + off; }
        const int nig = WGM * nN, gid = wgid / nig, fm = gid * WGM, gsz = (nM - fm) < WGM ? (nM - fm) : WGM;
        u.pm = fm + ((wgid % nig) % gsz); u.pn = (wgid % nig) / gsz; return true;
    }
    __device__ __forceinline__ void a_ready(const Unit&) const {}
    __device__ __forceinline__ void done(const Unit&) const {}
};

__device__ __forceinline__ unsigned cvt_pk_bf16(float lo, float hi) { unsigned r; asm volatile("v_cvt_pk_bf16_f32 %0, %1, %2" : "=v"(r) : "v"(lo), "v"(hi)); return r; }
__device__ __forceinline__ u32x4 pack8(const f32x4& v0, const f32x4& v1) { u32x4 w; w.x = cvt_pk_bf16(v0[0], v0[1]); w.y = cvt_pk_bf16(v0[2], v0[3]); w.z = cvt_pk_bf16(v1[0], v1[1]); w.w = cvt_pk_bf16(v1[2], v1[3]); return w; }
__device__ __forceinline__ f32x4 shfl_xor4(const f32x4& v, int m) { f32x4 r; r[0] = __shfl_xor(v[0], m); r[1] = __shfl_xor(v[1], m); r[2] = __shfl_xor(v[2], m); r[3] = __shfl_xor(v[3], m); return r; }
__device__ __forceinline__ int seq_base_of_row(int row) { return row < 16384 ? 0 : (row < 20480 ? 16384 : 20480); }

struct EpiPlainBf16 {
    static constexpr bool PERM = true, AFTER_DRAIN = false;
    bf16_t* O; int ldc;
    __device__ __forceinline__ void operator()(const f32x4 (&acc)[2][2][4][2], const Unit& u, int wr, int wc, int fr_, int fq_) const {
        int fr = fr_, fq = fq_; asm volatile("" : "+v"(fr), "+v"(fq));
        const int row0 = u.pm * BM + wr * 64 + fr, col0 = u.pn * BM + wc * 32 + 8 * fq;
#pragma unroll
        for (int ai = 0; ai < 2; ++ai)
#pragma unroll
            for (int m = 0; m < 4; ++m) { bf16_t* rowp = O + (size_t)(row0 + ai * HALF + m * 16) * ldc + col0;
#pragma unroll
                for (int bj = 0; bj < 2; ++bj) *(u32x4*)(rowp + bj * HALF) = pack8(acc[ai][bj][m][0], acc[ai][bj][m][1]); }
    }
};

struct EpiEvenQKV {
    static constexpr bool PERM = true, AFTER_DRAIN = false;
    bf16_t* Q; bf16_t* Kb; bf16_t* Vb; const float* cosT; const float* sinT;
    __device__ __forceinline__ void operator()(const f32x4 (&acc)[2][2][4][2], const Unit& u, int wr, int wc, int fr_, int fq_) const {
        int fr = fr_, fq = fq_; asm volatile("" : "+v"(fr), "+v"(fq));
        const int row0 = u.pm * BM + wr * 64 + fr; const int sbase = seq_base_of_row(u.pm * BM);
        const bool ropew = ((wc & 1) == 0);
        const float sgn = (fq & 1) ? 1.f : -1.f;
#pragma unroll
        for (int ai = 0; ai < 2; ++ai)
#pragma unroll
            for (int m = 0; m < 4; ++m) { const int row = row0 + ai * HALF + m * 16; const int pos = row - sbase;
                f32x4 c0 = {1.f, 1.f, 1.f, 1.f}, c1 = c0, s0 = {0.f, 0.f, 0.f, 0.f}, s1 = s0;
                if (ropew && fq < 2) { c0 = *(const f32x4*)(cosT + (size_t)pos * 8); c1 = *(const f32x4*)(cosT + (size_t)pos * 8 + 4); s0 = *(const f32x4*)(sinT + (size_t)pos * 8); s1 = *(const f32x4*)(sinT + (size_t)pos * 8 + 4); }
#pragma unroll
                for (int bj = 0; bj < 2; ++bj) { f32x4 v0 = acc[ai][bj][m][0], v1 = acc[ai][bj][m][1];
                    const bool is_v = (u.pn == 4 && bj == 1);
                    if (ropew && !is_v) { const f32x4 p0 = shfl_xor4(v0, 16), p1 = shfl_xor4(v1, 16);
                        v0 = v0 * c0 + (p0 * s0) * sgn; v1 = v1 * c1 + (p1 * s1) * sgn; }
                    bf16_t* dst;
                    if (u.pn < 4) dst = Q + (size_t)row * 1024 + u.pn * 256 + bj * HALF + wc * 32 + 8 * fq;
                    else dst = (bj == 0 ? Kb : Vb) + (size_t)row * 128 + wc * 32 + 8 * fq;
                    *(u32x4*)dst = pack8(v0, v1); }
                asm volatile("" ::: "memory"); }
    }
};

struct EpiOddQKV {
    static constexpr bool PERM = true, AFTER_DRAIN = false;
    bf16_t* O; const float* cosT; const float* sinT; int Mtot;
    __device__ __forceinline__ void operator()(const f32x4 (&acc)[2][2][4][2], const Unit& u, int wr, int wc, int fr_, int fq_) const {
        int fr = fr_, fq = fq_; asm volatile("" : "+v"(fr), "+v"(fq));
        const int row0 = u.pm * BM + wr * 64 + fr; const int sbase = seq_base_of_row(u.pm * BM); const int L = sbase == 0 ? 16384 : 4096;
        const int sg = u.pn >> 3, s = sg / 3, g = sg - 3 * s; const int dsh = 2 * g;
        const int ls = L >> dsh;
        const bool ropew = (wc == 0) && (s < 2);
        const float sgn = (fq & 2) ? 1.f : -1.f;
        const int tb = (fq & 1) * 8;
#pragma unroll
        for (int ai = 0; ai < 2; ++ai)
#pragma unroll
            for (int m = 0; m < 4; ++m) { const int row = row0 + ai * HALF + m * 16; const int pos = row - sbase;
                const int prow = sbase + (pos & ((1 << dsh) - 1)) * ls + (pos >> dsh);
                f32x4 c0 = {1.f, 1.f, 1.f, 1.f}, c1 = c0, s0 = {0.f, 0.f, 0.f, 0.f}, s1 = s0;
                if (ropew) { const float* cp = cosT + (size_t)pos * 16 + tb; const float* sp = sinT + (size_t)pos * 16 + tb; c0 = *(const f32x4*)cp; c1 = *(const f32x4*)(cp + 4); s0 = *(const f32x4*)sp; s1 = *(const f32x4*)(sp + 4); }
#pragma unroll
                for (int bj = 0; bj < 2; ++bj) { f32x4 v0 = acc[ai][bj][m][0], v1 = acc[ai][bj][m][1];
                    if (ropew) { const f32x4 p0 = shfl_xor4(v0, 32), p1 = shfl_xor4(v1, 32);
                        v0 = v0 * c0 + (p0 * s0) * sgn; v1 = v1 * c1 + (p1 * s1) * sgn; }
                    const int head = 2 * (u.pn & 7) + bj;
                    bf16_t* dst = O + ((size_t)(sg * 16 + head) * Mtot + prow) * 128 + wc * 32 + 8 * fq;
                    *(u32x4*)dst = pack8(v0, v1); }
                asm volatile("" ::: "memory"); }
    }
};

struct EpiResid {
    static constexpr bool PERM = false, AFTER_DRAIN = false;
    float* X; int ldc; float alpha;
    __device__ __forceinline__ void operator()(const f32x4 (&acc)[2][2][4][2], const Unit& u, int wr, int wc, int fr_, int fq_) const {
        int fr = fr_, fq = fq_; asm volatile("" : "+v"(fr), "+v"(fq));
        const int row0 = u.pm * BM + wr * 64 + fr, col0 = u.pn * BM + wc * 32 + 4 * fq;
#pragma unroll
        for (int ai = 0; ai < 2; ++ai)
#pragma unroll
            for (int m = 0; m < 4; ++m) { float* rowp = X + (size_t)(row0 + ai * HALF + m * 16) * ldc + col0;
#pragma unroll
                for (int bj = 0; bj < 2; ++bj)
#pragma unroll
                    for (int n = 0; n < 2; ++n) { f32x4* p = (f32x4*)(rowp + bj * HALF + n * 16); const f32x4 x = *p; *p = x * alpha + acc[ai][bj][m][n]; }
                if (m & 1) asm volatile("" ::: "memory"); }
    }
};

struct EpiSwiGLU {
    static constexpr bool PERM = true, AFTER_DRAIN = false;
    bf16_t* H; int ldh;
    static __device__ __forceinline__ float silu_mul(float g, float up) { const float e = __builtin_amdgcn_exp2f(g * -1.4426950408889634f); return g * __builtin_amdgcn_rcpf(1.0f + e) * up; }
    __device__ __forceinline__ void operator()(const f32x4 (&acc)[2][2][4][2], const Unit& u, int wr, int wc, int fr_, int fq_) const {
        int fr = fr_, fq = fq_; asm volatile("" : "+v"(fr), "+v"(fq));
        const int row0 = u.pm * BM + wr * 64 + fr, col0 = u.pn * HALF + wc * 32 + 8 * fq;
#pragma unroll
        for (int ai = 0; ai < 2; ++ai)
#pragma unroll
            for (int m = 0; m < 4; ++m) { bf16_t* dst = H + (size_t)(row0 + ai * HALF + m * 16) * ldh + col0;
                f32x4 h0, h1;
#pragma unroll
                for (int e = 0; e < 4; ++e) { h0[e] = silu_mul(acc[ai][0][m][0][e], acc[ai][1][m][0][e]); h1[e] = silu_mul(acc[ai][0][m][1][e], acc[ai][1][m][1][e]); }
                *(u32x4*)dst = pack8(h0, h1); }
    }
};

template <class Epi, class Sched, bool ALIGN_EPI = false, bool SP2 = false>
__device__ __forceinline__ void gemm_phase(PG8_LAS unsigned char* lds, const Gemm g, const Sched& S, const Epi& E, const int wave_id) {
    int tid_; asm volatile("v_mbcnt_lo_u32_b32 %0, -1, 0\n\tv_mbcnt_hi_u32_b32 %0, -1, %0" : "=v"(tid_)); tid_ += wave_id * 64;
    const int tid = tid_, wid = __builtin_amdgcn_readfirstlane(tid >> 6), lane = tid & 63, wr = wid >> 2, wc = wid & 3, fr = lane & 15, fq = lane >> 4;
    const int K = g.K, nt = K / BK;
    unsigned voffA[2], voffB[2];
#pragma unroll
    for (int i = 0; i < 2; ++i) { int R, C; stage_rc(tid * 16 + i * 8192, R, C); const int Rb = Epi::PERM ? ((R & ~31) + perm32(R & 31)) : R;
        voffA[i] = (unsigned)(R * K + C) * 2u; voffB[i] = (unsigned)(Rb * K + C) * 2u; }
    const size_t kstep = (size_t)(BK * 2);
    const size_t hstep = (size_t)HALF * K * 2;
    const size_t tstep = 2 * hstep;
    const unsigned ldsw = (unsigned)wid * 1024u;
    const int aoff = lds_byte(wr * 64 + fr, fq * 8), boff = lds_byte(wc * 32 + fr, fq * 8);
#define PG8_SA(b, h) (((b) * 2 + (h)) * HTB)
#define PG8_SB(b, h) ((4 + (b) * 2 + (h)) * HTB)
#define PG8_STAGE(bufoff, gbase, voff) do { _Pragma("unroll") for (int _i = 0; _i < 2; ++_i) \
        __builtin_amdgcn_global_load_lds((const unsigned*)((const char*)(gbase) + (voff)[_i]), (PG8_LAS unsigned*)(lds + (bufoff) + ldsw + _i * 8192), 16, 0, 0); } while (0)
#define PG8_LDA(dst, b, h) do { _Pragma("unroll") for (int m = 0; m < 4; ++m) _Pragma("unroll") for (int k = 0; k < 2; ++k) dst[m][k] = *(const PG8_LAS bf16x8*)(lds + PG8_SA(b, h) + aoff + m * 2048 + k * 1024); } while (0)
#define PG8_LDB(dst, b, h) do { _Pragma("unroll") for (int n = 0; n < 2; ++n) _Pragma("unroll") for (int k = 0; k < 2; ++k) dst[n][k] = *(const PG8_LAS bf16x8*)(lds + PG8_SB(b, h) + boff + n * 2048 + k * 1024); } while (0)
#define PG8_MMA(ai, bj, At, Bt) do { __builtin_amdgcn_s_setprio(1); _Pragma("unroll") for (int m = 0; m < 4; ++m) _Pragma("unroll") for (int n = 0; n < 2; ++n) _Pragma("unroll") for (int k = 0; k < 2; ++k) \
        acc[ai][bj][m][n] = __builtin_amdgcn_mfma_f32_16x16x32_bf16(Bt[n][k], At[m][k], acc[ai][bj][m][n], 0, 0, 0); __builtin_amdgcn_s_setprio(0); } while (0)
#define PG8_WAIT_V(n) asm volatile("s_waitcnt vmcnt(" #n ")" ::: "memory")
#define PG8_WAIT_L(n) asm volatile("s_waitcnt lgkmcnt(" #n ")" ::: "memory")
#define PG8_BAR __builtin_amdgcn_s_barrier()
#define PG8_SCHED __builtin_amdgcn_sched_barrier(0)
    Unit cur, nxt; int ui = 0;
    if (!S.next(0, cur)) return;
    f32x4 acc[2][2][4][2];
#pragma unroll
    for (int a = 0; a < 2; ++a)
#pragma unroll
        for (int b = 0; b < 2; ++b)
#pragma unroll
            for (int m = 0; m < 4; ++m)
#pragma unroll
                for (int n = 0; n < 2; ++n) acc[a][b][m][n] = (f32x4){0.f, 0.f, 0.f, 0.f};
    bf16x8 At[4][2], B0[2][2], B1[2][2];
    const char* cA = (const char*)g.A + (size_t)cur.pm * tstep; const char* cB = (const char*)g.Bt + (size_t)cur.pn * tstep;
    S.a_ready(cur);
    if constexpr (SP2) {
        PG8_STAGE(PG8_SB(0, 0), cB, voffB); PG8_STAGE(PG8_SB(0, 1), cB + hstep, voffB); PG8_STAGE(PG8_SA(0, 0), cA, voffA); PG8_STAGE(PG8_SA(0, 1), cA + hstep, voffA);
        if (wr == 1) PG8_BAR;
        PG8_WAIT_V(2); PG8_BAR;
        PG8_STAGE(PG8_SB(1, 0), cB + kstep, voffB); PG8_STAGE(PG8_SA(1, 0), cA + kstep, voffA); PG8_STAGE(PG8_SB(1, 1), cB + hstep + kstep, voffB);
        PG8_WAIT_V(6); PG8_BAR;
    } else {
        PG8_STAGE(PG8_SB(0, 0), cB, voffB); PG8_STAGE(PG8_SA(0, 0), cA, voffA); PG8_STAGE(PG8_SB(0, 1), cB + hstep, voffB); PG8_STAGE(PG8_SA(0, 1), cA + hstep, voffA);
        if (wr == 1) PG8_BAR;
        PG8_WAIT_V(4); PG8_BAR;
        PG8_STAGE(PG8_SB(1, 0), cB + kstep, voffB); PG8_STAGE(PG8_SA(1, 0), cA + kstep, voffA); PG8_STAGE(PG8_SB(1, 1), cB + hstep + kstep, voffB);
        PG8_WAIT_V(6); PG8_BAR;
    }
    for (;;) {
        const bool has_next = S.next(ui + 1, nxt);
        const char* nA = has_next ? (const char*)g.A + (size_t)nxt.pm * tstep : cA; const char* nB = has_next ? (const char*)g.Bt + (size_t)nxt.pn * tstep : cB;
        for (int t = 0; t < nt; t += 2) {
            const bool last = (t == nt - 2);
            const char* a1 = cA + (size_t)(t + 1) * kstep;
            const char* a2 = last ? nA : cA + (size_t)(t + 2) * kstep; const char* b2 = last ? nB : cB + (size_t)(t + 2) * kstep;
            const char* a3 = a2 + kstep; const char* b3 = b2 + kstep;
            if (last && has_next) S.a_ready(nxt);
            if constexpr (SP2) {
            PG8_LDB(B0, 0, 0); PG8_LDB(B1, 0, 1); PG8_SCHED; PG8_LDA(At, 0, 0); PG8_STAGE(PG8_SA(1, 1), a1 + hstep, voffA);
            PG8_WAIT_V(8); PG8_WAIT_L(0); PG8_BAR; PG8_MMA(0, 0, At, B0); PG8_MMA(0, 1, At, B1); PG8_BAR; PG8_SCHED;
            PG8_LDA(At, 0, 1); PG8_STAGE(PG8_SB(0, 0), b2, voffB); PG8_STAGE(PG8_SB(0, 1), b2 + hstep, voffB); PG8_STAGE(PG8_SA(0, 0), a2, voffA);
            PG8_WAIT_V(8); PG8_WAIT_L(0); PG8_BAR; PG8_MMA(1, 0, At, B0); PG8_MMA(1, 1, At, B1); PG8_BAR; PG8_SCHED;
            PG8_LDB(B0, 1, 0); PG8_LDB(B1, 1, 1); PG8_SCHED; PG8_LDA(At, 1, 0); PG8_STAGE(PG8_SA(0, 1), a2 + hstep, voffA);
            PG8_WAIT_V(8); PG8_WAIT_L(0); PG8_BAR; PG8_MMA(0, 0, At, B0); PG8_MMA(0, 1, At, B1); PG8_BAR; PG8_SCHED;
            PG8_LDA(At, 1, 1); PG8_STAGE(PG8_SB(1, 0), b3, voffB); PG8_STAGE(PG8_SB(1, 1), b3 + hstep, voffB); PG8_STAGE(PG8_SA(1, 0), a3, voffA);
            PG8_WAIT_V(8); PG8_WAIT_L(0); PG8_BAR; PG8_MMA(1, 0, At, B0); PG8_MMA(1, 1, At, B1); PG8_BAR; PG8_SCHED;
            } else {
            PG8_LDB(B0, 0, 0); PG8_SCHED; PG8_LDA(At, 0, 0); PG8_STAGE(PG8_SA(1, 1), a1 + hstep, voffA);
            PG8_WAIT_L(8); PG8_BAR; PG8_WAIT_L(0); PG8_MMA(0, 0, At, B0); PG8_BAR; PG8_SCHED;
            PG8_LDB(B1, 0, 1); PG8_STAGE(PG8_SB(0, 0), b2, voffB);
            PG8_BAR; PG8_WAIT_L(0); PG8_MMA(0, 1, At, B1); PG8_BAR;
            PG8_LDA(At, 0, 1); PG8_STAGE(PG8_SA(0, 0), a2, voffA);
            PG8_BAR; PG8_WAIT_L(0); PG8_MMA(1, 0, At, B0); PG8_BAR; PG8_SCHED;
            PG8_STAGE(PG8_SB(0, 1), b2 + hstep, voffB);
            PG8_WAIT_V(6); PG8_BAR; PG8_MMA(1, 1, At, B1); PG8_BAR;
            PG8_LDB(B0, 1, 0); PG8_SCHED; PG8_LDA(At, 1, 0); PG8_STAGE(PG8_SA(0, 1), a2 + hstep, voffA);
            PG8_WAIT_L(8); PG8_BAR; PG8_WAIT_L(0); PG8_MMA(0, 0, At, B0); PG8_BAR; PG8_SCHED;
            PG8_LDB(B1, 1, 1); PG8_STAGE(PG8_SB(1, 0), b3, voffB);
            PG8_BAR; PG8_WAIT_L(0); PG8_MMA(0, 1, At, B1); PG8_BAR;
            PG8_LDA(At, 1, 1); PG8_STAGE(PG8_SA(1, 0), a3, voffA);
            PG8_BAR; PG8_WAIT_L(0); PG8_MMA(1, 0, At, B0); PG8_BAR; PG8_SCHED;
            PG8_STAGE(PG8_SB(1, 1), b3 + hstep, voffB);
            PG8_WAIT_V(6); PG8_BAR; PG8_MMA(1, 1, At, B1); PG8_BAR;
            }
        }
        if constexpr (ALIGN_EPI) { if (wr == 0) PG8_BAR; }
        if constexpr (!Epi::AFTER_DRAIN) { E(acc, cur, wr, wc, fr, fq); S.done(cur); }
        if (!has_next) break;
#pragma unroll
        for (int a = 0; a < 2; ++a)
#pragma unroll
            for (int b = 0; b < 2; ++b)
#pragma unroll
                for (int m = 0; m < 4; ++m)
#pragma unroll
                    for (int n = 0; n < 2; ++n) acc[a][b][m][n] = (f32x4){0.f, 0.f, 0.f, 0.f};
        cur = nxt; cA = nA; cB = nB; ++ui;
        if constexpr (ALIGN_EPI) { if (wr == 1) PG8_BAR; }
    }
    PG8_WAIT_V(0);
    if constexpr (!ALIGN_EPI) { if (wr == 0) PG8_BAR; }
    PG8_BAR;
    if constexpr (Epi::AFTER_DRAIN) { E.fused(acc, cur, wr, wc, fr, fq, lds, wid, lane); S.done(cur); }
#undef PG8_SA
#undef PG8_SB
#undef PG8_STAGE
#undef PG8_LDA
#undef PG8_LDB
#undef PG8_MMA
#undef PG8_WAIT_V
#undef PG8_WAIT_L
#undef PG8_BAR
#undef PG8_SCHED
}
}
#define GAS __attribute__((address_space(1)))
#define LAS __attribute__((address_space(3)))
typedef unsigned short bf16;
typedef unsigned v4u __attribute__((ext_vector_type(4)));
typedef float f32x4 __attribute__((ext_vector_type(4)));
typedef short bf16x8 __attribute__((ext_vector_type(8)));
typedef GAS unsigned gu32;
typedef GAS unsigned long long gu64;
#define RLX_AGENT __ATOMIC_RELAXED, __HIP_MEMORY_SCOPE_AGENT
#define LDS_WAIT() asm volatile("s_waitcnt lgkmcnt(0)" ::: "memory")
#define VM_WAIT() asm volatile("s_waitcnt vmcnt(0)" ::: "memory")
__device__ __forceinline__ unsigned long long rt() { return __builtin_amdgcn_s_memrealtime(); }
__device__ __forceinline__ unsigned f2bf(float f) { unsigned u = __builtin_bit_cast(unsigned, f); return (u + 0x7fffu + ((u >> 16) & 1u)) >> 16; }
__device__ __forceinline__ unsigned pk2(float lo, float hi) { return f2bf(lo) | (f2bf(hi) << 16); }

#define XB_TMO      128
#define XB_XCNT(j)  (256  + 64 * (j))
#define XB_XSUB(j)  (1280 + 64 * (j))
#define XB_XGEN(j)  (2304 + 64 * (j))
#define XB_TOP      3328
#define XB_TOPGEN   3392
#define XCD_BAR_WORDS 3456
#define XB_SPIN_CAP (1u << 18)

__device__ __forceinline__ unsigned xb_ld(unsigned* p)              { return __hip_atomic_load(p, __ATOMIC_RELAXED, __HIP_MEMORY_SCOPE_AGENT); }
__device__ __forceinline__ unsigned xb_add(unsigned* p, unsigned v) { return __hip_atomic_fetch_add(p, v, __ATOMIC_RELAXED, __HIP_MEMORY_SCOPE_AGENT); }
__device__ __forceinline__ unsigned xb_xcc_id() { return (unsigned)__builtin_amdgcn_s_getreg((3 << 11) | 20) & 0xFu; }
#define XB_SPIN(cond, bar) do { unsigned _sp = 0; while (cond) { __builtin_amdgcn_s_sleep(1); \
    if ((++_sp & 255u) == 0u) { if (xb_ld(&(bar)[XB_TMO])) break; if (_sp > XB_SPIN_CAP) { atomicAdd(&(bar)[XB_TMO], 1u); break; } } } } while (0)

struct XcdBarrier {
    unsigned* bar; unsigned x;
    volatile LAS unsigned* st;
};

__device__ __forceinline__ XcdBarrier xcd_barrier_post(unsigned* bar, volatile LAS unsigned* st) {
    XcdBarrier b; b.bar = bar; b.x = xb_xcc_id(); b.st = st;
    if (threadIdx.x == 0) (void)xb_add(&bar[XB_XCNT(b.x)], 1u);
    return b;
}
__device__ __forceinline__ void xcd_barrier_complete(unsigned* bar, unsigned x, unsigned& nloc, unsigned& nx) {
    const unsigned G = gridDim.x * gridDim.y * gridDim.z;
    unsigned sum, cnt, mine, sp = 0u;
    for (;;) {
        sum = 0u; cnt = 0u; mine = 0u;
#pragma unroll
        for (unsigned j = 0; j < 16; ++j) { const unsigned c = xb_ld(&bar[XB_XCNT(j)]); sum += c; cnt += (c > 0u) ? 1u : 0u; mine = (j == x) ? c : mine; }
        if (sum == G) break;
        __builtin_amdgcn_s_sleep(1);
        if ((++sp & 255u) == 0u) { if (xb_ld(&bar[XB_TMO])) break; if (sp > XB_SPIN_CAP) { atomicAdd(&bar[XB_TMO], 1u); break; } }
    }
    nloc = mine > 0u ? mine : 1u; nx = cnt > 0u ? cnt : 1u;
}

__device__ __forceinline__ void xcd_barrier(const XcdBarrier& b) {
    asm volatile("s_waitcnt vmcnt(0)" ::: "memory");
    __syncthreads();
    if (threadIdx.x == 0) {
        unsigned* bar = b.bar;
        __builtin_amdgcn_s_waitcnt(0);
        unsigned nloc = b.st[0], nx = b.st[1];
        if (nloc == 0u) { xcd_barrier_complete(bar, b.x, nloc, nx); b.st[0] = nloc; b.st[1] = nx; }
        const unsigned old = xb_add(&bar[XB_XSUB(b.x)], 1u);
        const unsigned gen = old / nloc;
        if (old + 1u == (gen + 1u) * nloc) {
            __builtin_amdgcn_fence(__ATOMIC_RELEASE, "agent");
            asm volatile("s_waitcnt vmcnt(0)" ::: "memory");
            const unsigned og = xb_add(&bar[XB_TOP], 1u);
            const unsigned tg = og / nx;
            if (og + 1u == (tg + 1u) * nx) xb_add(&bar[XB_TOPGEN], 1u);
            else XB_SPIN(xb_ld(&bar[XB_TOPGEN]) == tg, bar);
            __builtin_amdgcn_fence(__ATOMIC_ACQUIRE, "agent");
            xb_add(&bar[XB_XGEN(b.x)], 1u);
            asm volatile("s_waitcnt vmcnt(0)" ::: "memory");
        } else {
            XB_SPIN(xb_ld(&bar[XB_XGEN(b.x)]) == gen, bar);
            __builtin_amdgcn_fence(__ATOMIC_ACQUIRE, "agent");
            asm volatile("s_waitcnt vmcnt(0)" ::: "memory");
        }
    }
    __syncthreads();
}

constexpr int NWAVES = 8;
constexpr int M = 24576, D = 2048, DFF = 5632, DEPTH = 4;
constexpr int NSEQ = 3;
__host__ __device__ __forceinline__ int seq_base(int s) { return s == 0 ? 0 : (s == 1 ? 16384 : 20480); }
__host__ __device__ __forceinline__ int seq_len(int s) { return s == 0 ? 16384 : 4096; }
constexpr int E_PROJ = 4352, O_PROJ = 18432;
constexpr float LN_EPS = 1e-5f;
constexpr float ALPHA = 1.6817928305074290861f;
constexpr int PH_PER_LAYER = 9, NPHASE = DEPTH * PH_PER_LAYER;

constexpr size_t MiB = 1u << 20;
constexpr size_t WS_CTL = 0, CTL_ZERO_BYTES = 1 * MiB;
constexpr size_t WS_COSE = 1 * MiB, WS_SINE = WS_COSE + 512 * 1024, WS_COSO = 2 * MiB, WS_SINO = 3 * MiB;
constexpr size_t WS_LSE = 8 * MiB;
constexpr size_t WS_XB = 16 * MiB;
constexpr size_t WS_W = 112 * MiB;
constexpr size_t WS_BIG = 258 * MiB;
constexpr size_t WS_END = WS_BIG + 864 * MiB;
constexpr size_t W_IN = 0;
constexpr size_t W_OUT = 72 * MiB;
constexpr size_t W_GU = 80 * MiB;
constexpr size_t W_DN = 124 * MiB;
constexpr size_t B_Q = 0, B_K = 48 * MiB, B_V = 54 * MiB, B_HYT = 60 * MiB, B_TAP0 = 204 * MiB, B_TAP1 = 332 * MiB, B_ZT = 364 * MiB, B_PSUM = 412 * MiB;
constexpr int CW_BAR = 4096;

constexpr int RING_OFF = 0, RING_BYTES = 131072;
constexpr int LDSCTL_OFF = RING_BYTES, MISC_OFF = LDSCTL_OFF + 320;
constexpr int LDS_BYTES = 147456;

struct InTab { __device__ __forceinline__ const float* operator[](int i) const {
    const unsigned char __attribute__((address_space(4)))* k = (const unsigned char __attribute__((address_space(4)))*)__builtin_amdgcn_kernarg_segment_ptr();
    asm volatile("" : "+s"(k));
    return *(const float* const __attribute__((address_space(4)))*)(k + 8 * i); } };
struct Frame {
    LAS unsigned char* lds;
    volatile LAS unsigned* MISC;
    gu32* ctl;
    int tid, lane, wave;
    int G, bx;
    unsigned char* ws;
    float* X;
    InTab in;
};
__device__ __forceinline__ float bf2f(unsigned short b) { return __builtin_bit_cast(float, (unsigned)b << 16); }
__device__ __forceinline__ float wave_sum(float v) {
#pragma unroll
    for (int o = 1; o < 64; o <<= 1) v += __shfl_xor(v, o);
    return v;
}
__device__ __forceinline__ float wave_max(float v) {
#pragma unroll
    for (int o = 1; o < 64; o <<= 1) v = fmaxf(v, __shfl_xor(v, o));
    return v;
}


__device__ __forceinline__ void sincos_d(double x, double& sn, double& cs) {
    const double k = __builtin_rint(x * 0.63661977236758134308);
    double r = __builtin_fma(-k, 1.57079632679489655800, x); r = __builtin_fma(-k, 6.12323399573676603587e-17, r);
    const double r2 = r * r;
    double sp = -7.6471637318198164759e-13; sp = sp * r2 + 1.6059043836821614599e-10; sp = sp * r2 - 2.5052108385441718775e-08; sp = sp * r2 + 2.7557319223985890653e-06;
    sp = sp * r2 - 1.9841269841269841270e-04; sp = sp * r2 + 8.3333333333333333333e-03; sp = sp * r2 - 1.6666666666666666667e-01; const double s = r + r * r2 * sp;
    double cp = 4.7794773323873852974e-14; cp = cp * r2 - 1.1470745597729724714e-11; cp = cp * r2 + 2.0876756987868098979e-09; cp = cp * r2 - 2.7557319223985890653e-07;
    cp = cp * r2 + 2.4801587301587301587e-05; cp = cp * r2 - 1.3888888888888888889e-03; cp = cp * r2 + 4.1666666666666666667e-02; cp = cp * r2 - 0.5; const double c = 1.0 + r2 * cp;
    const int q = ((int)k) & 3;
    sn = (q == 0) ? s : (q == 1) ? c : (q == 2) ? -s : -c;
    cs = (q == 0) ? c : (q == 1) ? -s : (q == 2) ? -c : s;
}
__device__ __forceinline__ void sincos_f(float x, float& sn, float& cs) {
    const float k = __builtin_rintf(x * 0.636619772367581343f);
    float r = __builtin_fmaf(-k, 1.5703125f, x); r = __builtin_fmaf(-k, 4.837512969970703125e-4f, r); r = __builtin_fmaf(-k, 7.54978995489188216e-8f, r);
    const float r2 = r * r;
    float sp = 2.7557319224e-06f; sp = sp * r2 - 1.9841269841e-04f; sp = sp * r2 + 8.3333333333e-03f; sp = sp * r2 - 1.6666666667e-01f; const float s = r + r * r2 * sp;
    float cp = -2.7557319224e-07f; cp = cp * r2 + 2.4801587302e-05f; cp = cp * r2 - 1.3888888889e-03f; cp = cp * r2 + 4.1666666667e-02f; cp = cp * r2 - 0.5f; const float c = 1.0f + r2 * cp;
    const int q = ((int)k) & 3;
    sn = (q == 0) ? s : (q == 1) ? c : (q == 2) ? -s : -c;
    cs = (q == 0) ? c : (q == 1) ? -s : (q == 2) ? -c : s;
}
__device__ __forceinline__ float sin_f(float x) { float s, c; sincos_f(x, s, c); return s; }

__device__ __forceinline__ void transpose_item(const float* W, int K, int ldn, int c0, bf16* WT, int r0, LAS float* scr, int kb, int nb, int lane) {
    const int k0 = 64 * kb, n0 = 32 * nb;
#pragma unroll 8
    for (int i = 0; i < 32; ++i) { const int kk = 2 * i + (lane >> 5); scr[kk * 33 + (lane & 31)] = W[(size_t)(k0 + kk) * ldn + c0 + n0 + (lane & 31)]; }
    LDS_WAIT(); asm volatile("" ::: "memory");
    const int c = lane & 7;
#pragma unroll
    for (int j = 0; j < 4; ++j) { const int n = (lane >> 3) + 8 * j; const LAS float* s = scr + (8 * c) * 33 + n;
        v4u o; o.x = pk2(s[0 * 33], s[1 * 33]); o.y = pk2(s[2 * 33], s[3 * 33]); o.z = pk2(s[4 * 33], s[5 * 33]); o.w = pk2(s[6 * 33], s[7 * 33]);
        *(GAS v4u*)(WT + (size_t)(r0 + n0 + n) * K + k0 + 8 * c) = o; }
    LDS_WAIT(); asm volatile("" ::: "memory");
}
__device__ __forceinline__ void convert_segment(Frame& F, const float* W, int K, int ldn, int c0, int cnt, bf16* WT, int r0) {
    LAS float* scr = (LAS float*)(F.lds + RING_OFF + F.wave * 16384);
    const int gw = F.bx * NWAVES + F.wave, NGW = F.G * NWAVES;
    const int nnb = cnt / 32, nit = (K / 64) * nnb;
    for (int it = gw; it < nit; it += NGW) transpose_item(W, K, ldn, c0, WT, r0, scr, it / nnb, it % nnb, F.lane);
}

__device__ __forceinline__ void p_input(Frame& F) {
    const float* xp = F.in[0]; const float* xs = F.in[1];
    bf16* XB = (bf16*)(F.ws + WS_XB);
    const size_t n4 = (size_t)M * D / 4, np4 = (size_t)16384 * D / 4;
    for (size_t i = (size_t)F.bx * 512 + F.tid; i < n4; i += (size_t)F.G * 512) {
        const f32x4 v = i < np4 ? ((const f32x4*)xp)[i] : ((const f32x4*)xs)[i - np4];
        ((f32x4*)F.X)[i] = v;
        unsigned long long w = (unsigned long long)pk2(v[0], v[1]) | ((unsigned long long)pk2(v[2], v[3]) << 32);
        ((unsigned long long*)XB)[i] = w;
    }
    float* cE = (float*)(F.ws + WS_COSE); float* sE = (float*)(F.ws + WS_SINE); float* cO = (float*)(F.ws + WS_COSO); float* sO = (float*)(F.ws + WS_SINO);
    for (int i = F.bx * 512 + F.tid; i < 16384 * 24; i += F.G * 512) {
        const int pos = i / 24, f = i % 24;
        const float inv16[16] = {1.f, 0.440366596f, 0.193922743f, 0.0853971019f, 0.0376060307f, 0.016560439f, 0.00729266461f, 0.00321144587f, 0.00141421356f, 0.000622772379f, 0.000274248188f, 0.000120769735f, 5.3182961e-05f, 2.34199997e-05f, 1.03133862e-05f, 4.54167048e-06f};
        const int ff = f < 8 ? 2 * f : f - 8;
        float inv = 1.f;
#pragma unroll
        for (int q = 0; q < 16; ++q) inv = (ff == q) ? inv16[q] : inv;
        const float ang = (float)pos * inv; double sn, cs; sincos_d((double)ang, sn, cs);
        if (f < 8) { cE[pos * 8 + f] = (float)cs; sE[pos * 8 + f] = (float)sn; } else { cO[pos * 16 + (f - 8)] = (float)cs; sO[pos * 16 + (f - 8)] = (float)sn; }
    }
}

__device__ __forceinline__ void p_convert_weights(Frame& F, int layer) {
    const int j = layer >> 1; const bool even = !(layer & 1);
    bf16* Wb = (bf16*)(F.ws + WS_W);
    if (even) {
        const float* w_in = F.in[2] + (size_t)j * D * E_PROJ;
        convert_segment(F, w_in, D, E_PROJ, 0, 1280, (bf16*)((unsigned char*)Wb + W_IN), 0);
        convert_segment(F, w_in, D, E_PROJ, 1280, 3072, (bf16*)((unsigned char*)Wb + W_IN) + (size_t)1280 * D, 0);
        convert_segment(F, F.in[15] + (size_t)j * D * D, D, D, 0, D, (bf16*)((unsigned char*)Wb + W_OUT), 0);
    } else {
        convert_segment(F, F.in[16] + (size_t)j * D * O_PROJ, D, O_PROJ, 0, O_PROJ, (bf16*)((unsigned char*)Wb + W_IN), 0);
        convert_segment(F, F.in[17] + (size_t)j * D * D, D, D, 0, D, (bf16*)((unsigned char*)Wb + W_OUT), 0);
    }
    const float* wg = F.in[18] + (size_t)layer * D * DFF; const float* wu = F.in[19] + (size_t)layer * D * DFF;
    bf16* WGU = (bf16*)((unsigned char*)Wb + W_GU);
    {   LAS float* scr = (LAS float*)(F.lds + RING_OFF + F.wave * 16384);
        const int gw = F.bx * NWAVES + F.wave, NGW = F.G * NWAVES;
        const int nit = (D / 64) * (2 * DFF / 32);
        for (int it = gw; it < nit; it += NGW) { const int kb = it / 352, nb = it % 352;
            const int pn = nb >> 3, half = (nb >> 2) & 1, sub = nb & 3;
            transpose_item(half ? wu : wg, D, DFF, 128 * pn + 32 * sub, WGU, 32 * nb, scr, kb, 0, F.lane); }
    }
    convert_segment(F, F.in[20] + (size_t)layer * DFF * D, DFF, D, 0, D, (bf16*)((unsigned char*)Wb + W_DN), 0);
}

__device__ __forceinline__ void taps_tile(Frame& F, int j, int cls, int tile) {
    const int L = cls ? 4096 : 16384; const int i0 = tile * 64;
    LAS float* zf = (LAS float*)(F.lds + RING_OFF);
    LAS float* h1 = zf + 64 * 33;
    LAS float* h2 = h1 + 64 * 65;
    const float* w1 = F.in[6] + (size_t)j * 33 * 64; const float* b1 = F.in[7] + j * 64; const float* f1 = F.in[8] + j * 64;
    const float* w2 = F.in[9] + (size_t)j * 64 * 64; const float* b2 = F.in[10] + j * 64; const float* f2 = F.in[11] + j * 64;
    const float* w3 = F.in[12] + (size_t)j * 64 * 4096; const float* b3 = F.in[13] + (size_t)j * 4096;
    for (int idx = F.tid; idx < 64 * 33; idx += 512) { const int p = idx / 33, f = idx % 33, i = i0 + p; float val;
        if (f == 0) val = (float)i / (float)(L - 1);
        else { const int mm = (f - 1) & 15; const float band = 1e-4f + (float)mm * ((15.0f - 1e-4f) / 15.0f); const float w = 6.283185307179586f * (float)i / (float)L;
            float sn, cs; sincos_f(band * w, sn, cs); val = f <= 16 ? cs : -sn; }
        zf[p * 33 + f] = val; }
    __syncthreads();
    for (int idx = F.tid; idx < 64 * 64; idx += 512) { const int p = idx >> 6, k = idx & 63; float a = b1[k];
        for (int f = 0; f < 33; ++f) a += zf[p * 33 + f] * w1[f * 64 + k];
        h1[p * 65 + k] = sin_f(f1[k] * a); }
    __syncthreads();
    for (int idx = F.tid; idx < 64 * 64; idx += 512) { const int p = idx >> 6, k = idx & 63; float a = b2[k];
        for (int f = 0; f < 64; ++f) a += h1[p * 65 + f] * w2[f * 64 + k];
        h2[p * 65 + k] = sin_f(f2[k] * a); }
    __syncthreads();
    const int i = i0 + F.lane; const float ti = (float)i / (float)(L - 1);
    bf16* TAPS = (bf16*)(F.ws + WS_BIG + (cls ? B_TAP1 : B_TAP0));
    float* PS = (float*)(F.ws + WS_BIG + B_PSUM) + (cls ? (size_t)256 * 4096 : 0) + (size_t)tile * 4096;
    const float dmin = -3.0701134573253943f  , dmax = -15.350567286626973f  ;
    const LAS float* hrow = h2 + F.lane * 65;
#pragma unroll 1
    for (int cb = 0; cb < 512; cb += 4) { const int col = F.wave * 512 + cb;
        asm volatile("" ::: "memory");
        f32x4 a = *(const f32x4*)(b3 + col);
#pragma unroll 8
        for (int k = 0; k < 64; ++k) { const f32x4 wv = *(const f32x4*)(w3 + (size_t)k * 4096 + col); const float hk = hrow[k]; a += wv * hk; }
        const int dir = col >> 11, o = (col >> 10) & 1, ch0 = col & 1023;
#pragma unroll
        for (int e = 0; e < 4; ++e) { const int ch = ch0 + e; const float delta = fabsf(dmin + (dmax - dmin) * ((float)ch / 1023.0f));
            float val = a[e] * __expf(-ti * delta);
            bf16* tp = TAPS + ((size_t)(o * 1024 + ch)) * (2 * L);
            if (dir == 0) tp[L + i] = (bf16)f2bf(val);
            else { if (i >= 1) tp[L - i] = (bf16)f2bf(val); else { tp[0] = 0; val = 0.f; } }
            const float s = wave_sum(fabsf(val));
            if (F.lane == 0) PS[col + e] = s; }
    }
    __syncthreads();
}

__device__ __forceinline__ void p_layernorm(Frame& F, const float* gam, const float* bet) {
    bf16* XB = (bf16*)(F.ws + WS_XB);
    const int gw = F.bx * NWAVES + F.wave, NGW = F.G * NWAVES;
    f32x4 gv[8], bv[8];
#pragma unroll
    for (int q = 0; q < 8; ++q) { gv[q] = ((const f32x4*)gam)[F.lane + 64 * q]; bv[q] = ((const f32x4*)bet)[F.lane + 64 * q]; }
    for (int m = gw; m < M; m += NGW) {
        f32x4* xr = (f32x4*)(F.X + (size_t)m * D) + F.lane;
        f32x4 v[8]; float s = 0.f;
#pragma unroll
        for (int q = 0; q < 8; ++q) { v[q] = xr[64 * q]; s += (v[q][0] + v[q][1]) + (v[q][2] + v[q][3]); }
        const float mean = wave_sum(s) * (1.f / D); float s2 = 0.f;
#pragma unroll
        for (int q = 0; q < 8; ++q) { v[q] = v[q] - mean; s2 += (v[q][0] * v[q][0] + v[q][1] * v[q][1]) + (v[q][2] * v[q][2] + v[q][3] * v[q][3]); }
        const float rstd = 1.f / sqrtf(wave_sum(s2) * (1.f / D) + LN_EPS);
        unsigned long long* o8 = (unsigned long long*)(XB + (size_t)m * D) + F.lane;
#pragma unroll
        for (int q = 0; q < 8; ++q) { const f32x4 y = v[q] * rstd * gv[q] + bv[q]; xr[64 * q] = y;
            o8[64 * q] = (unsigned long long)pk2(y[0], y[1]) | ((unsigned long long)pk2(y[2], y[3]) << 32); }
    }
}

__device__ __forceinline__ void p_attn_even_naive(Frame& F, int j) {
    const bf16* Q = (const bf16*)(F.ws + WS_BIG + B_Q); const bf16* Kb = (const bf16*)(F.ws + WS_BIG + B_K); const bf16* Vb = (const bf16*)(F.ws + WS_BIG + B_V);
    bf16* AO = (bf16*)(F.ws + WS_XB);
    const float* sink = F.in[3] + j * 16;
    const int gw = F.bx * NWAVES + F.wave, NGW = F.G * NWAVES;
    for (int it = gw; it < M * 16; it += NGW) {
        const int tok = it >> 4, h = it & 15, kvh = h >> 3;
        const int sb = pg8::seq_base_of_row(tok), L = sb == 0 ? 16384 : 4096, pos = tok - sb;
        float sc[5]; bool ok[5];
#pragma unroll
        for (int c = 0; c < 5; ++c) sc[c] = 0.f;
        int kr[5];
#pragma unroll
        for (int c = 0; c < 5; ++c) { const int kp = pos - 128 + F.lane + 64 * c; ok[c] = (kp <= pos + 128) && kp >= 0 && kp < L; kr[c] = ok[c] ? sb + kp : tok; }
        for (int t = 0; t < 8; ++t) {
            const v4u qv = *(const v4u*)(Q + (size_t)tok * 1024 + h * 64 + 8 * t);
            float qf[8];
#pragma unroll
            for (int e = 0; e < 4; ++e) { qf[2 * e] = bf2f((unsigned short)(qv[e] & 0xffff)); qf[2 * e + 1] = bf2f((unsigned short)(qv[e] >> 16)); }
#pragma unroll
            for (int c = 0; c < 5; ++c) { const v4u kv = *(const v4u*)(Kb + (size_t)kr[c] * 128 + kvh * 64 + 8 * t);
#pragma unroll
                for (int e = 0; e < 4; ++e) sc[c] += qf[2 * e] * bf2f((unsigned short)(kv[e] & 0xffff)) + qf[2 * e + 1] * bf2f((unsigned short)(kv[e] >> 16)); }
        }
        const float sk = sink[h];
        float mx = sk;
#pragma unroll
        for (int c = 0; c < 5; ++c) { sc[c] = ok[c] ? sc[c] * 0.125f : -INFINITY; mx = fmaxf(mx, sc[c]); }
        mx = wave_max(mx);
        float p[5]; float ps = 0.f;
#pragma unroll
        for (int c = 0; c < 5; ++c) { p[c] = ok[c] ? __expf(sc[c] - mx) : 0.f; ps += p[c]; }
        const float den = wave_sum(ps) + __expf(sk - mx);
        float o = 0.f;
#pragma unroll
        for (int c = 0; c < 5; ++c)
            for (int l = 0; l < 64; ++l) { const float pl = __shfl(p[c], l); const int kp = pos - 128 + l + 64 * c;
                if (pl != 0.f) o += pl * bf2f(Vb[(size_t)(sb + kp) * 128 + kvh * 64 + F.lane]); }
        AO[(size_t)tok * D + h * 64 + F.lane] = (bf16)f2bf(o / den);
    }
}

__device__ __forceinline__ void p_attn_odd_naive(Frame& F) {
    bf16* QKV = (bf16*)(F.ws + WS_BIG); float* LSE = (float*)(F.ws + WS_LSE);
    const int gw = F.bx * NWAVES + F.wave, NGW = F.G * NWAVES;
    for (int it = gw; it < 3 * 16 * M; it += NGW) {
        const int prow = it % M, gh = it / M, g = gh >> 4, h = gh & 15;
        const int sb = pg8::seq_base_of_row(prow), L = sb == 0 ? 16384 : 4096, ls = L >> (2 * g);
        const int pp = prow - sb, rho = pp / ls, idx = pp - rho * ls;
        bf16* Qg = QKV + ((size_t)((0 * 3 + g) * 16 + h) * M) * 128; const bf16* Kg = QKV + ((size_t)((1 * 3 + g) * 16 + h) * M) * 128; const bf16* Vg = QKV + ((size_t)((2 * 3 + g) * 16 + h) * M) * 128;
        float sc[3]; bool ok[3]; int kr[3];
#pragma unroll
        for (int c = 0; c < 3; ++c) { const int ki = idx - 64 + F.lane + 64 * c; ok[c] = (ki <= idx + 64) && ki >= 0 && ki < ls; kr[c] = ok[c] ? sb + rho * ls + ki : prow; sc[c] = 0.f; }
        for (int t = 0; t < 16; ++t) {
            const v4u qv = *(const v4u*)(Qg + (size_t)prow * 128 + 8 * t);
            float qf[8];
#pragma unroll
            for (int e = 0; e < 4; ++e) { qf[2 * e] = bf2f((unsigned short)(qv[e] & 0xffff)); qf[2 * e + 1] = bf2f((unsigned short)(qv[e] >> 16)); }
#pragma unroll
            for (int c = 0; c < 3; ++c) { const v4u kv = *(const v4u*)(Kg + (size_t)kr[c] * 128 + 8 * t);
#pragma unroll
                for (int e = 0; e < 4; ++e) sc[c] += qf[2 * e] * bf2f((unsigned short)(kv[e] & 0xffff)) + qf[2 * e + 1] * bf2f((unsigned short)(kv[e] >> 16)); }
        }
        float mx = -INFINITY;
#pragma unroll
        for (int c = 0; c < 3; ++c) { sc[c] = ok[c] ? sc[c] * 0.08838834764831845f : -INFINITY; mx = fmaxf(mx, sc[c]); }
        mx = wave_max(mx);
        float p[3]; float ps = 0.f;
#pragma unroll
        for (int c = 0; c < 3; ++c) { p[c] = ok[c] ? __expf(sc[c] - mx) : 0.f; ps += p[c]; }
        const float den = wave_sum(ps);
        float o0 = 0.f, o1 = 0.f;
#pragma unroll
        for (int c = 0; c < 3; ++c)
            for (int l = 0; l < 64; ++l) { const float pl = __shfl(p[c], l); const int ki = idx - 64 + l + 64 * c;
                if (pl != 0.f) { const unsigned vv = *(const unsigned*)(Vg + (size_t)(sb + rho * ls + ki) * 128 + 2 * F.lane); o0 += pl * bf2f((unsigned short)(vv & 0xffff)); o1 += pl * bf2f((unsigned short)(vv >> 16)); } }
        const float inv = 1.f / den;
        *(unsigned*)(Qg + (size_t)prow * 128 + 2 * F.lane) = pk2(o0 * inv, o1 * inv);
        if (F.lane == 0) LSE[((size_t)g * M + prow) * 16 + h] = mx + __logf(den);
    }
}

__device__ __forceinline__ void p_combine_odd(Frame& F) {
    const bf16* QKV = (const bf16*)(F.ws + WS_BIG); const float* LSE = (const float*)(F.ws + WS_LSE); bf16* AO = (bf16*)(F.ws + WS_XB);
    for (int it = F.bx * 512 + F.tid; it < M * 256; it += F.G * 512) {
        const int tok = it >> 8, h = (it >> 4) & 15, ck = it & 15;
        const int sb = pg8::seq_base_of_row(tok), L = sb == 0 ? 16384 : 4096, pos = tok - sb;
        float l[3]; int pr[3];
#pragma unroll
        for (int g = 0; g < 3; ++g) { const int dsh = 2 * g; pr[g] = sb + (pos & ((1 << dsh) - 1)) * (L >> dsh) + (pos >> dsh); l[g] = LSE[((size_t)g * M + pr[g]) * 16 + h]; }
        const float mx = fmaxf(l[0], fmaxf(l[1], l[2]));
        float w[3]; float ws = 0.f;
#pragma unroll
        for (int g = 0; g < 3; ++g) { w[g] = __expf(l[g] - mx); ws += w[g]; }
        const float inv = 1.f / ws;
        float acc[8];
#pragma unroll
        for (int e = 0; e < 8; ++e) acc[e] = 0.f;
#pragma unroll
        for (int g = 0; g < 3; ++g) { const v4u ov = *(const v4u*)(QKV + ((size_t)(g * 16 + h) * M + pr[g]) * 128 + 8 * ck); const float wg = w[g] * inv;
#pragma unroll
            for (int e = 0; e < 4; ++e) { acc[2 * e] += wg * bf2f((unsigned short)(ov[e] & 0xffff)); acc[2 * e + 1] += wg * bf2f((unsigned short)(ov[e] >> 16)); } }
        v4u o; o.x = pk2(acc[0], acc[1]); o.y = pk2(acc[2], acc[3]); o.z = pk2(acc[4], acc[5]); o.w = pk2(acc[6], acc[7]);
        *(v4u*)(AO + (size_t)tok * D + h * 128 + 8 * ck) = o;
    }
}

template <int L> __device__ __forceinline__ void hyena_unit_naive(Frame& F, int j, int s, int ch) {
    constexpr int NQ = L / 512, cls = (L == 4096) ? 1 : 0, NT = L / 64;
    const int sb = seq_base(s);
    LAS bf16* tp = (LAS bf16*)(F.lds + RING_OFF); LAS bf16* vb = tp + 2 * L; LAS bf16* zb = vb + L;
    LAS float* red = (LAS float*)(F.lds + LDSCTL_OFF + 64);
    const bf16* HYT = (const bf16*)(F.ws + WS_BIG + B_HYT); bf16* ZT = (bf16*)(F.ws + WS_BIG + B_ZT);
    const bf16* TAPS = (const bf16*)(F.ws + WS_BIG + (cls ? B_TAP1 : B_TAP0));
    const float* PS = (const float*)(F.ws + WS_BIG + B_PSUM) + (cls ? (size_t)256 * 4096 : 0);
    const float* cw = F.in[4] + (size_t)j * 3 * 3072; const float* cb = F.in[5] + (size_t)j * 3072; const float* hb = F.in[14] + (size_t)j * 2 * 1024;
    if (F.wave < 2) { const int o = F.wave; float a = 0.f;
        for (int t = F.lane; t < NT; t += 64) a += PS[(size_t)t * 4096 + (0 * 2 + o) * 1024 + ch] + PS[(size_t)t * 4096 + (1 * 2 + o) * 1024 + ch];
        a = wave_sum(a); if (F.lane == 0) red[o] = a; }
    { const bf16* hr = HYT + (size_t)ch * M + sb; const float w0 = cw[0 * 3072 + ch], w1 = cw[1 * 3072 + ch], w2 = cw[2 * 3072 + ch], b = cb[ch];
      for (int i = F.tid; i < L; i += 512) { const float xm = i > 0 ? bf2f(hr[i - 1]) : 0.f, x0 = bf2f(hr[i]), xp = i < L - 1 ? bf2f(hr[i + 1]) : 0.f; vb[i] = (bf16)f2bf(b + w0 * xm + w1 * x0 + w2 * xp); } }
    __syncthreads();
#pragma unroll 1
    for (int o = 0; o < 2; ++o) {
        const bf16* tg = TAPS + (size_t)(o * 1024 + ch) * (2 * L);
        for (int i = F.tid; i < 2 * L / 8; i += 512) ((LAS v4u*)tp)[i] = ((const v4u*)tg)[i];
        __syncthreads();
        const LAS bf16* src = o == 0 ? vb : zb;
        float acc[NQ];
#pragma unroll
        for (int q = 0; q < NQ; ++q) acc[q] = 0.f;
        for (int jj = 0; jj < L; ++jj) { const float uj = bf2f(src[jj]); const LAS bf16* tq = tp + (L + F.tid - jj);
#pragma unroll
            for (int q = 0; q < NQ; ++q) acc[q] += bf2f(tq[512 * q]) * uj; }
        const float invS = 1.f / red[o]; const float bias = hb[o * 1024 + ch];
        const int gch = (o == 0 ? 1024 : 2048) + ch;
        const bf16* hr = HYT + (size_t)gch * M + sb; const float w0 = cw[0 * 3072 + gch], w1 = cw[1 * 3072 + gch], w2 = cw[2 * 3072 + gch], b = cb[gch];
#pragma unroll
        for (int q = 0; q < NQ; ++q) { const int i = 512 * q + F.tid;
            const float xm = i > 0 ? bf2f(hr[i - 1]) : 0.f, x0 = bf2f(hr[i]), xp = i < L - 1 ? bf2f(hr[i + 1]) : 0.f; const float xg = b + w0 * xm + w1 * x0 + w2 * xp;
            const float y = acc[q] * invS + bias * bf2f(src[i]); const float z = xg * y;
            if (o == 0) zb[i] = (bf16)f2bf(z); else ZT[(size_t)ch * M + sb + i] = (bf16)f2bf(z); }
        __syncthreads();
    }
}

__device__ __forceinline__ void p_zt_transpose(Frame& F) {
    const bf16* ZT = (const bf16*)(F.ws + WS_BIG + B_ZT); bf16* AO = (bf16*)(F.ws + WS_XB);
    for (int it = F.bx * 512 + F.tid; it < M * 128; it += F.G * 512) {
        const int tok = it % M, cg = it / M;
        unsigned short v[8];
#pragma unroll
        for (int e = 0; e < 8; ++e) v[e] = ZT[(size_t)(cg * 8 + e) * M + tok];
        v4u o; o.x = v[0] | ((unsigned)v[1] << 16); o.y = v[2] | ((unsigned)v[3] << 16); o.z = v[4] | ((unsigned)v[5] << 16); o.w = v[6] | ((unsigned)v[7] << 16);
        *(v4u*)(AO + (size_t)tok * D + 1024 + cg * 8) = o;
    }
}

#ifndef MK_MASK
#define MK_MASK 0xFFFFF
#endif
#define HAS(b) ((MK_MASK >> (b)) & 1)
struct Args { const float* in[25]; float* out; unsigned char* ws; int ph_lo, ph_hi; };
__global__ void __launch_bounds__(NWAVES * 64, 2) mk_fwd(Args args) {
    extern __shared__ __attribute__((aligned(16))) unsigned char lds[];
    Frame F;
    F.lds = (LAS unsigned char*)lds;
    F.MISC = (volatile LAS unsigned*)(F.lds + MISC_OFF);
    F.tid = threadIdx.x; F.lane = F.tid & 63; F.wave = __builtin_amdgcn_readfirstlane(F.tid >> 6);
    F.G = gridDim.x; F.bx = blockIdx.x;
    F.ws = args.ws; F.ctl = (gu32*)(args.ws + WS_CTL); F.X = args.out;
    for (int u = F.tid; u < (LDS_BYTES - LDSCTL_OFF) / 4; u += NWAVES * 64) ((LAS unsigned*)(F.lds + LDSCTL_OFF))[u] = 0u;
    __syncthreads();
    const int lo = args.ph_lo, hi = args.ph_hi;
    XcdBarrier bar; bar.bar = (unsigned*)(F.ctl + CW_BAR); bar.x = 0; bar.st = nullptr;
    if (hi - lo > 1) bar = xcd_barrier_post((unsigned*)(F.ctl + CW_BAR), F.MISC + 8);
#define IN(k) (lo <= (k) && (k) < hi)
#define SEAM(k) do { if ((k) + 1 < hi) xcd_barrier(bar); } while (0)
#define XB ((bf16*)(F.ws + WS_XB))
#define Wb ((bf16*)(F.ws + WS_W))
#define BIG (F.ws + WS_BIG)

    if (HAS(0) && IN(0)) p_input(F);
    for (int layer = 0; layer < DEPTH; ++layer) {
        const int pb = layer * PH_PER_LAYER; const bool even = !(layer & 1); const int j = layer >> 1;
#define FRESH() do { int l_; asm volatile("v_mbcnt_lo_u32_b32 %0, -1, 0\n\tv_mbcnt_hi_u32_b32 %0, -1, %0" : "=v"(l_)); int bx_ = blockIdx.x; asm volatile("" : "+s"(bx_)); F.bx = bx_; F.lane = l_; F.tid = F.wave * 64 + l_; unsigned char* w_ = args.ws; float* x_ = args.out; asm volatile("" : "+s"(w_), "+s"(x_)); F.ws = w_; F.X = x_; } while (0)
        if (HAS(0) && IN(pb + 0)) { FRESH();
            p_convert_weights(F, layer);
            __syncthreads();
            if (even) { for (int t = F.bx; t < 320; t += F.G) { if (t < 256) taps_tile(F, j, 0, t); else taps_tile(F, j, 1, t - 256); } }
            SEAM(pb + 0);
        }
        if (HAS(1) && IN(pb + 1)) { FRESH();
            if (HAS(9) && even) {
                { pg8::Gemm g{XB, (const bf16*)((unsigned char*)Wb + W_IN), M, 1280, D}; pg8::StaticOrder S; S.init(M, 1280, F.G, F.bx);
                  pg8::EpiEvenQKV E{(bf16*)(BIG + B_Q), (bf16*)(BIG + B_K), (bf16*)(BIG + B_V), (const float*)(F.ws + WS_COSE), (const float*)(F.ws + WS_SINE)};
                  pg8::gemm_phase<pg8::EpiEvenQKV, pg8::StaticOrder, true, true>(F.lds + RING_OFF, g, S, E, F.wave); }
                { pg8::Gemm g{(const bf16*)((unsigned char*)Wb + W_IN) + (size_t)1280 * D, XB, 3072, M, D}; pg8::StaticOrder S; S.init(3072, M, F.G, (int)(((unsigned)F.bx + 128u) % (unsigned)F.G));
                  pg8::EpiPlainBf16 E{(bf16*)(BIG + B_HYT), M};
                  pg8::gemm_phase<pg8::EpiPlainBf16, pg8::StaticOrder, true, true>(F.lds + RING_OFF, g, S, E, F.wave); }
            } else if (HAS(10)) {
                pg8::Gemm g{XB, (const bf16*)((unsigned char*)Wb + W_IN), M, O_PROJ, D}; pg8::StaticOrder S; S.init(M, O_PROJ, F.G, F.bx);
                pg8::EpiOddQKV E{(bf16*)BIG, (const float*)(F.ws + WS_COSO), (const float*)(F.ws + WS_SINO), M};
                pg8::gemm_phase<pg8::EpiOddQKV, pg8::StaticOrder, true, true>(F.lds + RING_OFF, g, S, E, F.wave);
            }
            SEAM(pb + 1);
        }
        if (HAS(2) && IN(pb + 2)) { FRESH();
            if (even) {
                for (int u = F.bx; u < 3072; u += F.G) { if (u < 1024) hyena_unit_naive<16384>(F, j, 0, u); else hyena_unit_naive<4096>(F, j, 1 + ((u - 1024) >> 10), (u - 1024) & 1023); }
                p_attn_even_naive(F, j);
            } else p_attn_odd_naive(F);
            SEAM(pb + 2);
        }
        if (HAS(3) && IN(pb + 3)) { FRESH();
            if (even) p_zt_transpose(F); else p_combine_odd(F);
            SEAM(pb + 3);
        }
        if (HAS(4) && IN(pb + 4)) { FRESH();
            pg8::Gemm g{XB, (const bf16*)((unsigned char*)Wb + W_OUT), M, D, D}; pg8::StaticOrder S; S.init(M, D, F.G, F.bx);
            pg8::EpiResid E{F.X, D, ALPHA};
            pg8::gemm_phase<pg8::EpiResid, pg8::StaticOrder, true, true>(F.lds + RING_OFF, g, S, E, F.wave);
            SEAM(pb + 4);
        }
        if (HAS(5) && IN(pb + 5)) { FRESH(); p_layernorm(F, F.in[21] + (size_t)layer * D, F.in[22] + (size_t)layer * D); SEAM(pb + 5); }
        if (HAS(6) && IN(pb + 6)) { FRESH();
            pg8::Gemm g{XB, (const bf16*)((unsigned char*)Wb + W_GU), M, 2 * DFF, D}; pg8::StaticOrder S; S.init(M, 2 * DFF, F.G, F.bx);
            pg8::EpiSwiGLU E{(bf16*)BIG, DFF};
            pg8::gemm_phase<pg8::EpiSwiGLU, pg8::StaticOrder, true, true>(F.lds + RING_OFF, g, S, E, F.wave);
            SEAM(pb + 6);
        }
        if (HAS(7) && IN(pb + 7)) { FRESH();
            pg8::Gemm g{(const bf16*)BIG, (const bf16*)((unsigned char*)Wb + W_DN), M, D, DFF}; pg8::StaticOrder S; S.init(M, D, F.G, F.bx);
            pg8::EpiResid E{F.X, D, ALPHA};
            pg8::gemm_phase<pg8::EpiResid, pg8::StaticOrder, true, true>(F.lds + RING_OFF, g, S, E, F.wave);
            SEAM(pb + 7);
        }
        if (HAS(8) && IN(pb + 8)) { FRESH(); p_layernorm(F, F.in[23] + (size_t)layer * D, F.in[24] + (size_t)layer * D); SEAM(pb + 8); }
    }
#undef IN
#undef SEAM
#undef FRESH
#undef XB
#undef Wb
#undef BIG
}

#ifndef MK_ONE_LAUNCH
#define MK_ONE_LAUNCH 0
#endif
extern "C" void kernel_launch(void* const* d_in, const int* in_sizes, int n_in, void* d_out, int out_size, void* d_ws, size_t ws_size, hipStream_t stream) {
    static int grid = 0;
    if (grid == 0) {
        if (n_in != 25 || out_size != M * D || ws_size < WS_END) { fprintf(stderr, "kernel_launch: unexpected shapes (n_in %d, out %d, ws %zu < %zu)\n", n_in, out_size, ws_size, (size_t)WS_END); grid = -1; return; }
        int dev = 0, cus = 0, per_cu = 0;
        if (hipGetDevice(&dev) != hipSuccess || hipDeviceGetAttribute(&cus, hipDeviceAttributeMultiprocessorCount, dev) != hipSuccess) { grid = -1; return; }
        if (hipFuncSetAttribute((const void*)mk_fwd, hipFuncAttributeMaxDynamicSharedMemorySize, LDS_BYTES) != hipSuccess) { fprintf(stderr, "kernel_launch: hipFuncSetAttribute failed\n"); grid = -1; return; }
        if (hipOccupancyMaxActiveBlocksPerMultiprocessor(&per_cu, (const void*)mk_fwd, NWAVES * 64, LDS_BYTES) != hipSuccess || per_cu < 1) { fprintf(stderr, "kernel_launch: occupancy query says %d\n", per_cu); }
        (void)hipGetLastError();
        grid = cus;
    }
    if (grid < 0) return;
    (void)hipMemsetAsync((char*)d_ws + WS_CTL, 0, CTL_ZERO_BYTES, stream);
    Args a{};
    for (int i = 0; i < 25; ++i) a.in[i] = (const float*)d_in[i];
    a.out = (float*)d_out; a.ws = (unsigned char*)d_ws;
#if MK_ONE_LAUNCH
    a.ph_lo = 0; a.ph_hi = NPHASE;
    hipLaunchKernelGGL(mk_fwd, dim3(grid), dim3(NWAVES * 64), LDS_BYTES, stream, a);
#else
    for (int ph = 0; ph < NPHASE; ++ph) { a.ph_lo = ph; a.ph_hi = ph + 1; hipLaunchKernelGGL(mk_fwd, dim3(grid), dim3(NWAVES * 64), LDS_BYTES, stream, a); }
#endif
}
```

```cpp
#include <hip/hip_runtime.h>
#include <cstdio>
#include <cstdint>
#include <cmath>
namespace pg8 {
#define PG8_LAS __attribute__((address_space(3)))
typedef unsigned short bf16_t;
typedef short bf16x8 __attribute__((ext_vector_type(8)));
typedef float f32x4 __attribute__((ext_vector_type(4)));
typedef unsigned u32x4 __attribute__((ext_vector_type(4)));
constexpr int BM = 256, BK = 64, HALF = 128, HTB = HALF * BK * 2  , STAGE_BYTES = 8 * HTB, NXCD = 8, WGM = 8;

__host__ __device__ __forceinline__ int lds_byte(int r, int c) { const int st = (r >> 4) * 2 + (c >> 5), rr = r & 15, cc = c & 31, ob = rr * 64 + cc * 2; return st * 1024 + (ob ^ (((ob >> 9) & 1) << 5)); }
__host__ __device__ __forceinline__ void stage_rc(int b, int& R, int& C) { const int st = b / 1024, sb = b % 1024, swz = sb ^ (((sb >> 9) & 1) << 5); R = (st >> 1) * 16 + swz / 64; C = (st & 1) * 32 + (swz % 64) / 2; }
__host__ __device__ __forceinline__ int perm32(int rho) { const int n = rho >> 4, i = rho & 15; return 8 * (i >> 2) + 4 * n + (i & 3); }

struct Unit { int pm, pn; };
struct Gemm { const bf16_t* A; const bf16_t* Bt; int M, N, K; };

struct StaticOrder {
    int nM, nN, nwg, G, c;
    __host__ __device__ void init(int M, int N, int G_, int c_) { nM = M / BM; nN = N / BM; nwg = nM * nN; G = G_; c = c_; }
    __host__ __device__ bool next(int i, Unit& u) const {
        const long L = (long)i * G + c; if (L >= nwg) return false;
        int wgid = (int)L; { const int q = nwg / NXCD, r = nwg % NXCD, xcd = wgid % NXCD, off = wgid / NXCD; wgid = (xcd < r ? xcd * (q + 1) : r * (q + 1) + (xcd - r) * q) + off; }
        const int nig = WGM * nN, gid = wgid / nig, fm = gid * WGM, gsz = (nM - fm) < WGM ? (nM - fm) : WGM;
        u.pm = fm + ((wgid % nig) % gsz); u.pn = (wgid % nig) / gsz; return true;
    }
    __device__ __forceinline__ void a_ready(const Unit&) const {}
    __device__ __forceinline__ void done(const Unit&) const {}
};

__device__ __forceinline__ unsigned cvt_pk_bf16(float lo, float hi) { unsigned r; asm volatile("v_cvt_pk_bf16_f32 %0, %1, %2" : "=v"(r) : "v"(lo), "v"(hi)); return r; }
__device__ __forceinline__ u32x4 pack8(const f32x4& v0, const f32x4& v1) { u32x4 w; w.x = cvt_pk_bf16(v0[0], v0[1]); w.y = cvt_pk_bf16(v0[2], v0[3]); w.z = cvt_pk_bf16(v1[0], v1[1]); w.w = cvt_pk_bf16(v1[2], v1[3]); return w; }
__device__ __forceinline__ f32x4 shfl_xor4(const f32x4& v, int m) { f32x4 r; r[0] = __shfl_xor(v[0], m); r[1] = __shfl_xor(v[1], m); r[2] = __shfl_xor(v[2], m); r[3] = __shfl_xor(v[3], m); return r; }
__device__ __forceinline__ int seq_base_of_row(int row) { return row < 16384 ? 0 : (row < 20480 ? 16384 : 20480); }

struct EpiPlainBf16 {
    static constexpr bool PERM = true, AFTER_DRAIN = false;
    bf16_t* O; int ldc;
    __device__ __forceinline__ void operator()(const f32x4 (&acc)[2][2][4][2], const Unit& u, int wr, int wc, int fr_, int fq_) const {
        int fr = fr_, fq = fq_; asm volatile("" : "+v"(fr), "+v"(fq));
        const int row0 = u.pm * BM + wr * 64 + fr, col0 = u.pn * BM + wc * 32 + 8 * fq;
#pragma unroll
        for (int ai = 0; ai < 2; ++ai)
#pragma unroll
            for (int m = 0; m < 4; ++m) { bf16_t* rowp = O + (size_t)(row0 + ai * HALF + m * 16) * ldc + col0;
#pragma unroll
                for (int bj = 0; bj < 2; ++bj) *(u32x4*)(rowp + bj * HALF) = pack8(acc[ai][bj][m][0], acc[ai][bj][m][1]); }
    }
};

struct EpiEvenQKV {
    static constexpr bool PERM = true, AFTER_DRAIN = false;
    bf16_t* Q; bf16_t* Kb; bf16_t* Vb; const float* cosT; const float* sinT;
    __device__ __forceinline__ void operator()(const f32x4 (&acc)[2][2][4][2], const Unit& u, int wr, int wc, int fr_, int fq_) const {
        int fr = fr_, fq = fq_; asm volatile("" : "+v"(fr), "+v"(fq));
        const int row0 = u.pm * BM + wr * 64 + fr; const int sbase = seq_base_of_row(u.pm * BM);
        const bool ropew = ((wc & 1) == 0);
        const float sgn = (fq & 1) ? 1.f : -1.f;
#pragma unroll
        for (int ai = 0; ai < 2; ++ai)
#pragma unroll
            for (int m = 0; m < 4; ++m) { const int row = row0 + ai * HALF + m * 16; const int pos = row - sbase;
                f32x4 c0 = {1.f, 1.f, 1.f, 1.f}, c1 = c0, s0 = {0.f, 0.f, 0.f, 0.f}, s1 = s0;
                if (ropew && fq < 2) { c0 = *(const f32x4*)(cosT + (size_t)pos * 8); c1 = *(const f32x4*)(cosT + (size_t)pos * 8 + 4); s0 = *(const f32x4*)(sinT + (size_t)pos * 8); s1 = *(const f32x4*)(sinT + (size_t)pos * 8 + 4); }
#pragma unroll
                for (int bj = 0; bj < 2; ++bj) { f32x4 v0 = acc[ai][bj][m][0], v1 = acc[ai][bj][m][1];
                    const bool is_v = (u.pn == 4 && bj == 1);
                    if (ropew && !is_v) { const f32x4 p0 = shfl_xor4(v0, 16), p1 = shfl_xor4(v1, 16);
                        v0 = v0 * c0 + (p0 * s0) * sgn; v1 = v1 * c1 + (p1 * s1) * sgn; }
                    bf16_t* dst;
                    if (u.pn < 4) dst = Q + (size_t)row * 1024 + u.pn * 256 + bj * HALF + wc * 32 + 8 * fq;
                    else dst = (bj == 0 ? Kb : Vb) + (size_t)row * 128 + wc * 32 + 8 * fq;
                    *(u32x4*)dst = pack8(v0, v1); }
                asm volatile("" ::: "memory"); }
    }
};

struct EpiOddQKV {
    static constexpr bool PERM = true, AFTER_DRAIN = false;
    bf16_t* O; const float* cosT; const float* sinT; int Mtot;
    __device__ __forceinline__ void operator()(const f32x4 (&acc)[2][2][4][2], const Unit& u, int wr, int wc, int fr_, int fq_) const {
        int fr = fr_, fq = fq_; asm volatile("" : "+v"(fr), "+v"(fq));
        const int row0 = u.pm * BM + wr * 64 + fr; const int sbase = seq_base_of_row(u.pm * BM); const int L = sbase == 0 ? 16384 : 4096;
        const int sg = u.pn >> 3, s = sg / 3, g = sg - 3 * s; const int dsh = 2 * g;
        const int ls = L >> dsh;
        const bool ropew = (wc == 0) && (s < 2);
        const float sgn = (fq & 2) ? 1.f : -1.f;
        const int tb = (fq & 1) * 8;
#pragma unroll
        for (int ai = 0; ai < 2; ++ai)
#pragma unroll
            for (int m = 0; m < 4; ++m) { const int row = row0 + ai * HALF + m * 16; const int pos = row - sbase;
                const int prow = sbase + (pos & ((1 << dsh) - 1)) * ls + (pos >> dsh);
                f32x4 c0 = {1.f, 1.f, 1.f, 1.f}, c1 = c0, s0 = {0.f, 0.f, 0.f, 0.f}, s1 = s0;
                if (ropew) { const float* cp = cosT + (size_t)pos * 16 + tb; const float* sp = sinT + (size_t)pos * 16 + tb; c0 = *(const f32x4*)cp; c1 = *(const f32x4*)(cp + 4); s0 = *(const f32x4*)sp; s1 = *(const f32x4*)(sp + 4); }
#pragma unroll
                for (int bj = 0; bj < 2; ++bj) { f32x4 v0 = acc[ai][bj][m][0], v1 = acc[ai][bj][m][1];
                    if (ropew) { const f32x4 p0 = shfl_xor4(v0, 32), p1 = shfl_xor4(v1, 32);
                        v0 = v0 * c0 + (p0 * s0) * sgn; v1 = v1 * c1 + (p1 * s1) * sgn; }
                    const int head = 2 * (u.pn & 7) + bj;
                    bf16_t* dst = O + ((size_t)(sg * 16 + head) * Mtot + prow) * 128 + wc * 32 + 8 * fq;
                    *(u32x4*)dst = pack8(v0, v1); }
                asm volatile("" ::: "memory"); }
    }
};

struct EpiResid {
    static constexpr bool PERM = false, AFTER_DRAIN = false;
    float* X; int ldc; float alpha;
    __device__ __forceinline__ void operator()(const f32x4 (&acc)[2][2][4][2], const Unit& u, int wr, int wc, int fr_, int fq_) const {
        int fr = fr_, fq = fq_; asm volatile("" : "+v"(fr), "+v"(fq));
        const int row0 = u.pm * BM + wr * 64 + fr, col0 = u.pn * BM + wc * 32 + 4 * fq;
#pragma unroll
        for (int ai = 0; ai < 2; ++ai)
#pragma unroll
            for (int m = 0; m < 4; ++m) { float* rowp = X + (size_t)(row0 + ai * HALF + m * 16) * ldc + col0;
#pragma unroll
                for (int bj = 0; bj < 2; ++bj)
#pragma unroll
                    for (int n = 0; n < 2; ++n) { f32x4* p = (f32x4*)(rowp + bj * HALF + n * 16); const f32x4 x = *p; *p = x * alpha + acc[ai][bj][m][n]; }
                if (m & 1) asm volatile("" ::: "memory"); }
    }
};

struct EpiSwiGLU {
    static constexpr bool PERM = true, AFTER_DRAIN = false;
    bf16_t* H; int ldh;
    static __device__ __forceinline__ float silu_mul(float g, float up) { const float e = __builtin_amdgcn_exp2f(g * -1.4426950408889634f); return g * __builtin_amdgcn_rcpf(1.0f + e) * up; }
    __device__ __forceinline__ void operator()(const f32x4 (&acc)[2][2][4][2], const Unit& u, int wr, int wc, int fr_, int fq_) const {
        int fr = fr_, fq = fq_; asm volatile("" : "+v"(fr), "+v"(fq));
        const int row0 = u.pm * BM + wr * 64 + fr, col0 = u.pn * HALF + wc * 32 + 8 * fq;
#pragma unroll
        for (int ai = 0; ai < 2; ++ai)
#pragma unroll
            for (int m = 0; m < 4; ++m) { bf16_t* dst = H + (size_t)(row0 + ai * HALF + m * 16) * ldh + col0;
                f32x4 h0, h1;
#pragma unroll
                for (int e = 0; e < 4; ++e) { h0[e] = silu_mul(acc[ai][0][m][0][e], acc[ai][1][m][0][e]); h1[e] = silu_mul(acc[ai][0][m][1][e], acc[ai][1][m][1][e]); }
                *(u32x4*)dst = pack8(h0, h1); }
    }
};

template <class Epi, class Sched, bool ALIGN_EPI = false, bool SP2 = false>
__device__ __forceinline__ void gemm_phase(PG8_LAS unsigned char* lds, const Gemm g, const Sched& S, const Epi& E, const int wave_id) {
    int tid_; asm volatile("v_mbcnt_lo_u32_b32 %0, -1, 0\n\tv_mbcnt_hi_u32_b32 %0, -1, %0" : "=v"(tid_)); tid_ += wave_id * 64;
    const int tid = tid_, wid = __builtin_amdgcn_readfirstlane(tid >> 6), lane = tid & 63, wr = wid >> 2, wc = wid & 3, fr = lane & 15, fq = lane >> 4;
    const int K = g.K, nt = K / BK;
    unsigned voffA[2], voffB[2];
#pragma unroll
    for (int i = 0; i < 2; ++i) { int R, C; stage_rc(tid * 16 + i * 8192, R, C); const int Rb = Epi::PERM ? ((R & ~31) + perm32(R & 31)) : R;
        voffA[i] = (unsigned)(R * K + C) * 2u; voffB[i] = (unsigned)(Rb * K + C) * 2u; }
    const size_t kstep = (size_t)(BK * 2);
    const size_t hstep = (size_t)HALF * K * 2;
    const size_t tstep = 2 * hstep;
    const unsigned ldsw = (unsigned)wid * 1024u;
    const int aoff = lds_byte(wr * 64 + fr, fq * 8), boff = lds_byte(wc * 32 + fr, fq * 8);
#define PG8_SA(b, h) (((b) * 2 + (h)) * HTB)
#define PG8_SB(b, h) ((4 + (b) * 2 + (h)) * HTB)
#define PG8_STAGE(bufoff, gbase, voff) do { _Pragma("unroll") for (int _i = 0; _i < 2; ++_i) \
        __builtin_amdgcn_global_load_lds((const unsigned*)((const char*)(gbase) + (voff)[_i]), (PG8_LAS unsigned*)(lds + (bufoff) + ldsw + _i * 8192), 16, 0, 0); } while (0)
#define PG8_LDA(dst, b, h) do { _Pragma("unroll") for (int m = 0; m < 4; ++m) _Pragma("unroll") for (int k = 0; k < 2; ++k) dst[m][k] = *(const PG8_LAS bf16x8*)(lds + PG8_SA(b, h) + aoff + m * 2048 + k * 1024); } while (0)
#define PG8_LDB(dst, b, h) do { _Pragma("unroll") for (int n = 0; n < 2; ++n) _Pragma("unroll") for (int k = 0; k < 2; ++k) dst[n][k] = *(const PG8_LAS bf16x8*)(lds + PG8_SB(b, h) + boff + n * 2048 + k * 1024); } while (0)
#define PG8_MMA(ai, bj, At, Bt) do { __builtin_amdgcn_s_setprio(1); _Pragma("unroll") for (int m = 0; m < 4; ++m) _Pragma("unroll") for (int n = 0; n < 2; ++n) _Pragma("unroll") for (int k = 0; k < 2; ++k) \
        acc[ai][bj][m][n] = __builtin_amdgcn_mfma_f32_16x16x32_bf16(Bt[n][k], At[m][k], acc[ai][bj][m][n], 0, 0, 0); __builtin_amdgcn_s_setprio(0); } while (0)
#define PG8_WAIT_V(n) asm volatile("s_waitcnt vmcnt(" #n ")" ::: "memory")
#define PG8_WAIT_L(n) asm volatile("s_waitcnt lgkmcnt(" #n ")" ::: "memory")
#define PG8_BAR __builtin_amdgcn_s_barrier()
#define PG8_SCHED __builtin_amdgcn_sched_barrier(0)
    Unit cur, nxt; int ui = 0;
    if (!S.next(0, cur)) return;
    f32x4 acc[2][2][4][2];
#pragma unroll
    for (int a = 0; a < 2; ++a)
#pragma unroll
        for (int b = 0; b < 2; ++b)
#pragma unroll
            for (int m = 0; m < 4; ++m)
#pragma unroll
                for (int n = 0; n < 2; ++n) acc[a][b][m][n] = (f32x4){0.f, 0.f, 0.f, 0.f};
    bf16x8 At[4][2], B0[2][2], B1[2][2];
    const char* cA = (const char*)g.A + (size_t)cur.pm * tstep; const char* cB = (const char*)g.Bt + (size_t)cur.pn * tstep;
    S.a_ready(cur);
    if constexpr (SP2) {
        PG8_STAGE(PG8_SB(0, 0), cB, voffB); PG8_STAGE(PG8_SB(0, 1), cB + hstep, voffB); PG8_STAGE(PG8_SA(0, 0), cA, voffA); PG8_STAGE(PG8_SA(0, 1), cA + hstep, voffA);
        if (wr == 1) PG8_BAR;
        PG8_WAIT_V(2); PG8_BAR;
        PG8_STAGE(PG8_SB(1, 0), cB + kstep, voffB); PG8_STAGE(PG8_SA(1, 0), cA + kstep, voffA); PG8_STAGE(PG8_SB(1, 1), cB + hstep + kstep, voffB);
        PG8_WAIT_V(6); PG8_BAR;
    } else {
        PG8_STAGE(PG8_SB(0, 0), cB, voffB); PG8_STAGE(PG8_SA(0, 0), cA, voffA); PG8_STAGE(PG8_SB(0, 1), cB + hstep, voffB); PG8_STAGE(PG8_SA(0, 1), cA + hstep, voffA);
        if (wr == 1) PG8_BAR;
        PG8_WAIT_V(4); PG8_BAR;
        PG8_STAGE(PG8_SB(1, 0), cB + kstep, voffB); PG8_STAGE(PG8_SA(1, 0), cA + kstep, voffA); PG8_STAGE(PG8_SB(1, 1), cB + hstep + kstep, voffB);
        PG8_WAIT_V(6); PG8_BAR;
    }
    for (;;) {
        const bool has_next = S.next(ui + 1, nxt);
        const char* nA = has_next ? (const char*)g.A + (size_t)nxt.pm * tstep : cA; const char* nB = has_next ? (const char*)g.Bt + (size_t)nxt.pn * tstep : cB;
        for (int t = 0; t < nt; t += 2) {
            const bool last = (t == nt - 2);
            const char* a1 = cA + (size_t)(t + 1) * kstep;
            const char* a2 = last ? nA : cA + (size_t)(t + 2) * kstep; const char* b2 = last ? nB : cB + (size_t)(t + 2) * kstep;
            const char* a3 = a2 + kstep; const char* b3 = b2 + kstep;
            if (last && has_next) S.a_ready(nxt);
            if constexpr (SP2) {
            PG8_LDB(B0, 0, 0); PG8_LDB(B1, 0, 1); PG8_SCHED; PG8_LDA(At, 0, 0); PG8_STAGE(PG8_SA(1, 1), a1 + hstep, voffA);
            PG8_WAIT_V(8); PG8_WAIT_L(0); PG8_BAR; PG8_MMA(0, 0, At, B0); PG8_MMA(0, 1, At, B1); PG8_BAR; PG8_SCHED;
            PG8_LDA(At, 0, 1); PG8_STAGE(PG8_SB(0, 0), b2, voffB); PG8_STAGE(PG8_SB(0, 1), b2 + hstep, voffB); PG8_STAGE(PG8_SA(0, 0), a2, voffA);
            PG8_WAIT_V(8); PG8_WAIT_L(0); PG8_BAR; PG8_MMA(1, 0, At, B0); PG8_MMA(1, 1, At, B1); PG8_BAR; PG8_SCHED;
            PG8_LDB(B0, 1, 0); PG8_LDB(B1, 1, 1); PG8_SCHED; PG8_LDA(At, 1, 0); PG8_STAGE(PG8_SA(0, 1), a2 + hstep, voffA);
            PG8_WAIT_V(8); PG8_WAIT_L(0); PG8_BAR; PG8_MMA(0, 0, At, B0); PG8_MMA(0, 1, At, B1); PG8_BAR; PG8_SCHED;
            PG8_LDA(At, 1, 1); PG8_STAGE(PG8_SB(1, 0), b3, voffB); PG8_STAGE(PG8_SB(1, 1), b3 + hstep, voffB); PG8_STAGE(PG8_SA(1, 0), a3, voffA);
            PG8_WAIT_V(8); PG8_WAIT_L(0); PG8_BAR; PG8_MMA(1, 0, At, B0); PG8_MMA(1, 1, At, B1); PG8_BAR; PG8_SCHED;
            } else {
            PG8_LDB(B0, 0, 0); PG8_SCHED; PG8_LDA(At, 0, 0); PG8_STAGE(PG8_SA(1, 1), a1 + hstep, voffA);
            PG8_WAIT_L(8); PG8_BAR; PG8_WAIT_L(0); PG8_MMA(0, 0, At, B0); PG8_BAR; PG8_SCHED;
            PG8_LDB(B1, 0, 1); PG8_STAGE(PG8_SB(0, 0), b2, voffB);
            PG8_BAR; PG8_WAIT_L(0); PG8_MMA(0, 1, At, B1); PG8_BAR;
            PG8_LDA(At, 0, 1); PG8_STAGE(PG8_SA(0, 0), a2, voffA);
            PG8_BAR; PG8_WAIT_L(0); PG8_MMA(1, 0, At, B0); PG8_BAR; PG8_SCHED;
            PG8_STAGE(PG8_SB(0, 1), b2 + hstep, voffB);
            PG8_WAIT_V(6); PG8_BAR; PG8_MMA(1, 1, At, B1); PG8_BAR;
            PG8_LDB(B0, 1, 0); PG8_SCHED; PG8_LDA(At, 1, 0); PG8_STAGE(PG8_SA(0, 1), a2 + hstep, voffA);
            PG8_WAIT_L(8); PG8_BAR; PG8_WAIT_L(0); PG8_MMA(0, 0, At, B0); PG8_BAR; PG8_SCHED;
            PG8_LDB(B1, 1, 1); PG8_STAGE(PG8_SB(1, 0), b3, voffB);
            PG8_BAR; PG8_WAIT_L(0); PG8_MMA(0, 1, At, B1); PG8_BAR;
            PG8_LDA(At, 1, 1); PG8_STAGE(PG8_SA(1, 0), a3, voffA);
            PG8_BAR; PG8_WAIT_L(0); PG8_MMA(1, 0, At, B0); PG8_BAR; PG8_SCHED;
            PG8_STAGE(PG8_SB(1, 1), b3 + hstep, voffB);
            PG8_WAIT_V(6); PG8_BAR; PG8_MMA(1, 1, At, B1); PG8_BAR;
            }
        }
        if constexpr (ALIGN_EPI) { if (wr == 0) PG8_BAR; }
        if constexpr (!Epi::AFTER_DRAIN) { E(acc, cur, wr, wc, fr, fq); S.done(cur); }
        if (!has_next) break;
#pragma unroll
        for (int a = 0; a < 2; ++a)
#pragma unroll
            for (int b = 0; b < 2; ++b)
#pragma unroll
                for (int m = 0; m < 4; ++m)
#pragma unroll
                    for (int n = 0; n < 2; ++n) acc[a][b][m][n] = (f32x4){0.f, 0.f, 0.f, 0.f};
        cur = nxt; cA = nA; cB = nB; ++ui;
        if constexpr (ALIGN_EPI) { if (wr == 1) PG8_BAR; }
    }
    PG8_WAIT_V(0);
    if constexpr (!ALIGN_EPI) { if (wr == 0) PG8_BAR; }
    PG8_BAR;
    if constexpr (Epi::AFTER_DRAIN) { E.fused(acc, cur, wr, wc, fr, fq, lds, wid, lane); S.done(cur); }
#undef PG8_SA
#undef PG8_SB
#undef PG8_STAGE
#undef PG8_LDA
#undef PG8_LDB
#undef PG8_MMA
#undef PG8_WAIT_V
#undef PG8_WAIT_L
#undef PG8_BAR
#undef PG8_SCHED
}
}
#define GAS __attribute__((address_space(1)))
#define LAS __attribute__((address_space(3)))
typedef unsigned short bf16;
typedef unsigned v4u __attribute__((ext_vector_type(4)));
typedef float f32x4 __attribute__((ext_vector_type(4)));
typedef short bf16x8 __attribute__((ext_vector_type(8)));
typedef GAS unsigned gu32;
typedef GAS unsigned long long gu64;
#define RLX_AGENT __ATOMIC_RELAXED, __HIP_MEMORY_SCOPE_AGENT
#define LDS_WAIT() asm volatile("s_waitcnt lgkmcnt(0)" ::: "memory")
#define VM_WAIT() asm volatile("s_waitcnt vmcnt(0)" ::: "memory")
__device__ __forceinline__ unsigned long long rt() { return __builtin_amdgcn_s_memrealtime(); }
__device__ __forceinline__ unsigned f2bf(float f) { unsigned u = __builtin_bit_cast(unsigned, f); return (u + 0x7fffu + ((u >> 16) & 1u)) >> 16; }
__device__ __forceinline__ unsigned pk2(float lo, float hi) { return f2bf(lo) | (f2bf(hi) << 16); }

#define XB_TMO      128
#define XB_XCNT(j)  (256  + 64 * (j))
#define XB_XSUB(j)  (1280 + 64 * (j))
#define XB_XGEN(j)  (2304 + 64 * (j))
#define XB_TOP      3328
#define XB_TOPGEN   3392
#define XCD_BAR_WORDS 3456
#define XB_SPIN_CAP (1u << 22)

__device__ __forceinline__ unsigned xb_ld(unsigned* p)              { return __hip_atomic_load(p, __ATOMIC_RELAXED, __HIP_MEMORY_SCOPE_AGENT); }
__device__ __forceinline__ unsigned xb_add(unsigned* p, unsigned v) { return __hip_atomic_fetch_add(p, v, __ATOMIC_RELAXED, __HIP_MEMORY_SCOPE_AGENT); }
__device__ __forceinline__ unsigned xb_xcc_id() { return (unsigned)__builtin_amdgcn_s_getreg((3 << 11) | 20) & 0xFu; }
#define XB_SPIN(cond, bar) do { unsigned _sp = 0; while (cond) { __builtin_amdgcn_s_sleep(1); \
    if ((++_sp & 255u) == 0u) { if (xb_ld(&(bar)[XB_TMO])) break; if (_sp > XB_SPIN_CAP) { atomicAdd(&(bar)[XB_TMO], 1u); break; } } } } while (0)

struct XcdBarrier {
    unsigned* bar; unsigned x;
    volatile LAS unsigned* st;
};

__device__ __forceinline__ XcdBarrier xcd_barrier_post(unsigned* bar, volatile LAS unsigned* st) {
    XcdBarrier b; b.bar = bar; b.x = xb_xcc_id(); b.st = st;
    if (threadIdx.x == 0) (void)xb_add(&bar[XB_XCNT(b.x)], 1u);
    return b;
}
__device__ __forceinline__ void xcd_barrier_complete(unsigned* bar, unsigned x, unsigned& nloc, unsigned& nx) {
    const unsigned G = gridDim.x * gridDim.y * gridDim.z;
    unsigned sum, cnt, mine, sp = 0u;
    for (;;) {
        sum = 0u; cnt = 0u; mine = 0u;
#pragma unroll
        for (unsigned j = 0; j < 16; ++j) { const unsigned c = xb_ld(&bar[XB_XCNT(j)]); sum += c; cnt += (c > 0u) ? 1u : 0u; mine = (j == x) ? c : mine; }
        if (sum == G) break;
        __builtin_amdgcn_s_sleep(1);
        if ((++sp & 255u) == 0u) { if (xb_ld(&bar[XB_TMO])) break; if (sp > XB_SPIN_CAP) { atomicAdd(&bar[XB_TMO], 1u); break; } }
    }
    nloc = mine > 0u ? mine : 1u; nx = cnt > 0u ? cnt : 1u;
}

__device__ __forceinline__ void xcd_barrier(const XcdBarrier& b) {
    asm volatile("s_waitcnt vmcnt(0)" ::: "memory");
    __syncthreads();
    if (threadIdx.x == 0) {
        unsigned* bar = b.bar;
        __builtin_amdgcn_s_waitcnt(0);
        unsigned nloc = b.st[0], nx = b.st[1];
        if (nloc == 0u) { xcd_barrier_complete(bar, b.x, nloc, nx); b.st[0] = nloc; b.st[1] = nx; }
        const unsigned old = xb_add(&bar[XB_XSUB(b.x)], 1u);
        const unsigned gen = old / nloc;
        if (old + 1u == (gen + 1u) * nloc) {
            __builtin_amdgcn_fence(__ATOMIC_RELEASE, "agent");
            asm volatile("s_waitcnt vmcnt(0)" ::: "memory");
            const unsigned og = xb_add(&bar[XB_TOP], 1u);
            const unsigned tg = og / nx;
            if (og + 1u == (tg + 1u) * nx) xb_add(&bar[XB_TOPGEN], 1u);
            else XB_SPIN(xb_ld(&bar[XB_TOPGEN]) == tg, bar);
            __builtin_amdgcn_fence(__ATOMIC_ACQUIRE, "agent");
            xb_add(&bar[XB_XGEN(b.x)], 1u);
            asm volatile("s_waitcnt vmcnt(0)" ::: "memory");
        } else {
            XB_SPIN(xb_ld(&bar[XB_XGEN(b.x)]) == gen, bar);
            __builtin_amdgcn_fence(__ATOMIC_ACQUIRE, "agent");
            asm volatile("s_waitcnt vmcnt(0)" ::: "memory");
        }
    }
    __syncthreads();
}

constexpr int NWAVES = 8;
constexpr int M = 24576, D = 2048, DFF = 5632, DEPTH = 4;
constexpr int NSEQ = 3;
__host__ __device__ __forceinline__ int seq_base(int s) { return s == 0 ? 0 : (s == 1 ? 16384 : 20480); }
__host__ __device__ __forceinline__ int seq_len(int s) { return s == 0 ? 16384 : 4096; }
constexpr int E_PROJ = 4352, O_PROJ = 18432;
constexpr float LN_EPS = 1e-5f;
constexpr float ALPHA = 1.6817928305074290861f;
constexpr int PH_PER_LAYER = 9, NPHASE = DEPTH * PH_PER_LAYER;

constexpr size_t MiB = 1u << 20;
constexpr size_t WS_CTL = 0, CTL_ZERO_BYTES = 1 * MiB;
constexpr size_t WS_COSE = 1 * MiB, WS_SINE = WS_COSE + 512 * 1024, WS_COSO = 2 * MiB, WS_SINO = 3 * MiB;
constexpr size_t WS_LSE = 8 * MiB;
constexpr size_t WS_XB = 16 * MiB;
constexpr size_t WS_W = 112 * MiB;
constexpr size_t WS_BIG = 258 * MiB;
constexpr size_t WS_END = WS_BIG + 864 * MiB;
constexpr size_t W_IN = 0;
constexpr size_t W_OUT = 72 * MiB;
constexpr size_t W_GU = 80 * MiB;
constexpr size_t W_DN = 124 * MiB;
constexpr size_t B_Q = 0, B_K = 48 * MiB, B_V = 54 * MiB, B_HYT = 60 * MiB, B_TAP0 = 204 * MiB, B_TAP1 = 332 * MiB, B_ZT = 364 * MiB, B_PSUM = 412 * MiB;
constexpr int CW_BAR = 4096;

constexpr int RING_OFF = 0, RING_BYTES = 131072;
constexpr int LDSCTL_OFF = RING_BYTES, MISC_OFF = LDSCTL_OFF + 320;
constexpr int LDS_BYTES = 147456;

struct InTab { __device__ __forceinline__ const float* operator[](int i) const {
    const unsigned char __attribute__((address_space(4)))* k = (const unsigned char __attribute__((address_space(4)))*)__builtin_amdgcn_kernarg_segment_ptr();
    asm volatile("" : "+s"(k));
    return *(const float* const __attribute__((address_space(4)))*)(k + 8 * i); } };
struct Frame {
    LAS unsigned char* lds;
    volatile LAS unsigned* MISC;
    gu32* ctl;
    int tid, lane, wave;
    int G, bx;
    unsigned char* ws;
    float* X;
    InTab in;
};
__device__ __forceinline__ float bf2f(unsigned short b) { return __builtin_bit_cast(float, (unsigned)b << 16); }
__device__ __forceinline__ float wave_sum(float v) {
#pragma unroll
    for (int o = 1; o < 64; o <<= 1) v += __shfl_xor(v, o);
    return v;
}
__device__ __forceinline__ float wave_max(float v) {
#pragma unroll
    for (int o = 1; o < 64; o <<= 1) v = fmaxf(v, __shfl_xor(v, o));
    return v;
}


__device__ __forceinline__ void sincos_d(double x, double& sn, double& cs) {
    const double k = __builtin_rint(x * 0.63661977236758134308);
    double r = __builtin_fma(-k, 1.57079632679489655800, x); r = __builtin_fma(-k, 6.12323399573676603587e-17, r);
    const double r2 = r * r;
    double sp = -7.6471637318198164759e-13; sp = sp * r2 + 1.6059043836821614599e-10; sp = sp * r2 - 2.5052108385441718775e-08; sp = sp * r2 + 2.7557319223985890653e-06;
    sp = sp * r2 - 1.9841269841269841270e-04; sp = sp * r2 + 8.3333333333333333333e-03; sp = sp * r2 - 1.6666666666666666667e-01; const double s = r + r * r2 * sp;
    double cp = 4.7794773323873852974e-14; cp = cp * r2 - 1.1470745597729724714e-11; cp = cp * r2 + 2.0876756987868098979e-09; cp = cp * r2 - 2.7557319223985890653e-07;
    cp = cp * r2 + 2.4801587301587301587e-05; cp = cp * r2 - 1.3888888888888888889e-03; cp = cp * r2 + 4.1666666666666666667e-02; cp = cp * r2 - 0.5; const double c = 1.0 + r2 * cp;
    const int q = ((int)k) & 3;
    sn = (q == 0) ? s : (q == 1) ? c : (q == 2) ? -s : -c;
    cs = (q == 0) ? c : (q == 1) ? -s : (q == 2) ? -c : s;
}
__device__ __forceinline__ void sincos_f(float x, float& sn, float& cs) {
    const float k = __builtin_rintf(x * 0.636619772367581343f);
    float r = __builtin_fmaf(-k, 1.5703125f, x); r = __builtin_fmaf(-k, 4.837512969970703125e-4f, r); r = __builtin_fmaf(-k, 7.54978995489188216e-8f, r);
    const float r2 = r * r;
    float sp = 2.7557319224e-06f; sp = sp * r2 - 1.9841269841e-04f; sp = sp * r2 + 8.3333333333e-03f; sp = sp * r2 - 1.6666666667e-01f; const float s = r + r * r2 * sp;
    float cp = -2.7557319224e-07f; cp = cp * r2 + 2.4801587302e-05f; cp = cp * r2 - 1.3888888889e-03f; cp = cp * r2 + 4.1666666667e-02f; cp = cp * r2 - 0.5f; const float c = 1.0f + r2 * cp;
    const int q = ((int)k) & 3;
    sn = (q == 0) ? s : (q == 1) ? c : (q == 2) ? -s : -c;
    cs = (q == 0) ? c : (q == 1) ? -s : (q == 2) ? -c : s;
}
__device__ __forceinline__ float sin_f(float x) { float s, c; sincos_f(x, s, c); return s; }

__device__ __forceinline__ void transpose_item(const float* W, int K, int ldn, int c0, bf16* WT, int r0, LAS float* scr, int kb, int nb, int lane) {
    const int k0 = 64 * kb, n0 = 32 * nb;
#pragma unroll 8
    for (int i = 0; i < 32; ++i) { const int kk = 2 * i + (lane >> 5); scr[kk * 33 + (lane & 31)] = W[(size_t)(k0 + kk) * ldn + c0 + n0 + (lane & 31)]; }
    LDS_WAIT(); asm volatile("" ::: "memory");
    const int c = lane & 7;
#pragma unroll
    for (int j = 0; j < 4; ++j) { const int n = (lane >> 3) + 8 * j; const LAS float* s = scr + (8 * c) * 33 + n;
        v4u o; o.x = pk2(s[0 * 33], s[1 * 33]); o.y = pk2(s[2 * 33], s[3 * 33]); o.z = pk2(s[4 * 33], s[5 * 33]); o.w = pk2(s[6 * 33], s[7 * 33]);
        *(GAS v4u*)(WT + (size_t)(r0 + n0 + n) * K + k0 + 8 * c) = o; }
    LDS_WAIT(); asm volatile("" ::: "memory");
}
__device__ __forceinline__ void convert_segment(Frame& F, const float* W, int K, int ldn, int c0, int cnt, bf16* WT, int r0) {
    LAS float* scr = (LAS float*)(F.lds + RING_OFF + F.wave * 16384);
    const int gw = F.bx * NWAVES + F.wave, NGW = F.G * NWAVES;
    const int nnb = cnt / 32, nit = (K / 64) * nnb;
    for (int it = gw; it < nit; it += NGW) transpose_item(W, K, ldn, c0, WT, r0, scr, it / nnb, it % nnb, F.lane);
}

__device__ __forceinline__ void p_input(Frame& F) {
    const float* xp = F.in[0]; const float* xs = F.in[1];
    bf16* XB = (bf16*)(F.ws + WS_XB);
    const size_t n4 = (size_t)M * D / 4, np4 = (size_t)16384 * D / 4;
    for (size_t i = (size_t)F.bx * 512 + F.tid; i < n4; i += (size_t)F.G * 512) {
        const f32x4 v = i < np4 ? ((const f32x4*)xp)[i] : ((const f32x4*)xs)[i - np4];
        ((f32x4*)F.X)[i] = v;
        unsigned long long w = (unsigned long long)pk2(v[0], v[1]) | ((unsigned long long)pk2(v[2], v[3]) << 32);
        ((unsigned long long*)XB)[i] = w;
    }
    float* cE = (float*)(F.ws + WS_COSE); float* sE = (float*)(F.ws + WS_SINE); float* cO = (float*)(F.ws + WS_COSO); float* sO = (float*)(F.ws + WS_SINO);
    for (int i = F.bx * 512 + F.tid; i < 16384 * 24; i += F.G * 512) {
        const int pos = i / 24, f = i % 24;
        const float inv16[16] = {1.f, 0.440366596f, 0.193922743f, 0.0853971019f, 0.0376060307f, 0.016560439f, 0.00729266461f, 0.00321144587f, 0.00141421356f, 0.000622772379f, 0.000274248188f, 0.000120769735f, 5.3182961e-05f, 2.34199997e-05f, 1.03133862e-05f, 4.54167048e-06f};
        const int ff = f < 8 ? 2 * f : f - 8;
        float inv = 1.f;
#pragma unroll
        for (int q = 0; q < 16; ++q) inv = (ff == q) ? inv16[q] : inv;
        const float ang = (float)pos * inv; double sn, cs; sincos_d((double)ang, sn, cs);
        if (f < 8) { cE[pos * 8 + f] = (float)cs; sE[pos * 8 + f] = (float)sn; } else { cO[pos * 16 + (f - 8)] = (float)cs; sO[pos * 16 + (f - 8)] = (float)sn; }
    }
}

__device__ __forceinline__ void p_convert_weights(Frame& F, int layer) {
    const int j = layer >> 1; const bool even = !(layer & 1);
    bf16* Wb = (bf16*)(F.ws + WS_W);
    if (even) {
        const float* w_in = F.in[2] + (size_t)j * D * E_PROJ;
        convert_segment(F, w_in, D, E_PROJ, 0, 1280, (bf16*)((unsigned char*)Wb + W_IN), 0);
        convert_segment(F, w_in, D, E_PROJ, 1280, 3072, (bf16*)((unsigned char*)Wb + W_IN) + (size_t)1280 * D, 0);
        convert_segment(F, F.in[15] + (size_t)j * D * D, D, D, 0, D, (bf16*)((unsigned char*)Wb + W_OUT), 0);
    } else {
        convert_segment(F, F.in[16] + (size_t)j * D * O_PROJ, D, O_PROJ, 0, O_PROJ, (bf16*)((unsigned char*)Wb + W_IN), 0);
        convert_segment(F, F.in[17] + (size_t)j * D * D, D, D, 0, D, (bf16*)((unsigned char*)Wb + W_OUT), 0);
    }
    const float* wg = F.in[18] + (size_t)layer * D * DFF; const float* wu = F.in[19] + (size_t)layer * D * DFF;
    bf16* WGU = (bf16*)((unsigned char*)Wb + W_GU);
    {   LAS float* scr = (LAS float*)(F.lds + RING_OFF + F.wave * 16384);
        const int gw = F.bx * NWAVES + F.wave, NGW = F.G * NWAVES;
        const int nit = (D / 64) * (2 * DFF / 32);
        for (int it = gw; it < nit; it += NGW) { const int kb = it / 352, nb = it % 352;
            const int pn = nb >> 3, half = (nb >> 2) & 1, sub = nb & 3;
            transpose_item(half ? wu : wg, D, DFF, 128 * pn + 32 * sub, WGU, 32 * nb, scr, kb, 0, F.lane); }
    }
    convert_segment(F, F.in[20] + (size_t)layer * DFF * D, DFF, D, 0, D, (bf16*)((unsigned char*)Wb + W_DN), 0);
}

__device__ __forceinline__ void taps_tile(Frame& F, int j, int cls, int tile) {
    const int L = cls ? 4096 : 16384; const int i0 = tile * 64;
    LAS float* zf = (LAS float*)(F.lds + RING_OFF);
    LAS float* h1 = zf + 64 * 33;
    LAS float* h2 = h1 + 64 * 65;
    const float* w1 = F.in[6] + (size_t)j * 33 * 64; const float* b1 = F.in[7] + j * 64; const float* f1 = F.in[8] + j * 64;
    const float* w2 = F.in[9] + (size_t)j * 64 * 64; const float* b2 = F.in[10] + j * 64; const float* f2 = F.in[11] + j * 64;
    const float* w3 = F.in[12] + (size_t)j * 64 * 4096; const float* b3 = F.in[13] + (size_t)j * 4096;
    for (int idx = F.tid; idx < 64 * 33; idx += 512) { const int p = idx / 33, f = idx % 33, i = i0 + p; float val;
        if (f == 0) val = (float)i / (float)(L - 1);
        else { const int mm = (f - 1) & 15; const float band = 1e-4f + (float)mm * ((15.0f - 1e-4f) / 15.0f); const float w = 6.283185307179586f * (float)i / (float)L;
            float sn, cs; sincos_f(band * w, sn, cs); val = f <= 16 ? cs : -sn; }
        zf[p * 33 + f] = val; }
    __syncthreads();
    for (int idx = F.tid; idx < 64 * 64; idx += 512) { const int p = idx >> 6, k = idx & 63; float a = b1[k];
        for (int f = 0; f < 33; ++f) a += zf[p * 33 + f] * w1[f * 64 + k];
        h1[p * 65 + k] = sin_f(f1[k] * a); }
    __syncthreads();
    for (int idx = F.tid; idx < 64 * 64; idx += 512) { const int p = idx >> 6, k = idx & 63; float a = b2[k];
        for (int f = 0; f < 64; ++f) a += h1[p * 65 + f] * w2[f * 64 + k];
        h2[p * 65 + k] = sin_f(f2[k] * a); }
    __syncthreads();
    const int i = i0 + F.lane; const float ti = (float)i / (float)(L - 1);
    bf16* TAPS = (bf16*)(F.ws + WS_BIG + (cls ? B_TAP1 : B_TAP0));
    float* PS = (float*)(F.ws + WS_BIG + B_PSUM) + (cls ? (size_t)256 * 4096 : 0) + (size_t)tile * 4096;
    const float dmin = -3.0701134573253943f  , dmax = -15.350567286626973f  ;
    const LAS float* hrow = h2 + F.lane * 65;
#pragma unroll 1
    for (int cb = 0; cb < 512; cb += 4) { const int col = F.wave * 512 + cb;
        asm volatile("" ::: "memory");
        f32x4 a = *(const f32x4*)(b3 + col);
#pragma unroll 8
        for (int k = 0; k < 64; ++k) { const f32x4 wv = *(const f32x4*)(w3 + (size_t)k * 4096 + col); const float hk = hrow[k]; a += wv * hk; }
        const int dir = col >> 11, o = (col >> 10) & 1, ch0 = col & 1023;
#pragma unroll
        for (int e = 0; e < 4; ++e) { const int ch = ch0 + e; const float delta = fabsf(dmin + (dmax - dmin) * ((float)ch / 1023.0f));
            float val = a[e] * __expf(-ti * delta);
            bf16* tp = TAPS + ((size_t)(o * 1024 + ch)) * (2 * L);
            if (dir == 0) tp[L + i] = (bf16)f2bf(val);
            else { if (i >= 1) tp[L - i] = (bf16)f2bf(val); else { tp[0] = 0; val = 0.f; } }
            const float s = wave_sum(fabsf(val));
            if (F.lane == 0) PS[col + e] = s; }
    }
    __syncthreads();
}

__device__ __forceinline__ void p_layernorm(Frame& F, const float* gam, const float* bet) {
    bf16* XB = (bf16*)(F.ws + WS_XB);
    const int gw = F.bx * NWAVES + F.wave, NGW = F.G * NWAVES;
    f32x4 gv[8], bv[8];
#pragma unroll
    for (int q = 0; q < 8; ++q) { gv[q] = ((const f32x4*)gam)[F.lane + 64 * q]; bv[q] = ((const f32x4*)bet)[F.lane + 64 * q]; }
    for (int m = gw; m < M; m += NGW) {
        f32x4* xr = (f32x4*)(F.X + (size_t)m * D) + F.lane;
        f32x4 v[8]; float s = 0.f;
#pragma unroll
        for (int q = 0; q < 8; ++q) { v[q] = xr[64 * q]; s += (v[q][0] + v[q][1]) + (v[q][2] + v[q][3]); }
        const float mean = wave_sum(s) * (1.f / D); float s2 = 0.f;
#pragma unroll
        for (int q = 0; q < 8; ++q) { v[q] = v[q] - mean; s2 += (v[q][0] * v[q][0] + v[q][1] * v[q][1]) + (v[q][2] * v[q][2] + v[q][3] * v[q][3]); }
        const float rstd = 1.f / sqrtf(wave_sum(s2) * (1.f / D) + LN_EPS);
        unsigned long long* o8 = (unsigned long long*)(XB + (size_t)m * D) + F.lane;
#pragma unroll
        for (int q = 0; q < 8; ++q) { const f32x4 y = v[q] * rstd * gv[q] + bv[q]; xr[64 * q] = y;
            o8[64 * q] = (unsigned long long)pk2(y[0], y[1]) | ((unsigned long long)pk2(y[2], y[3]) << 32); }
    }
}

__device__ __forceinline__ void p_attn_even_naive(Frame& F, int j) {
    const bf16* Q = (const bf16*)(F.ws + WS_BIG + B_Q); const bf16* Kb = (const bf16*)(F.ws + WS_BIG + B_K); const bf16* Vb = (const bf16*)(F.ws + WS_BIG + B_V);
    bf16* AO = (bf16*)(F.ws + WS_XB);
    const float* sink = F.in[3] + j * 16;
    const int gw = F.bx * NWAVES + F.wave, NGW = F.G * NWAVES;
    for (int it = gw; it < M * 16; it += NGW) {
        const int tok = it >> 4, h = it & 15, kvh = h >> 3;
        const int sb = pg8::seq_base_of_row(tok), L = sb == 0 ? 16384 : 4096, pos = tok - sb;
        float sc[5]; bool ok[5];
#pragma unroll
        for (int c = 0; c < 5; ++c) sc[c] = 0.f;
        int kr[5];
#pragma unroll
        for (int c = 0; c < 5; ++c) { const int kp = pos - 128 + F.lane + 64 * c; ok[c] = (kp <= pos + 128) && kp >= 0 && kp < L; kr[c] = ok[c] ? sb + kp : tok; }
        for (int t = 0; t < 8; ++t) {
            const v4u qv = *(const v4u*)(Q + (size_t)tok * 1024 + h * 64 + 8 * t);
            float qf[8];
#pragma unroll
            for (int e = 0; e < 4; ++e) { qf[2 * e] = bf2f((unsigned short)(qv[e] & 0xffff)); qf[2 * e + 1] = bf2f((unsigned short)(qv[e] >> 16)); }
#pragma unroll
            for (int c = 0; c < 5; ++c) { const v4u kv = *(const v4u*)(Kb + (size_t)kr[c] * 128 + kvh * 64 + 8 * t);
#pragma unroll
                for (int e = 0; e < 4; ++e) sc[c] += qf[2 * e] * bf2f((unsigned short)(kv[e] & 0xffff)) + qf[2 * e + 1] * bf2f((unsigned short)(kv[e] >> 16)); }
        }
        const float sk = sink[h];
        float mx = sk;
#pragma unroll
        for (int c = 0; c < 5; ++c) { sc[c] = ok[c] ? sc[c] * 0.125f : -INFINITY; mx = fmaxf(mx, sc[c]); }
        mx = wave_max(mx);
        float p[5]; float ps = 0.f;
#pragma unroll
        for (int c = 0; c < 5; ++c) { p[c] = ok[c] ? __expf(sc[c] - mx) : 0.f; ps += p[c]; }
        const float den = wave_sum(ps) + __expf(sk - mx);
        float o = 0.f;
#pragma unroll
        for (int c = 0; c < 5; ++c)
            for (int l = 0; l < 64; ++l) { const float pl = __shfl(p[c], l); const int kp = pos - 128 + l + 64 * c;
                if (pl != 0.f) o += pl * bf2f(Vb[(size_t)(sb + kp) * 128 + kvh * 64 + F.lane]); }
        AO[(size_t)tok * D + h * 64 + F.lane] = (bf16)f2bf(o / den);
    }
}

__device__ __forceinline__ void p_attn_odd_naive(Frame& F) {
    bf16* QKV = (bf16*)(F.ws + WS_BIG); float* LSE = (float*)(F.ws + WS_LSE);
    const int gw = F.bx * NWAVES + F.wave, NGW = F.G * NWAVES;
    for (int it = gw; it < 3 * 16 * M; it += NGW) {
        const int prow = it % M, gh = it / M, g = gh >> 4, h = gh & 15;
        const int sb = pg8::seq_base_of_row(prow), L = sb == 0 ? 16384 : 4096, ls = L >> (2 * g);
        const int pp = prow - sb, rho = pp / ls, idx = pp - rho * ls;
        bf16* Qg = QKV + ((size_t)((0 * 3 + g) * 16 + h) * M) * 128; const bf16* Kg = QKV + ((size_t)((1 * 3 + g) * 16 + h) * M) * 128; const bf16* Vg = QKV + ((size_t)((2 * 3 + g) * 16 + h) * M) * 128;
        float sc[3]; bool ok[3]; int kr[3];
#pragma unroll
        for (int c = 0; c < 3; ++c) { const int ki = idx - 64 + F.lane + 64 * c; ok[c] = (ki <= idx + 64) && ki >= 0 && ki < ls; kr[c] = ok[c] ? sb + rho * ls + ki : prow; sc[c] = 0.f; }
        for (int t = 0; t < 16; ++t) {
            const v4u qv = *(const v4u*)(Qg + (size_t)prow * 128 + 8 * t);
            float qf[8];
#pragma unroll
            for (int e = 0; e < 4; ++e) { qf[2 * e] = bf2f((unsigned short)(qv[e] & 0xffff)); qf[2 * e + 1] = bf2f((unsigned short)(qv[e] >> 16)); }
#pragma unroll
            for (int c = 0; c < 3; ++c) { const v4u kv = *(const v4u*)(Kg + (size_t)kr[c] * 128 + 8 * t);
#pragma unroll
                for (int e = 0; e < 4; ++e) sc[c] += qf[2 * e] * bf2f((unsigned short)(kv[e] & 0xffff)) + qf[2 * e + 1] * bf2f((unsigned short)(kv[e] >> 16)); }
        }
        float mx = -INFINITY;
#pragma unroll
        for (int c = 0; c < 3; ++c) { sc[c] = ok[c] ? sc[c] * 0.08838834764831845f : -INFINITY; mx = fmaxf(mx, sc[c]); }
        mx = wave_max(mx);
        float p[3]; float ps = 0.f;
#pragma unroll
        for (int c = 0; c < 3; ++c) { p[c] = ok[c] ? __expf(sc[c] - mx) : 0.f; ps += p[c]; }
        const float den = wave_sum(ps);
        float o0 = 0.f, o1 = 0.f;
#pragma unroll
        for (int c = 0; c < 3; ++c)
            for (int l = 0; l < 64; ++l) { const float pl = __shfl(p[c], l); const int ki = idx - 64 + l + 64 * c;
                if (pl != 0.f) { const unsigned vv = *(const unsigned*)(Vg + (size_t)(sb + rho * ls + ki) * 128 + 2 * F.lane); o0 += pl * bf2f((unsigned short)(vv & 0xffff)); o1 += pl * bf2f((unsigned short)(vv >> 16)); } }
        const float inv = 1.f / den;
        *(unsigned*)(Qg + (size_t)prow * 128 + 2 * F.lane) = pk2(o0 * inv, o1 * inv);
        if (F.lane == 0) LSE[((size_t)g * M + prow) * 16 + h] = mx + __logf(den);
    }
}

__device__ __forceinline__ void p_combine_odd(Frame& F) {
    const bf16* QKV = (const bf16*)(F.ws + WS_BIG); const float* LSE = (const float*)(F.ws + WS_LSE); bf16* AO = (bf16*)(F.ws + WS_XB);
    for (int it = F.bx * 512 + F.tid; it < M * 256; it += F.G * 512) {
        const int tok = it >> 8, h = (it >> 4) & 15, ck = it & 15;
        const int sb = pg8::seq_base_of_row(tok), L = sb == 0 ? 16384 : 4096, pos = tok - sb;
        float l[3]; int pr[3];
#pragma unroll
        for (int g = 0; g < 3; ++g) { const int dsh = 2 * g; pr[g] = sb + (pos & ((1 << dsh) - 1)) * (L >> dsh) + (pos >> dsh); l[g] = LSE[((size_t)g * M + pr[g]) * 16 + h]; }
        const float mx = fmaxf(l[0], fmaxf(l[1], l[2]));
        float w[3]; float ws = 0.f;
#pragma unroll
        for (int g = 0; g < 3; ++g) { w[g] = __expf(l[g] - mx); ws += w[g]; }
        const float inv = 1.f / ws;
        float acc[8];
#pragma unroll
        for (int e = 0; e < 8; ++e) acc[e] = 0.f;
#pragma unroll
        for (int g = 0; g < 3; ++g) { const v4u ov = *(const v4u*)(QKV + ((size_t)(g * 16 + h) * M + pr[g]) * 128 + 8 * ck); const float wg = w[g] * inv;
#pragma unroll
            for (int e = 0; e < 4; ++e) { acc[2 * e] += wg * bf2f((unsigned short)(ov[e] & 0xffff)); acc[2 * e + 1] += wg * bf2f((unsigned short)(ov[e] >> 16)); } }
        v4u o; o.x = pk2(acc[0], acc[1]); o.y = pk2(acc[2], acc[3]); o.z = pk2(acc[4], acc[5]); o.w = pk2(acc[6], acc[7]);
        *(v4u*)(AO + (size_t)tok * D + h * 128 + 8 * ck) = o;
    }
}

template <int L> __device__ __forceinline__ void hyena_unit_naive(Frame& F, int j, int s, int ch) {
    constexpr int NQ = L / 512, cls = (L == 4096) ? 1 : 0, NT = L / 64;
    const int sb = seq_base(s);
    LAS bf16* tp = (LAS bf16*)(F.lds + RING_OFF); LAS bf16* vb = tp + 2 * L; LAS bf16* zb = vb + L;
    LAS float* red = (LAS float*)(F.lds + LDSCTL_OFF + 64);
    const bf16* HYT = (const bf16*)(F.ws + WS_BIG + B_HYT); bf16* ZT = (bf16*)(F.ws + WS_BIG + B_ZT);
    const bf16* TAPS = (const bf16*)(F.ws + WS_BIG + (cls ? B_TAP1 : B_TAP0));
    const float* PS = (const float*)(F.ws + WS_BIG + B_PSUM) + (cls ? (size_t)256 * 4096 : 0);
    const float* cw = F.in[4] + (size_t)j * 3 * 3072; const float* cb = F.in[5] + (size_t)j * 3072; const float* hb = F.in[14] + (size_t)j * 2 * 1024;
    if (F.wave < 2) { const int o = F.wave; float a = 0.f;
        for (int t = F.lane; t < NT; t += 64) a += PS[(size_t)t * 4096 + (0 * 2 + o) * 1024 + ch] + PS[(size_t)t * 4096 + (1 * 2 + o) * 1024 + ch];
        a = wave_sum(a); if (F.lane == 0) red[o] = a; }
    { const bf16* hr = HYT + (size_t)ch * M + sb; const float w0 = cw[0 * 3072 + ch], w1 = cw[1 * 3072 + ch], w2 = cw[2 * 3072 + ch], b = cb[ch];
      for (int i = F.tid; i < L; i += 512) { const float xm = i > 0 ? bf2f(hr[i - 1]) : 0.f, x0 = bf2f(hr[i]), xp = i < L - 1 ? bf2f(hr[i + 1]) : 0.f; vb[i] = (bf16)f2bf(b + w0 * xm + w1 * x0 + w2 * xp); } }
    __syncthreads();
#pragma unroll 1
    for (int o = 0; o < 2; ++o) {
        const bf16* tg = TAPS + (size_t)(o * 1024 + ch) * (2 * L);
        for (int i = F.tid; i < 2 * L / 8; i += 512) ((LAS v4u*)tp)[i] = ((const v4u*)tg)[i];
        __syncthreads();
        const LAS bf16* src = o == 0 ? vb : zb;
        float acc[NQ];
#pragma unroll
        for (int q = 0; q < NQ; ++q) acc[q] = 0.f;
        for (int jj = 0; jj < L; ++jj) { const float uj = bf2f(src[jj]); const LAS bf16* tq = tp + (L + F.tid - jj);
#pragma unroll
            for (int q = 0; q < NQ; ++q) acc[q] += bf2f(tq[512 * q]) * uj; }
        const float invS = 1.f / red[o]; const float bias = hb[o * 1024 + ch];
        const int gch = (o == 0 ? 1024 : 2048) + ch;
        const bf16* hr = HYT + (size_t)gch * M + sb; const float w0 = cw[0 * 3072 + gch], w1 = cw[1 * 3072 + gch], w2 = cw[2 * 3072 + gch], b = cb[gch];
#pragma unroll
        for (int q = 0; q < NQ; ++q) { const int i = 512 * q + F.tid;
            const float xm = i > 0 ? bf2f(hr[i - 1]) : 0.f, x0 = bf2f(hr[i]), xp = i < L - 1 ? bf2f(hr[i + 1]) : 0.f; const float xg = b + w0 * xm + w1 * x0 + w2 * xp;
            const float y = acc[q] * invS + bias * bf2f(src[i]); const float z = xg * y;
            if (o == 0) zb[i] = (bf16)f2bf(z); else ZT[(size_t)ch * M + sb + i] = (bf16)f2bf(z); }
        __syncthreads();
    }
}

__device__ __forceinline__ void p_zt_transpose(Frame& F) {
    const bf16* ZT = (const bf16*)(F.ws + WS_BIG + B_ZT); bf16* AO = (bf16*)(F.ws + WS_XB);
    for (int it = F.bx * 512 + F.tid; it < M * 128; it += F.G * 512) {
        const int tok = it % M, cg = it / M;
        unsigned short v[8];
#pragma unroll
        for (int e = 0; e < 8; ++e) v[e] = ZT[(size_t)(cg * 8 + e) * M + tok];
        v4u o; o.x = v[0] | ((unsigned)v[1] << 16); o.y = v[2] | ((unsigned)v[3] << 16); o.z = v[4] | ((unsigned)v[5] << 16); o.w = v[6] | ((unsigned)v[7] << 16);
        *(v4u*)(AO + (size_t)tok * D + 1024 + cg * 8) = o;
    }
}

#ifndef MK_MASK
#define MK_MASK 0xFFFFF
#endif
#define HAS(b) ((MK_MASK >> (b)) & 1)
struct Args { const float* in[25]; float* out; unsigned char* ws; int ph_lo, ph_hi; };
__global__ void __launch_bounds__(NWAVES * 64, 2) mk_fwd(Args args) {
    extern __shared__ __attribute__((aligned(16))) unsigned char lds[];
    Frame F;
    F.lds = (LAS unsigned char*)lds;
    F.MISC = (volatile LAS unsigned*)(F.lds + MISC_OFF);
    F.tid = threadIdx.x; F.lane = F.tid & 63; F.wave = __builtin_amdgcn_readfirstlane(F.tid >> 6);
    F.G = gridDim.x; F.bx = blockIdx.x;
    F.ws = args.ws; F.ctl = (gu32*)(args.ws + WS_CTL); F.X = args.out;
    for (int u = F.tid; u < (LDS_BYTES - LDSCTL_OFF) / 4; u += NWAVES * 64) ((LAS unsigned*)(F.lds + LDSCTL_OFF))[u] = 0u;
    __syncthreads();
    const int lo = args.ph_lo, hi = args.ph_hi;
    XcdBarrier bar; bar.bar = (unsigned*)(F.ctl + CW_BAR); bar.x = 0; bar.st = nullptr;
    if (hi - lo > 1) bar = xcd_barrier_post((unsigned*)(F.ctl + CW_BAR), F.MISC + 8);
#define IN(k) (lo <= (k) && (k) < hi)
#define SEAM(k) do { if ((k) + 1 < hi) xcd_barrier(bar); } while (0)
#define XB ((bf16*)(F.ws + WS_XB))
#define Wb ((bf16*)(F.ws + WS_W))
#define BIG (F.ws + WS_BIG)

    if (HAS(0) && IN(0)) p_input(F);
    for (int layer = 0; layer < DEPTH; ++layer) {
        const int pb = layer * PH_PER_LAYER; const bool even = !(layer & 1); const int j = layer >> 1;
#define FRESH() do { int l_; asm volatile("v_mbcnt_lo_u32_b32 %0, -1, 0\n\tv_mbcnt_hi_u32_b32 %0, -1, %0" : "=v"(l_)); int bx_ = blockIdx.x; asm volatile("" : "+s"(bx_)); F.bx = bx_; F.lane = l_; F.tid = F.wave * 64 + l_; unsigned char* w_ = args.ws; float* x_ = args.out; asm volatile("" : "+s"(w_), "+s"(x_)); F.ws = w_; F.X = x_; } while (0)
        if (HAS(0) && IN(pb + 0)) { FRESH();
            p_convert_weights(F, layer);
            __syncthreads();
            if (even) { for (int t = F.bx; t < 320; t += F.G) { if (t < 256) taps_tile(F, j, 0, t); else taps_tile(F, j, 1, t - 256); } }
            SEAM(pb + 0);
        }
        if (HAS(1) && IN(pb + 1)) { FRESH();
            if (HAS(9) && even) {
                { pg8::Gemm g{XB, (const bf16*)((unsigned char*)Wb + W_IN), M, 1280, D}; pg8::StaticOrder S; S.init(M, 1280, F.G, F.bx);
                  pg8::EpiEvenQKV E{(bf16*)(BIG + B_Q), (bf16*)(BIG + B_K), (bf16*)(BIG + B_V), (const float*)(F.ws + WS_COSE), (const float*)(F.ws + WS_SINE)};
                  pg8::gemm_phase<pg8::EpiEvenQKV, pg8::StaticOrder, true, true>(F.lds + RING_OFF, g, S, E, F.wave); }
                { pg8::Gemm g{(const bf16*)((unsigned char*)Wb + W_IN) + (size_t)1280 * D, XB, 3072, M, D}; pg8::StaticOrder S; S.init(3072, M, F.G, (int)(((unsigned)F.bx + 128u) % (unsigned)F.G));
                  pg8::EpiPlainBf16 E{(bf16*)(BIG + B_HYT), M};
                  pg8::gemm_phase<pg8::EpiPlainBf16, pg8::StaticOrder, true, true>(F.lds + RING_OFF, g, S, E, F.wave); }
            } else if (HAS(10)) {
                pg8::Gemm g{XB, (const bf16*)((unsigned char*)Wb + W_IN), M, O_PROJ, D}; pg8::StaticOrder S; S.init(M, O_PROJ, F.G, F.bx);
                pg8::EpiOddQKV E{(bf16*)BIG, (const float*)(F.ws + WS_COSO), (const float*)(F.ws + WS_SINO), M};
                pg8::gemm_phase<pg8::EpiOddQKV, pg8::StaticOrder, true, true>(F.lds + RING_OFF, g, S, E, F.wave);
            }
            SEAM(pb + 1);
        }
        if (HAS(2) && IN(pb + 2)) { FRESH();
            if (even) {
                for (int u = F.bx; u < 3072; u += F.G) { if (u < 1024) hyena_unit_naive<16384>(F, j, 0, u); else hyena_unit_naive<4096>(F, j, 1 + ((u - 1024) >> 10), (u - 1024) & 1023); }
                p_attn_even_naive(F, j);
            } else p_attn_odd_naive(F);
            SEAM(pb + 2);
        }
        if (HAS(3) && IN(pb + 3)) { FRESH();
            if (even) p_zt_transpose(F); else p_combine_odd(F);
            SEAM(pb + 3);
        }
        if (HAS(4) && IN(pb + 4)) { FRESH();
            pg8::Gemm g{XB, (const bf16*)((unsigned char*)Wb + W_OUT), M, D, D}; pg8::StaticOrder S; S.init(M, D, F.G, F.bx);
            pg8::EpiResid E{F.X, D, ALPHA};
            pg8::gemm_phase<pg8::EpiResid, pg8::StaticOrder, true, true>(F.lds + RING_OFF, g, S, E, F.wave);
            SEAM(pb + 4);
        }
        if (HAS(5) && IN(pb + 5)) { FRESH(); p_layernorm(F, F.in[21] + (size_t)layer * D, F.in[22] + (size_t)layer * D); SEAM(pb + 5); }
        if (HAS(6) && IN(pb + 6)) { FRESH();
            pg8::Gemm g{XB, (const bf16*)((unsigned char*)Wb + W_GU), M, 2 * DFF, D}; pg8::StaticOrder S; S.init(M, 2 * DFF, F.G, F.bx);
            pg8::EpiSwiGLU E{(bf16*)BIG, DFF};
            pg8::gemm_phase<pg8::EpiSwiGLU, pg8::StaticOrder, true, true>(F.lds + RING_OFF, g, S, E, F.wave);
            SEAM(pb + 6);
        }
        if (HAS(7) && IN(pb + 7)) { FRESH();
            pg8::Gemm g{(const bf16*)BIG, (const bf16*)((unsigned char*)Wb + W_DN), M, D, DFF}; pg8::StaticOrder S; S.init(M, D, F.G, F.bx);
            pg8::EpiResid E{F.X, D, ALPHA};
            pg8::gemm_phase<pg8::EpiResid, pg8::StaticOrder, true, true>(F.lds + RING_OFF, g, S, E, F.wave);
            SEAM(pb + 7);
        }
        if (HAS(8) && IN(pb + 8)) { FRESH(); p_layernorm(F, F.in[23] + (size_t)layer * D, F.in[24] + (size_t)layer * D); SEAM(pb + 8); }
    }
#undef IN
#undef SEAM
#undef FRESH
#undef XB
#undef Wb
#undef BIG
}

#ifndef MK_ONE_LAUNCH
#define MK_ONE_LAUNCH 1
#endif
extern "C" void kernel_launch(void* const* d_in, const int* in_sizes, int n_in, void* d_out, int out_size, void* d_ws, size_t ws_size, hipStream_t stream) {
    static int grid = 0;
    if (grid == 0) {
        if (n_in != 25 || out_size != M * D || ws_size < WS_END) { fprintf(stderr, "kernel_launch: unexpected shapes (n_in %d, out %d, ws %zu < %zu)\n", n_in, out_size, ws_size, (size_t)WS_END); grid = -1; return; }
        int dev = 0, cus = 0, per_cu = 0;
        if (hipGetDevice(&dev) != hipSuccess || hipDeviceGetAttribute(&cus, hipDeviceAttributeMultiprocessorCount, dev) != hipSuccess) { grid = -1; return; }
        if (hipFuncSetAttribute((const void*)mk_fwd, hipFuncAttributeMaxDynamicSharedMemorySize, LDS_BYTES) != hipSuccess) { fprintf(stderr, "kernel_launch: hipFuncSetAttribute failed\n"); grid = -1; return; }
        if (hipOccupancyMaxActiveBlocksPerMultiprocessor(&per_cu, (const void*)mk_fwd, NWAVES * 64, LDS_BYTES) != hipSuccess || per_cu < 1) { fprintf(stderr, "kernel_launch: occupancy query says %d\n", per_cu); }
        (void)hipGetLastError();
        grid = cus;
    }
    if (grid < 0) return;
    (void)hipMemsetAsync((char*)d_ws + WS_CTL, 0, CTL_ZERO_BYTES, stream);
    Args a{};
    for (int i = 0; i < 25; ++i) a.in[i] = (const float*)d_in[i];
    a.out = (float*)d_out; a.ws = (unsigned char*)d_ws;
#if MK_ONE_LAUNCH
    a.ph_lo = 0; a.ph_hi = NPHASE;
    hipLaunchKernelGGL(mk_fwd, dim3(grid), dim3(NWAVES * 64), LDS_BYTES, stream, a);
#else
    for (int ph = 0; ph < NPHASE; ++ph) { a.ph_lo = ph; a.ph_hi = ph + 1; hipLaunchKernelGGL(mk_fwd, dim3(grid), dim3(NWAVES * 64), LDS_BYTES, stream, a); }
#endif
}
```

```cpp
#include <hip/hip_runtime.h>
#include <cstdio>
#include <cstdint>
#include <cmath>
namespace pg8 {
#define PG8_LAS __attribute__((address_space(3)))
typedef unsigned short bf16_t;
typedef short bf16x8 __attribute__((ext_vector_type(8)));
typedef float f32x4 __attribute__((ext_vector_type(4)));
typedef unsigned u32x4 __attribute__((ext_vector_type(4)));
constexpr int BM = 256, BK = 64, HALF = 128, HTB = HALF * BK * 2  , STAGE_BYTES = 8 * HTB, NXCD = 8, WGM = 8;

__host__ __device__ __forceinline__ int lds_byte(int r, int c) { const int st = (r >> 4) * 2 + (c >> 5), rr = r & 15, cc = c & 31, ob = rr * 64 + cc * 2; return st * 1024 + (ob ^ (((ob >> 9) & 1) << 5)); }
__host__ __device__ __forceinline__ void stage_rc(int b, int& R, int& C) { const int st = b / 1024, sb = b % 1024, swz = sb ^ (((sb >> 9) & 1) << 5); R = (st >> 1) * 16 + swz / 64; C = (st & 1) * 32 + (swz % 64) / 2; }
__host__ __device__ __forceinline__ int perm32(int rho) { const int n = rho >> 4, i = rho & 15; return 8 * (i >> 2) + 4 * n + (i & 3); }

struct Unit { int pm, pn; };
struct Gemm { const bf16_t* A; const bf16_t* Bt; int M, N, K; };

struct StaticOrder {
    int nM, nN, nwg, G, c;
    __host__ __device__ void init(int M, int N, int G_, int c_) { nM = M / BM; nN = N / BM; nwg = nM * nN; G = G_; c = c_; }
    __host__ __device__ bool next(int i, Unit& u) const {
        const long L = (long)i * G + c; if (L >= nwg) return false;
        int wgid = (int)L; { const int q = nwg / NXCD, r = nwg % NXCD, xcd = wgid % NXCD, off = wgid / NXCD; wgid = (xcd < r ? xcd * (q + 1) : r * (q + 1) + (xcd - r) * q) + off; }
        const int nig = WGM * nN, gid = wgid / nig, fm = gid * WGM, gsz = (nM - fm) < WGM ? (nM - fm) : WGM;
        u.pm = fm + ((wgid % nig) % gsz); u.pn = (wgid % nig) / gsz; return true;
    }
    __device__ __forceinline__ void a_ready(const Unit&) const {}
    __device__ __forceinline__ void done(const Unit&) const {}
};

__device__ __forceinline__ unsigned cvt_pk_bf16(float lo, float hi) { unsigned r; asm volatile("v_cvt_pk_bf16_f32 %0, %1, %2" : "=v"(r) : "v"(lo), "v"(hi)); return r; }
__device__ __forceinline__ u32x4 pack8(const f32x4& v0, const f32x4& v1) { u32x4 w; w.x = cvt_pk_bf16(v0[0], v0[1]); w.y = cvt_pk_bf16(v0[2], v0[3]); w.z = cvt_pk_bf16(v1[0], v1[1]); w.w = cvt_pk_bf16(v1[2], v1[3]); return w; }
__device__ __forceinline__ f32x4 shfl_xor4(const f32x4& v, int m) { f32x4 r; r[0] = __shfl_xor(v[0], m); r[1] = __shfl_xor(v[1], m); r[2] = __shfl_xor(v[2], m); r[3] = __shfl_xor(v[3], m); return r; }
__device__ __forceinline__ int seq_base_of_row(int row) { return row < 16384 ? 0 : (row < 20480 ? 16384 : 20480); }

struct EpiPlainBf16 {
    static constexpr bool PERM = true, AFTER_DRAIN = false;
    bf16_t* O; int ldc;
    __device__ __forceinline__ void operator()(const f32x4 (&acc)[2][2][4][2], const Unit& u, int wr, int wc, int fr_, int fq_) const {
        int fr = fr_, fq = fq_; asm volatile("" : "+v"(fr), "+v"(fq));
        const int row0 = u.pm * BM + wr * 64 + fr, col0 = u.pn * BM + wc * 32 + 8 * fq;
#pragma unroll
        for (int ai = 0; ai < 2; ++ai)
#pragma unroll
            for (int m = 0; m < 4; ++m) { bf16_t* rowp = O + (size_t)(row0 + ai * HALF + m * 16) * ldc + col0;
#pragma unroll
                for (int bj = 0; bj < 2; ++bj) *(u32x4*)(rowp + bj * HALF) = pack8(acc[ai][bj][m][0], acc[ai][bj][m][1]); }
    }
};

struct EpiEvenQKV {
    static constexpr bool PERM = true, AFTER_DRAIN = false;
    bf16_t* Q; bf16_t* Kb; bf16_t* Vb; const float* cosT; const float* sinT;
    __device__ __forceinline__ void operator()(const f32x4 (&acc)[2][2][4][2], const Unit& u, int wr, int wc, int fr_, int fq_) const {
        int fr = fr_, fq = fq_; asm volatile("" : "+v"(fr), "+v"(fq));
        const int row0 = u.pm * BM + wr * 64 + fr; const int sbase = seq_base_of_row(u.pm * BM);
        const bool ropew = ((wc & 1) == 0);
        const float sgn = (fq & 1) ? 1.f : -1.f;
#pragma unroll
        for (int ai = 0; ai < 2; ++ai)
#pragma unroll
            for (int m = 0; m < 4; ++m) { const int row = row0 + ai * HALF + m * 16; const int pos = row - sbase;
                f32x4 c0 = {1.f, 1.f, 1.f, 1.f}, c1 = c0, s0 = {0.f, 0.f, 0.f, 0.f}, s1 = s0;
                if (ropew && fq < 2) { c0 = *(const f32x4*)(cosT + (size_t)pos * 8); c1 = *(const f32x4*)(cosT + (size_t)pos * 8 + 4); s0 = *(const f32x4*)(sinT + (size_t)pos * 8); s1 = *(const f32x4*)(sinT + (size_t)pos * 8 + 4); }
#pragma unroll
                for (int bj = 0; bj < 2; ++bj) { f32x4 v0 = acc[ai][bj][m][0], v1 = acc[ai][bj][m][1];
                    const bool is_v = (u.pn == 4 && bj == 1);
                    if (ropew && !is_v) { const f32x4 p0 = shfl_xor4(v0, 16), p1 = shfl_xor4(v1, 16);
                        v0 = v0 * c0 + (p0 * s0) * sgn; v1 = v1 * c1 + (p1 * s1) * sgn; }
                    bf16_t* dst;
                    if (u.pn < 4) dst = Q + (size_t)row * 1024 + u.pn * 256 + bj * HALF + wc * 32 + 8 * fq;
                    else dst = (bj == 0 ? Kb : Vb) + (size_t)row * 128 + wc * 32 + 8 * fq;
                    *(u32x4*)dst = pack8(v0, v1); }
                asm volatile("" ::: "memory"); }
    }
};

struct EpiOddQKV {
    static constexpr bool PERM = true, AFTER_DRAIN = false;
    bf16_t* O; const float* cosT; const float* sinT; int Mtot;
    __device__ __forceinline__ void operator()(const f32x4 (&acc)[2][2][4][2], const Unit& u, int wr, int wc, int fr_, int fq_) const {
        int fr = fr_, fq = fq_; asm volatile("" : "+v"(fr), "+v"(fq));
        const int row0 = u.pm * BM + wr * 64 + fr; const int sbase = seq_base_of_row(u.pm * BM); const int L = sbase == 0 ? 16384 : 4096;
        const int sg = u.pn >> 3, s = sg / 3, g = sg - 3 * s; const int dsh = 2 * g;
        const int ls = L >> dsh;
        const bool ropew = (wc == 0) && (s < 2);
        const float sgn = (fq & 2) ? 1.f : -1.f;
        const int tb = (fq & 1) * 8;
#pragma unroll
        for (int ai = 0; ai < 2; ++ai)
#pragma unroll
            for (int m = 0; m < 4; ++m) { const int row = row0 + ai * HALF + m * 16; const int pos = row - sbase;
                const int prow = sbase + (pos & ((1 << dsh) - 1)) * ls + (pos >> dsh);
                f32x4 c0 = {1.f, 1.f, 1.f, 1.f}, c1 = c0, s0 = {0.f, 0.f, 0.f, 0.f}, s1 = s0;
                if (ropew) { const float* cp = cosT + (size_t)pos * 16 + tb; const float* sp = sinT + (size_t)pos * 16 + tb; c0 = *(const f32x4*)cp; c1 = *(const f32x4*)(cp + 4); s0 = *(const f32x4*)sp; s1 = *(const f32x4*)(sp + 4); }
#pragma unroll
                for (int bj = 0; bj < 2; ++bj) { f32x4 v0 = acc[ai][bj][m][0], v1 = acc[ai][bj][m][1];
                    if (ropew) { const f32x4 p0 = shfl_xor4(v0, 32), p1 = shfl_xor4(v1, 32);
                        v0 = v0 * c0 + (p0 * s0) * sgn; v1 = v1 * c1 + (p1 * s1) * sgn; }
                    const int head = 2 * (u.pn & 7) + bj;
                    bf16_t* dst = O + ((size_t)(sg * 16 + head) * Mtot + prow) * 128 + wc * 32 + 8 * fq;
                    *(u32x4*)dst = pack8(v0, v1); }
                asm volatile("" ::: "memory"); }
    }
};

struct EpiResid {
    static constexpr bool PERM = false, AFTER_DRAIN = false;
    float* X; int ldc; float alpha;
    __device__ __forceinline__ void operator()(const f32x4 (&acc)[2][2][4][2], const Unit& u, int wr, int wc, int fr_, int fq_) const {
        int fr = fr_, fq = fq_; asm volatile("" : "+v"(fr), "+v"(fq));
        const int row0 = u.pm * BM + wr * 64 + fr, col0 = u.pn * BM + wc * 32 + 4 * fq;
#pragma unroll
        for (int ai = 0; ai < 2; ++ai)
#pragma unroll
            for (int m = 0; m < 4; ++m) { float* rowp = X + (size_t)(row0 + ai * HALF + m * 16) * ldc + col0;
#pragma unroll
                for (int bj = 0; bj < 2; ++bj)
#pragma unroll
                    for (int n = 0; n < 2; ++n) { f32x4* p = (f32x4*)(rowp + bj * HALF + n * 16); const f32x4 x = *p; *p = x * alpha + acc[ai][bj][m][n]; }
                if (m & 1) asm volatile("" ::: "memory"); }
    }
};

struct EpiSwiGLU {
    static constexpr bool PERM = true, AFTER_DRAIN = false;
    bf16_t* H; int ldh;
    static __device__ __forceinline__ float silu_mul(float g, float up) { const float e = __builtin_amdgcn_exp2f(g * -1.4426950408889634f); return g * __builtin_amdgcn_rcpf(1.0f + e) * up; }
    __device__ __forceinline__ void operator()(const f32x4 (&acc)[2][2][4][2], const Unit& u, int wr, int wc, int fr_, int fq_) const {
        int fr = fr_, fq = fq_; asm volatile("" : "+v"(fr), "+v"(fq));
        const int row0 = u.pm * BM + wr * 64 + fr, col0 = u.pn * HALF + wc * 32 + 8 * fq;
#pragma unroll
        for (int ai = 0; ai < 2; ++ai)
#pragma unroll
            for (int m = 0; m < 4; ++m) { bf16_t* dst = H + (size_t)(row0 + ai * HALF + m * 16) * ldh + col0;
                f32x4 h0, h1;
#pragma unroll
                for (int e = 0; e < 4; ++e) { h0[e] = silu_mul(acc[ai][0][m][0][e], acc[ai][1][m][0][e]); h1[e] = silu_mul(acc[ai][0][m][1][e], acc[ai][1][m][1][e]); }
                *(u32x4*)dst = pack8(h0, h1); }
    }
};

template <class Epi, class Sched, bool ALIGN_EPI = false, bool SP2 = false>
__device__ __forceinline__ void gemm_phase(PG8_LAS unsigned char* lds, const Gemm g, const Sched& S, const Epi& E, const int wave_id) {
    int tid_; asm volatile("v_mbcnt_lo_u32_b32 %0, -1, 0\n\tv_mbcnt_hi_u32_b32 %0, -1, %0" : "=v"(tid_)); tid_ += wave_id * 64;
    const int tid = tid_, wid = __builtin_amdgcn_readfirstlane(tid >> 6), lane = tid & 63, wr = wid >> 2, wc = wid & 3, fr = lane & 15, fq = lane >> 4;
    const int K = g.K, nt = K / BK;
    unsigned voffA[2], voffB[2];
#pragma unroll
    for (int i = 0; i < 2; ++i) { int R, C; stage_rc(tid * 16 + i * 8192, R, C); const int Rb = Epi::PERM ? ((R & ~31) + perm32(R & 31)) : R;
        voffA[i] = (unsigned)(R * K + C) * 2u; voffB[i] = (unsigned)(Rb * K + C) * 2u; }
    const size_t kstep = (size_t)(BK * 2);
    const size_t hstep = (size_t)HALF * K * 2;
    const size_t tstep = 2 * hstep;
    const unsigned ldsw = (unsigned)wid * 1024u;
    const int aoff = lds_byte(wr * 64 + fr, fq * 8), boff = lds_byte(wc * 32 + fr, fq * 8);
#define PG8_SA(b, h) (((b) * 2 + (h)) * HTB)
#define PG8_SB(b, h) ((4 + (b) * 2 + (h)) * HTB)
#define PG8_STAGE(bufoff, gbase, voff) do { _Pragma("unroll") for (int _i = 0; _i < 2; ++_i) \
        __builtin_amdgcn_global_load_lds((const unsigned*)((const char*)(gbase) + (voff)[_i]), (PG8_LAS unsigned*)(lds + (bufoff) + ldsw + _i * 8192), 16, 0, 0); } while (0)
#define PG8_LDA(dst, b, h) do { _Pragma("unroll") for (int m = 0; m < 4; ++m) _Pragma("unroll") for (int k = 0; k < 2; ++k) dst[m][k] = *(const PG8_LAS bf16x8*)(lds + PG8_SA(b, h) + aoff + m * 2048 + k * 1024); } while (0)
#define PG8_LDB(dst, b, h) do { _Pragma("unroll") for (int n = 0; n < 2; ++n) _Pragma("unroll") for (int k = 0; k < 2; ++k) dst[n][k] = *(const PG8_LAS bf16x8*)(lds + PG8_SB(b, h) + boff + n * 2048 + k * 1024); } while (0)
#define PG8_MMA(ai, bj, At, Bt) do { __builtin_amdgcn_s_setprio(1); _Pragma("unroll") for (int m = 0; m < 4; ++m) _Pragma("unroll") for (int n = 0; n < 2; ++n) _Pragma("unroll") for (int k = 0; k < 2; ++k) \
        acc[ai][bj][m][n] = __builtin_amdgcn_mfma_f32_16x16x32_bf16(Bt[n][k], At[m][k], acc[ai][bj][m][n], 0, 0, 0); __builtin_amdgcn_s_setprio(0); } while (0)
#define PG8_WAIT_V(n) asm volatile("s_waitcnt vmcnt(" #n ")" ::: "memory")
#define PG8_WAIT_L(n) asm volatile("s_waitcnt lgkmcnt(" #n ")" ::: "memory")
#define PG8_BAR __builtin_amdgcn_s_barrier()
#define PG8_SCHED __builtin_amdgcn_sched_barrier(0)
    Unit cur, nxt; int ui = 0;
    if (!S.next(0, cur)) return;
    f32x4 acc[2][2][4][2];
#pragma unroll
    for (int a = 0; a < 2; ++a)
#pragma unroll
        for (int b = 0; b < 2; ++b)
#pragma unroll
            for (int m = 0; m < 4; ++m)
#pragma unroll
                for (int n = 0; n < 2; ++n) acc[a][b][m][n] = (f32x4){0.f, 0.f, 0.f, 0.f};
    bf16x8 At[4][2], B0[2][2], B1[2][2];
    const char* cA = (const char*)g.A + (size_t)cur.pm * tstep; const char* cB = (const char*)g.Bt + (size_t)cur.pn * tstep;
    S.a_ready(cur);
    if constexpr (SP2) {
        PG8_STAGE(PG8_SB(0, 0), cB, voffB); PG8_STAGE(PG8_SB(0, 1), cB + hstep, voffB); PG8_STAGE(PG8_SA(0, 0), cA, voffA); PG8_STAGE(PG8_SA(0, 1), cA + hstep, voffA);
        if (wr == 1) PG8_BAR;
        PG8_WAIT_V(2); PG8_BAR;
        PG8_STAGE(PG8_SB(1, 0), cB + kstep, voffB); PG8_STAGE(PG8_SA(1, 0), cA + kstep, voffA); PG8_STAGE(PG8_SB(1, 1), cB + hstep + kstep, voffB);
        PG8_WAIT_V(6); PG8_BAR;
    } else {
        PG8_STAGE(PG8_SB(0, 0), cB, voffB); PG8_STAGE(PG8_SA(0, 0), cA, voffA); PG8_STAGE(PG8_SB(0, 1), cB + hstep, voffB); PG8_STAGE(PG8_SA(0, 1), cA + hstep, voffA);
        if (wr == 1) PG8_BAR;
        PG8_WAIT_V(4); PG8_BAR;
        PG8_STAGE(PG8_SB(1, 0), cB + kstep, voffB); PG8_STAGE(PG8_SA(1, 0), cA + kstep, voffA); PG8_STAGE(PG8_SB(1, 1), cB + hstep + kstep, voffB);
        PG8_WAIT_V(6); PG8_BAR;
    }
    for (;;) {
        const bool has_next = S.next(ui + 1, nxt);
        const char* nA = has_next ? (const char*)g.A + (size_t)nxt.pm * tstep : cA; const char* nB = has_next ? (const char*)g.Bt + (size_t)nxt.pn * tstep : cB;
        for (int t = 0; t < nt; t += 2) {
            const bool last = (t == nt - 2);
            const char* a1 = cA + (size_t)(t + 1) * kstep;
            const char* a2 = last ? nA : cA + (size_t)(t + 2) * kstep; const char* b2 = last ? nB : cB + (size_t)(t + 2) * kstep;
            const char* a3 = a2 + kstep; const char* b3 = b2 + kstep;
            if (last && has_next) S.a_ready(nxt);
            if constexpr (SP2) {
            PG8_LDB(B0, 0, 0); PG8_LDB(B1, 0, 1); PG8_SCHED; PG8_LDA(At, 0, 0); PG8_STAGE(PG8_SA(1, 1), a1 + hstep, voffA);
            PG8_WAIT_V(8); PG8_WAIT_L(0); PG8_BAR; PG8_MMA(0, 0, At, B0); PG8_MMA(0, 1, At, B1); PG8_BAR; PG8_SCHED;
            PG8_LDA(At, 0, 1); PG8_STAGE(PG8_SB(0, 0), b2, voffB); PG8_STAGE(PG8_SB(0, 1), b2 + hstep, voffB); PG8_STAGE(PG8_SA(0, 0), a2, voffA);
            PG8_WAIT_V(8); PG8_WAIT_L(0); PG8_BAR; PG8_MMA(1, 0, At, B0); PG8_MMA(1, 1, At, B1); PG8_BAR; PG8_SCHED;
            PG8_LDB(B0, 1, 0); PG8_LDB(B1, 1, 1); PG8_SCHED; PG8_LDA(At, 1, 0); PG8_STAGE(PG8_SA(0, 1), a2 + hstep, voffA);
            PG8_WAIT_V(8); PG8_WAIT_L(0); PG8_BAR; PG8_MMA(0, 0, At, B0); PG8_MMA(0, 1, At, B1); PG8_BAR; PG8_SCHED;
            PG8_LDA(At, 1, 1); PG8_STAGE(PG8_SB(1, 0), b3, voffB); PG8_STAGE(PG8_SB(1, 1), b3 + hstep, voffB); PG8_STAGE(PG8_SA(1, 0), a3, voffA);
            PG8_WAIT_V(8); PG8_WAIT_L(0); PG8_BAR; PG8_MMA(1, 0, At, B0); PG8_MMA(1, 1, At, B1); PG8_BAR; PG8_SCHED;
            } else {
            PG8_LDB(B0, 0, 0); PG8_SCHED; PG8_LDA(At, 0, 0); PG8_STAGE(PG8_SA(1, 1), a1 + hstep, voffA);
            PG8_WAIT_L(8); PG8_BAR; PG8_WAIT_L(0); PG8_MMA(0, 0, At, B0); PG8_BAR; PG8_SCHED;
            PG8_LDB(B1, 0, 1); PG8_STAGE(PG8_SB(0, 0), b2, voffB);
            PG8_BAR; PG8_WAIT_L(0); PG8_MMA(0, 1, At, B1); PG8_BAR;
            PG8_LDA(At, 0, 1); PG8_STAGE(PG8_SA(0, 0), a2, voffA);
            PG8_BAR; PG8_WAIT_L(0); PG8_MMA(1, 0, At, B0); PG8_BAR; PG8_SCHED;
            PG8_STAGE(PG8_SB(0, 1), b2 + hstep, voffB);
            PG8_WAIT_V(6); PG8_BAR; PG8_MMA(1, 1, At, B1); PG8_BAR;
            PG8_LDB(B0, 1, 0); PG8_SCHED; PG8_LDA(At, 1, 0); PG8_STAGE(PG8_SA(0, 1), a2 + hstep, voffA);
            PG8_WAIT_L(8); PG8_BAR; PG8_WAIT_L(0); PG8_MMA(0, 0, At, B0); PG8_BAR; PG8_SCHED;
            PG8_LDB(B1, 1, 1); PG8_STAGE(PG8_SB(1, 0), b3, voffB);
            PG8_BAR; PG8_WAIT_L(0); PG8_MMA(0, 1, At, B1); PG8_BAR;
            PG8_LDA(At, 1, 1); PG8_STAGE(PG8_SA(1, 0), a3, voffA);
            PG8_BAR; PG8_WAIT_L(0); PG8_MMA(1, 0, At, B0); PG8_BAR; PG8_SCHED;
            PG8_STAGE(PG8_SB(1, 1), b3 + hstep, voffB);
            PG8_WAIT_V(6); PG8_BAR; PG8_MMA(1, 1, At, B1); PG8_BAR;
            }
        }
        if constexpr (ALIGN_EPI) { if (wr == 0) PG8_BAR; }
        if constexpr (!Epi::AFTER_DRAIN) { E(acc, cur, wr, wc, fr, fq); S.done(cur); }
        if (!has_next) break;
#pragma unroll
        for (int a = 0; a < 2; ++a)
#pragma unroll
            for (int b = 0; b < 2; ++b)
#pragma unroll
                for (int m = 0; m < 4; ++m)
#pragma unroll
                    for (int n = 0; n < 2; ++n) acc[a][b][m][n] = (f32x4){0.f, 0.f, 0.f, 0.f};
        cur = nxt; cA = nA; cB = nB; ++ui;
        if constexpr (ALIGN_EPI) { if (wr == 1) PG8_BAR; }
    }
    PG8_WAIT_V(0);
    if constexpr (!ALIGN_EPI) { if (wr == 0) PG8_BAR; }
    PG8_BAR;
    if constexpr (Epi::AFTER_DRAIN) { E.fused(acc, cur, wr, wc, fr, fq, lds, wid, lane); S.done(cur); }
#undef PG8_SA
#undef PG8_SB
#undef PG8_STAGE
#undef PG8_LDA
#undef PG8_LDB
#undef PG8_MMA
#undef PG8_WAIT_V
#undef PG8_WAIT_L
#undef PG8_BAR
#undef PG8_SCHED
}
}
#define GAS __attribute__((address_space(1)))
#define LAS __attribute__((address_space(3)))
typedef unsigned short bf16;
typedef unsigned v4u __attribute__((ext_vector_type(4)));
typedef float f32x4 __attribute__((ext_vector_type(4)));
typedef short bf16x8 __attribute__((ext_vector_type(8)));
typedef GAS unsigned gu32;
typedef GAS unsigned long long gu64;
#define RLX_AGENT __ATOMIC_RELAXED, __HIP_MEMORY_SCOPE_AGENT
#define LDS_WAIT() asm volatile("s_waitcnt lgkmcnt(0)" ::: "memory")
#define VM_WAIT() asm volatile("s_waitcnt vmcnt(0)" ::: "memory")
__device__ __forceinline__ unsigned long long rt() { return __builtin_amdgcn_s_memrealtime(); }
__device__ __forceinline__ unsigned f2bf(float f) { unsigned u = __builtin_bit_cast(unsigned, f); return (u + 0x7fffu + ((u >> 16) & 1u)) >> 16; }
__device__ __forceinline__ unsigned pk2(float lo, float hi) { return f2bf(lo) | (f2bf(hi) << 16); }

#define XB_TMO      128
#define XB_XCNT(j)  (256  + 64 * (j))
#define XB_XSUB(j)  (1280 + 64 * (j))
#define XB_XGEN(j)  (2304 + 64 * (j))
#define XB_TOP      3328
#define XB_TOPGEN   3392
#define XCD_BAR_WORDS 3456
#define XB_SPIN_CAP (1u << 22)

__device__ __forceinline__ unsigned xb_ld(unsigned* p)              { return __hip_atomic_load(p, __ATOMIC_RELAXED, __HIP_MEMORY_SCOPE_AGENT); }
__device__ __forceinline__ unsigned xb_add(unsigned* p, unsigned v) { return __hip_atomic_fetch_add(p, v, __ATOMIC_RELAXED, __HIP_MEMORY_SCOPE_AGENT); }
__device__ __forceinline__ unsigned xb_xcc_id() { return (unsigned)__builtin_amdgcn_s_getreg((3 << 11) | 20) & 0xFu; }
#define XB_SPIN(cond, bar) do { unsigned _sp = 0; while (cond) { __builtin_amdgcn_s_sleep(1); \
    if ((++_sp & 255u) == 0u) { if (xb_ld(&(bar)[XB_TMO])) break; if (_sp > XB_SPIN_CAP) { atomicAdd(&(bar)[XB_TMO], 1u); break; } } } } while (0)

struct XcdBarrier {
    unsigned* bar; unsigned x;
    volatile LAS unsigned* st;
};

__device__ __forceinline__ XcdBarrier xcd_barrier_post(unsigned* bar, volatile LAS unsigned* st) {
    XcdBarrier b; b.bar = bar; b.x = xb_xcc_id(); b.st = st;
    if (threadIdx.x == 0) (void)xb_add(&bar[XB_XCNT(b.x)], 1u);
    return b;
}
__device__ __forceinline__ void xcd_barrier_complete(unsigned* bar, unsigned x, unsigned& nloc, unsigned& nx) {
    const unsigned G = gridDim.x * gridDim.y * gridDim.z;
    unsigned sum, cnt, mine, sp = 0u;
    for (;;) {
        sum = 0u; cnt = 0u; mine = 0u;
#pragma unroll
        for (unsigned j = 0; j < 16; ++j) { const unsigned c = xb_ld(&bar[XB_XCNT(j)]); sum += c; cnt += (c > 0u) ? 1u : 0u; mine = (j == x) ? c : mine; }
        if (sum == G) break;
        __builtin_amdgcn_s_sleep(1);
        if ((++sp & 255u) == 0u) { if (xb_ld(&bar[XB_TMO])) break; if (sp > XB_SPIN_CAP) { atomicAdd(&bar[XB_TMO], 1u); break; } }
    }
    nloc = mine > 0u ? mine : 1u; nx = cnt > 0u ? cnt : 1u;
}

__device__ __forceinline__ void xcd_barrier(const XcdBarrier& b) {
    asm volatile("s_waitcnt vmcnt(0)" ::: "memory");
    __syncthreads();
    if (threadIdx.x == 0) {
        unsigned* bar = b.bar;
        __builtin_amdgcn_s_waitcnt(0);
        unsigned nloc = b.st[0], nx = b.st[1];
        if (nloc == 0u) { xcd_barrier_complete(bar, b.x, nloc, nx); b.st[0] = nloc; b.st[1] = nx; }
        const unsigned old = xb_add(&bar[XB_XSUB(b.x)], 1u);
        const unsigned gen = old / nloc;
        if (old + 1u == (gen + 1u) * nloc) {
            __builtin_amdgcn_fence(__ATOMIC_RELEASE, "agent");
            asm volatile("s_waitcnt vmcnt(0)" ::: "memory");
            const unsigned og = xb_add(&bar[XB_TOP], 1u);
            const unsigned tg = og / nx;
            if (og + 1u == (tg + 1u) * nx) xb_add(&bar[XB_TOPGEN], 1u);
            else XB_SPIN(xb_ld(&bar[XB_TOPGEN]) == tg, bar);
            __builtin_amdgcn_fence(__ATOMIC_ACQUIRE, "agent");
            xb_add(&bar[XB_XGEN(b.x)], 1u);
            asm volatile("s_waitcnt vmcnt(0)" ::: "memory");
        } else {
            XB_SPIN(xb_ld(&bar[XB_XGEN(b.x)]) == gen, bar);
            __builtin_amdgcn_fence(__ATOMIC_ACQUIRE, "agent");
            asm volatile("s_waitcnt vmcnt(0)" ::: "memory");
        }
    }
    __syncthreads();
}

constexpr int NWAVES = 8;
constexpr int M = 24576, D = 2048, DFF = 5632, DEPTH = 4;
constexpr int NSEQ = 3;
__host__ __device__ __forceinline__ int seq_base(int s) { return s == 0 ? 0 : (s == 1 ? 16384 : 20480); }
__host__ __device__ __forceinline__ int seq_len(int s) { return s == 0 ? 16384 : 4096; }
constexpr int E_PROJ = 4352, O_PROJ = 18432;
constexpr float LN_EPS = 1e-5f;
constexpr float ALPHA = 1.6817928305074290861f;
constexpr int PH_PER_LAYER = 9, NPHASE = DEPTH * PH_PER_LAYER;

constexpr size_t MiB = 1u << 20;
constexpr size_t WS_CTL = 0, CTL_ZERO_BYTES = 1 * MiB;
constexpr size_t WS_COSE = 1 * MiB, WS_SINE = WS_COSE + 512 * 1024, WS_COSO = 2 * MiB, WS_SINO = 3 * MiB;
constexpr size_t WS_LSE = 8 * MiB;
constexpr size_t WS_XB = 16 * MiB;
constexpr size_t WS_W = 112 * MiB;
constexpr size_t WS_BIG = 258 * MiB;
constexpr size_t WS_END = WS_BIG + 864 * MiB;
constexpr size_t W_IN = 0;
constexpr size_t W_OUT = 72 * MiB;
constexpr size_t W_GU = 80 * MiB;
constexpr size_t W_DN = 124 * MiB;
constexpr size_t B_Q = 0, B_K = 48 * MiB, B_V = 54 * MiB, B_HYT = 60 * MiB, B_TAP0 = 204 * MiB, B_TAP1 = 332 * MiB, B_ZT = 364 * MiB, B_PSUM = 412 * MiB;
constexpr int CW_BAR = 4096;

constexpr int RING_OFF = 0, RING_BYTES = 131072;
constexpr int LDSCTL_OFF = RING_BYTES, MISC_OFF = LDSCTL_OFF + 320;
constexpr int LDS_BYTES = 147456;

struct InTab { __device__ __forceinline__ const float* operator[](int i) const {
    const unsigned char __attribute__((address_space(4)))* k = (const unsigned char __attribute__((address_space(4)))*)__builtin_amdgcn_kernarg_segment_ptr();
    asm volatile("" : "+s"(k));
    return *(const float* const __attribute__((address_space(4)))*)(k + 8 * i); } };
struct Frame {
    LAS unsigned char* lds;
    volatile LAS unsigned* MISC;
    gu32* ctl;
    int tid, lane, wave;
    int G, bx;
    unsigned char* ws;
    float* X;
    InTab in;
};
__device__ __forceinline__ float bf2f(unsigned short b) { return __builtin_bit_cast(float, (unsigned)b << 16); }
__device__ __forceinline__ float wave_sum(float v) {
#pragma unroll
    for (int o = 1; o < 64; o <<= 1) v += __shfl_xor(v, o);
    return v;
}
__device__ __forceinline__ float wave_max(float v) {
#pragma unroll
    for (int o = 1; o < 64; o <<= 1) v = fmaxf(v, __shfl_xor(v, o));
    return v;
}


__device__ __forceinline__ void sincos_d(double x, double& sn, double& cs) {
    const double k = __builtin_rint(x * 0.63661977236758134308);
    double r = __builtin_fma(-k, 1.57079632679489655800, x); r = __builtin_fma(-k, 6.12323399573676603587e-17, r);
    const double r2 = r * r;
    double sp = -7.6471637318198164759e-13; sp = sp * r2 + 1.6059043836821614599e-10; sp = sp * r2 - 2.5052108385441718775e-08; sp = sp * r2 + 2.7557319223985890653e-06;
    sp = sp * r2 - 1.9841269841269841270e-04; sp = sp * r2 + 8.3333333333333333333e-03; sp = sp * r2 - 1.6666666666666666667e-01; const double s = r + r * r2 * sp;
    double cp = 4.7794773323873852974e-14; cp = cp * r2 - 1.1470745597729724714e-11; cp = cp * r2 + 2.0876756987868098979e-09; cp = cp * r2 - 2.7557319223985890653e-07;
    cp = cp * r2 + 2.4801587301587301587e-05; cp = cp * r2 - 1.3888888888888888889e-03; cp = cp * r2 + 4.1666666666666666667e-02; cp = cp * r2 - 0.5; const double c = 1.0 + r2 * cp;
    const int q = ((int)k) & 3;
    sn = (q == 0) ? s : (q == 1) ? c : (q == 2) ? -s : -c;
    cs = (q == 0) ? c : (q == 1) ? -s : (q == 2) ? -c : s;
}
__device__ __forceinline__ void sincos_f(float x, float& sn, float& cs) {
    const float k = __builtin_rintf(x * 0.636619772367581343f);
    float r = __builtin_fmaf(-k, 1.5703125f, x); r = __builtin_fmaf(-k, 4.837512969970703125e-4f, r); r = __builtin_fmaf(-k, 7.54978995489188216e-8f, r);
    const float r2 = r * r;
    float sp = 2.7557319224e-06f; sp = sp * r2 - 1.9841269841e-04f; sp = sp * r2 + 8.3333333333e-03f; sp = sp * r2 - 1.6666666667e-01f; const float s = r + r * r2 * sp;
    float cp = -2.7557319224e-07f; cp = cp * r2 + 2.4801587302e-05f; cp = cp * r2 - 1.3888888889e-03f; cp = cp * r2 + 4.1666666667e-02f; cp = cp * r2 - 0.5f; const float c = 1.0f + r2 * cp;
    const int q = ((int)k) & 3;
    sn = (q == 0) ? s : (q == 1) ? c : (q == 2) ? -s : -c;
    cs = (q == 0) ? c : (q == 1) ? -s : (q == 2) ? -c : s;
}
__device__ __forceinline__ float sin_f(float x) { float s, c; sincos_f(x, s, c); return s; }

__device__ __forceinline__ void transpose_item(const float* W, int K, int ldn, int c0, bf16* WT, int r0, LAS float* scr, int kb, int nb, int lane) {
    const int k0 = 64 * kb, n0 = 32 * nb;
#pragma unroll 8
    for (int i = 0; i < 32; ++i) { const int kk = 2 * i + (lane >> 5); scr[kk * 33 + (lane & 31)] = W[(size_t)(k0 + kk) * ldn + c0 + n0 + (lane & 31)]; }
    LDS_WAIT(); asm volatile("" ::: "memory");
    const int c = lane & 7;
#pragma unroll
    for (int j = 0; j < 4; ++j) { const int n = (lane >> 3) + 8 * j; const LAS float* s = scr + (8 * c) * 33 + n;
        v4u o; o.x = pk2(s[0 * 33], s[1 * 33]); o.y = pk2(s[2 * 33], s[3 * 33]); o.z = pk2(s[4 * 33], s[5 * 33]); o.w = pk2(s[6 * 33], s[7 * 33]);
        *(GAS v4u*)(WT + (size_t)(r0 + n0 + n) * K + k0 + 8 * c) = o; }
    LDS_WAIT(); asm volatile("" ::: "memory");
}
__device__ __forceinline__ void convert_segment(Frame& F, const float* W, int K, int ldn, int c0, int cnt, bf16* WT, int r0) {
    LAS float* scr = (LAS float*)(F.lds + RING_OFF + F.wave * 16384);
    const int gw = F.bx * NWAVES + F.wave, NGW = F.G * NWAVES;
    const int nnb = cnt / 32, nit = (K / 64) * nnb;
    for (int it = gw; it < nit; it += NGW) transpose_item(W, K, ldn, c0, WT, r0, scr, it / nnb, it % nnb, F.lane);
}

__device__ __forceinline__ void p_input(Frame& F) {
    const float* xp = F.in[0]; const float* xs = F.in[1];
    bf16* XB = (bf16*)(F.ws + WS_XB);
    const size_t n4 = (size_t)M * D / 4, np4 = (size_t)16384 * D / 4;
    for (size_t i = (size_t)F.bx * 512 + F.tid; i < n4; i += (size_t)F.G * 512) {
        const f32x4 v = i < np4 ? ((const f32x4*)xp)[i] : ((const f32x4*)xs)[i - np4];
        ((f32x4*)F.X)[i] = v;
        unsigned long long w = (unsigned long long)pk2(v[0], v[1]) | ((unsigned long long)pk2(v[2], v[3]) << 32);
        ((unsigned long long*)XB)[i] = w;
    }
    float* cE = (float*)(F.ws + WS_COSE); float* sE = (float*)(F.ws + WS_SINE); float* cO = (float*)(F.ws + WS_COSO); float* sO = (float*)(F.ws + WS_SINO);
    for (int i = F.bx * 512 + F.tid; i < 16384 * 24; i += F.G * 512) {
        const int pos = i / 24, f = i % 24;
        const float inv16[16] = {1.f, 0.440366596f, 0.193922743f, 0.0853971019f, 0.0376060307f, 0.016560439f, 0.00729266461f, 0.00321144587f, 0.00141421356f, 0.000622772379f, 0.000274248188f, 0.000120769735f, 5.3182961e-05f, 2.34199997e-05f, 1.03133862e-05f, 4.54167048e-06f};
        const int ff = f < 8 ? 2 * f : f - 8;
        float inv = 1.f;
#pragma unroll
        for (int q = 0; q < 16; ++q) inv = (ff == q) ? inv16[q] : inv;
        const float ang = (float)pos * inv; double sn, cs; sincos_d((double)ang, sn, cs);
        if (f < 8) { cE[pos * 8 + f] = (float)cs; sE[pos * 8 + f] = (float)sn; } else { cO[pos * 16 + (f - 8)] = (float)cs; sO[pos * 16 + (f - 8)] = (float)sn; }
    }
}

__device__ __forceinline__ void p_convert_weights(Frame& F, int layer) {
    const int j = layer >> 1; const bool even = !(layer & 1);
    bf16* Wb = (bf16*)(F.ws + WS_W);
    if (even) {
        const float* w_in = F.in[2] + (size_t)j * D * E_PROJ;
        convert_segment(F, w_in, D, E_PROJ, 0, 1280, (bf16*)((unsigned char*)Wb + W_IN), 0);
        convert_segment(F, w_in, D, E_PROJ, 1280, 3072, (bf16*)((unsigned char*)Wb + W_IN) + (size_t)1280 * D, 0);
        convert_segment(F, F.in[15] + (size_t)j * D * D, D, D, 0, D, (bf16*)((unsigned char*)Wb + W_OUT), 0);
    } else {
        convert_segment(F, F.in[16] + (size_t)j * D * O_PROJ, D, O_PROJ, 0, O_PROJ, (bf16*)((unsigned char*)Wb + W_IN), 0);
        convert_segment(F, F.in[17] + (size_t)j * D * D, D, D, 0, D, (bf16*)((unsigned char*)Wb + W_OUT), 0);
    }
    const float* wg = F.in[18] + (size_t)layer * D * DFF; const float* wu = F.in[19] + (size_t)layer * D * DFF;
    bf16* WGU = (bf16*)((unsigned char*)Wb + W_GU);
    {   LAS float* scr = (LAS float*)(F.lds + RING_OFF + F.wave * 16384);
        const int gw = F.bx * NWAVES + F.wave, NGW = F.G * NWAVES;
        const int nit = (D / 64) * (2 * DFF / 32);
        for (int it = gw; it < nit; it += NGW) { const int kb = it / 352, nb = it % 352;
            const int pn = nb >> 3, half = (nb >> 2) & 1, sub = nb & 3;
            transpose_item(half ? wu : wg, D, DFF, 128 * pn + 32 * sub, WGU, 32 * nb, scr, kb, 0, F.lane); }
    }
    convert_segment(F, F.in[20] + (size_t)layer * DFF * D, DFF, D, 0, D, (bf16*)((unsigned char*)Wb + W_DN), 0);
}

__device__ __forceinline__ void taps_tile(Frame& F, int j, int cls, int tile) {
    const int L = cls ? 4096 : 16384; const int i0 = tile * 64;
    LAS float* zf = (LAS float*)(F.lds + RING_OFF);
    LAS float* h1 = zf + 64 * 33;
    LAS float* h2 = h1 + 64 * 65;
    const float* w1 = F.in[6] + (size_t)j * 33 * 64; const float* b1 = F.in[7] + j * 64; const float* f1 = F.in[8] + j * 64;
    const float* w2 = F.in[9] + (size_t)j * 64 * 64; const float* b2 = F.in[10] + j * 64; const float* f2 = F.in[11] + j * 64;
    const float* w3 = F.in[12] + (size_t)j * 64 * 4096; const float* b3 = F.in[13] + (size_t)j * 4096;
    for (int idx = F.tid; idx < 64 * 33; idx += 512) { const int p = idx / 33, f = idx % 33, i = i0 + p; float val;
        if (f == 0) val = (float)i / (float)(L - 1);
        else { const int mm = (f - 1) & 15; const float band = 1e-4f + (float)mm * ((15.0f - 1e-4f) / 15.0f); const float w = 6.283185307179586f * (float)i / (float)L;
            float sn, cs; sincos_f(band * w, sn, cs); val = f <= 16 ? cs : -sn; }
        zf[p * 33 + f] = val; }
    __syncthreads();
    for (int idx = F.tid; idx < 64 * 64; idx += 512) { const int p = idx >> 6, k = idx & 63; float a = b1[k];
        for (int f = 0; f < 33; ++f) a += zf[p * 33 + f] * w1[f * 64 + k];
        h1[p * 65 + k] = sin_f(f1[k] * a); }
    __syncthreads();
    for (int idx = F.tid; idx < 64 * 64; idx += 512) { const int p = idx >> 6, k = idx & 63; float a = b2[k];
        for (int f = 0; f < 64; ++f) a += h1[p * 65 + f] * w2[f * 64 + k];
        h2[p * 65 + k] = sin_f(f2[k] * a); }
    __syncthreads();
    const int i = i0 + F.lane; const float ti = (float)i / (float)(L - 1);
    bf16* TAPS = (bf16*)(F.ws + WS_BIG + (cls ? B_TAP1 : B_TAP0));
    float* PS = (float*)(F.ws + WS_BIG + B_PSUM) + (cls ? (size_t)256 * 4096 : 0) + (size_t)tile * 4096;
    const float dmin = -3.0701134573253943f  , dmax = -15.350567286626973f  ;
    const LAS float* hrow = h2 + F.lane * 65;
#pragma unroll 1
    for (int cb = 0; cb < 512; cb += 4) { const int col = F.wave * 512 + cb;
        asm volatile("" ::: "memory");
        f32x4 a = *(const f32x4*)(b3 + col);
#pragma unroll 8
        for (int k = 0; k < 64; ++k) { const f32x4 wv = *(const f32x4*)(w3 + (size_t)k * 4096 + col); const float hk = hrow[k]; a += wv * hk; }
        const int dir = col >> 11, o = (col >> 10) & 1, ch0 = col & 1023;
#pragma unroll
        for (int e = 0; e < 4; ++e) { const int ch = ch0 + e; const float delta = fabsf(dmin + (dmax - dmin) * ((float)ch / 1023.0f));
            float val = a[e] * __expf(-ti * delta);
            bf16* tp = TAPS + ((size_t)(o * 1024 + ch)) * (2 * L);
            if (dir == 0) tp[L - i] = (bf16)f2bf(val);
            else { if (i >= 1) tp[L + i] = (bf16)f2bf(val); else { tp[0] = 0; val = 0.f; } }
            const float s = wave_sum(fabsf(val));
            if (F.lane == 0) PS[col + e] = s; }
    }
    __syncthreads();
}

__device__ __forceinline__ void p_layernorm(Frame& F, const float* gam, const float* bet) {
    bf16* XB = (bf16*)(F.ws + WS_XB);
    const int gw = F.bx * NWAVES + F.wave, NGW = F.G * NWAVES;
    f32x4 gv[8], bv[8];
#pragma unroll
    for (int q = 0; q < 8; ++q) { gv[q] = ((const f32x4*)gam)[F.lane + 64 * q]; bv[q] = ((const f32x4*)bet)[F.lane + 64 * q]; }
    for (int m = gw; m < M; m += NGW) {
        f32x4* xr = (f32x4*)(F.X + (size_t)m * D) + F.lane;
        f32x4 v[8]; float s = 0.f;
#pragma unroll
        for (int q = 0; q < 8; ++q) { v[q] = xr[64 * q]; s += (v[q][0] + v[q][1]) + (v[q][2] + v[q][3]); }
        const float mean = wave_sum(s) * (1.f / D); float s2 = 0.f;
#pragma unroll
        for (int q = 0; q < 8; ++q) { v[q] = v[q] - mean; s2 += (v[q][0] * v[q][0] + v[q][1] * v[q][1]) + (v[q][2] * v[q][2] + v[q][3] * v[q][3]); }
        const float rstd = 1.f / sqrtf(wave_sum(s2) * (1.f / D) + LN_EPS);
        unsigned long long* o8 = (unsigned long long*)(XB + (size_t)m * D) + F.lane;
#pragma unroll
        for (int q = 0; q < 8; ++q) { const f32x4 y = v[q] * rstd * gv[q] + bv[q]; xr[64 * q] = y;
            o8[64 * q] = (unsigned long long)pk2(y[0], y[1]) | ((unsigned long long)pk2(y[2], y[3]) << 32); }
    }
}

__device__ __forceinline__ void p_attn_even_naive(Frame& F, int j) {
    const bf16* Q = (const bf16*)(F.ws + WS_BIG + B_Q); const bf16* Kb = (const bf16*)(F.ws + WS_BIG + B_K); const bf16* Vb = (const bf16*)(F.ws + WS_BIG + B_V);
    bf16* AO = (bf16*)(F.ws + WS_XB);
    const float* sink = F.in[3] + j * 16;
    const int gw = F.bx * NWAVES + F.wave, NGW = F.G * NWAVES;
    for (int it = gw; it < M * 16; it += NGW) {
        const int tok = it >> 4, h = it & 15, kvh = h >> 3;
        const int sb = pg8::seq_base_of_row(tok), L = sb == 0 ? 16384 : 4096, pos = tok - sb;
        float sc[5]; bool ok[5];
#pragma unroll
        for (int c = 0; c < 5; ++c) sc[c] = 0.f;
        int kr[5];
#pragma unroll
        for (int c = 0; c < 5; ++c) { const int kp = pos - 128 + F.lane + 64 * c; ok[c] = (kp <= pos + 128) && kp >= 0 && kp < L; kr[c] = ok[c] ? sb + kp : tok; }
        for (int t = 0; t < 8; ++t) {
            const v4u qv = *(const v4u*)(Q + (size_t)tok * 1024 + h * 64 + 8 * t);
            float qf[8];
#pragma unroll
            for (int e = 0; e < 4; ++e) { qf[2 * e] = bf2f((unsigned short)(qv[e] & 0xffff)); qf[2 * e + 1] = bf2f((unsigned short)(qv[e] >> 16)); }
#pragma unroll
            for (int c = 0; c < 5; ++c) { const v4u kv = *(const v4u*)(Kb + (size_t)kr[c] * 128 + kvh * 64 + 8 * t);
#pragma unroll
                for (int e = 0; e < 4; ++e) sc[c] += qf[2 * e] * bf2f((unsigned short)(kv[e] & 0xffff)) + qf[2 * e + 1] * bf2f((unsigned short)(kv[e] >> 16)); }
        }
        const float sk = sink[h];
        float mx = sk;
#pragma unroll
        for (int c = 0; c < 5; ++c) { sc[c] = ok[c] ? sc[c] * 0.125f : -INFINITY; mx = fmaxf(mx, sc[c]); }
        mx = wave_max(mx);
        float p[5]; float ps = 0.f;
#pragma unroll
        for (int c = 0; c < 5; ++c) { p[c] = ok[c] ? __expf(sc[c] - mx) : 0.f; ps += p[c]; }
        const float den = wave_sum(ps) + __expf(sk - mx);
        float o = 0.f;
#pragma unroll
        for (int c = 0; c < 5; ++c)
            for (int l = 0; l < 64; ++l) { const float pl = __shfl(p[c], l); const int kp = pos - 128 + l + 64 * c;
                if (pl != 0.f) o += pl * bf2f(Vb[(size_t)(sb + kp) * 128 + kvh * 64 + F.lane]); }
        AO[(size_t)tok * D + h * 64 + F.lane] = (bf16)f2bf(o / den);
    }
}

__device__ __forceinline__ void p_attn_odd_naive(Frame& F) {
    bf16* QKV = (bf16*)(F.ws + WS_BIG); float* LSE = (float*)(F.ws + WS_LSE);
    const int gw = F.bx * NWAVES + F.wave, NGW = F.G * NWAVES;
    for (int it = gw; it < 3 * 16 * M; it += NGW) {
        const int prow = it % M, gh = it / M, g = gh >> 4, h = gh & 15;
        const int sb = pg8::seq_base_of_row(prow), L = sb == 0 ? 16384 : 4096, ls = L >> (2 * g);
        const int pp = prow - sb, rho = pp / ls, idx = pp - rho * ls;
        bf16* Qg = QKV + ((size_t)((0 * 3 + g) * 16 + h) * M) * 128; const bf16* Kg = QKV + ((size_t)((1 * 3 + g) * 16 + h) * M) * 128; const bf16* Vg = QKV + ((size_t)((2 * 3 + g) * 16 + h) * M) * 128;
        float sc[3]; bool ok[3]; int kr[3];
#pragma unroll
        for (int c = 0; c < 3; ++c) { const int ki = idx - 64 + F.lane + 64 * c; ok[c] = (ki <= idx + 64) && ki >= 0 && ki < ls; kr[c] = ok[c] ? sb + rho * ls + ki : prow; sc[c] = 0.f; }
        for (int t = 0; t < 16; ++t) {
            const v4u qv = *(const v4u*)(Qg + (size_t)prow * 128 + 8 * t);
            float qf[8];
#pragma unroll
            for (int e = 0; e < 4; ++e) { qf[2 * e] = bf2f((unsigned short)(qv[e] & 0xffff)); qf[2 * e + 1] = bf2f((unsigned short)(qv[e] >> 16)); }
#pragma unroll
            for (int c = 0; c < 3; ++c) { const v4u kv = *(const v4u*)(Kg + (size_t)kr[c] * 128 + 8 * t);
#pragma unroll
                for (int e = 0; e < 4; ++e) sc[c] += qf[2 * e] * bf2f((unsigned short)(kv[e] & 0xffff)) + qf[2 * e + 1] * bf2f((unsigned short)(kv[e] >> 16)); }
        }
        float mx = -INFINITY;
#pragma unroll
        for (int c = 0; c < 3; ++c) { sc[c] = ok[c] ? sc[c] * 0.08838834764831845f : -INFINITY; mx = fmaxf(mx, sc[c]); }
        mx = wave_max(mx);
        float p[3]; float ps = 0.f;
#pragma unroll
        for (int c = 0; c < 3; ++c) { p[c] = ok[c] ? __expf(sc[c] - mx) : 0.f; ps += p[c]; }
        const float den = wave_sum(ps);
        float o0 = 0.f, o1 = 0.f;
#pragma unroll
        for (int c = 0; c < 3; ++c)
            for (int l = 0; l < 64; ++l) { const float pl = __shfl(p[c], l); const int ki = idx - 64 + l + 64 * c;
                if (pl != 0.f) { const unsigned vv = *(const unsigned*)(Vg + (size_t)(sb + rho * ls + ki) * 128 + 2 * F.lane); o0 += pl * bf2f((unsigned short)(vv & 0xffff)); o1 += pl * bf2f((unsigned short)(vv >> 16)); } }
        const float inv = 1.f / den;
        *(unsigned*)(Qg + (size_t)prow * 128 + 2 * F.lane) = pk2(o0 * inv, o1 * inv);
        if (F.lane == 0) LSE[((size_t)g * M + prow) * 16 + h] = mx + __logf(den);
    }
}

__device__ __forceinline__ void p_combine_odd(Frame& F) {
    const bf16* QKV = (const bf16*)(F.ws + WS_BIG); const float* LSE = (const float*)(F.ws + WS_LSE); bf16* AO = (bf16*)(F.ws + WS_XB);
    for (int it = F.bx * 512 + F.tid; it < M * 256; it += F.G * 512) {
        const int tok = it >> 8, h = (it >> 4) & 15, ck = it & 15;
        const int sb = pg8::seq_base_of_row(tok), L = sb == 0 ? 16384 : 4096, pos = tok - sb;
        float l[3]; int pr[3];
#pragma unroll
        for (int g = 0; g < 3; ++g) { const int dsh = 2 * g; pr[g] = sb + (pos & ((1 << dsh) - 1)) * (L >> dsh) + (pos >> dsh); l[g] = LSE[((size_t)g * M + pr[g]) * 16 + h]; }
        const float mx = fmaxf(l[0], fmaxf(l[1], l[2]));
        float w[3]; float ws = 0.f;
#pragma unroll
        for (int g = 0; g < 3; ++g) { w[g] = __expf(l[g] - mx); ws += w[g]; }
        const float inv = 1.f / ws;
        float acc[8];
#pragma unroll
        for (int e = 0; e < 8; ++e) acc[e] = 0.f;
#pragma unroll
        for (int g = 0; g < 3; ++g) { const v4u ov = *(const v4u*)(QKV + ((size_t)(g * 16 + h) * M + pr[g]) * 128 + 8 * ck); const float wg = w[g] * inv;
#pragma unroll
            for (int e = 0; e < 4; ++e) { acc[2 * e] += wg * bf2f((unsigned short)(ov[e] & 0xffff)); acc[2 * e + 1] += wg * bf2f((unsigned short)(ov[e] >> 16)); } }
        v4u o; o.x = pk2(acc[0], acc[1]); o.y = pk2(acc[2], acc[3]); o.z = pk2(acc[4], acc[5]); o.w = pk2(acc[6], acc[7]);
        *(v4u*)(AO + (size_t)tok * D + h * 128 + 8 * ck) = o;
    }
}

template <int L> __device__ __forceinline__ void hyena_unit_naive(Frame& F, int j, int s, int ch) {
    constexpr int NQ = L / 512, cls = (L == 4096) ? 1 : 0, NT = L / 64;
    const int sb = seq_base(s);
    LAS bf16* tp = (LAS bf16*)(F.lds + RING_OFF); LAS bf16* vb = tp + 2 * L; LAS bf16* zb = vb + L;
    LAS float* red = (LAS float*)(F.lds + LDSCTL_OFF + 64);
    const bf16* HYT = (const bf16*)(F.ws + WS_BIG + B_HYT); bf16* ZT = (bf16*)(F.ws + WS_BIG + B_ZT);
    const bf16* TAPS = (const bf16*)(F.ws + WS_BIG + (cls ? B_TAP1 : B_TAP0));
    const float* PS = (const float*)(F.ws + WS_BIG + B_PSUM) + (cls ? (size_t)256 * 4096 : 0);
    const float* cw = F.in[4] + (size_t)j * 3 * 3072; const float* cb = F.in[5] + (size_t)j * 3072; const float* hb = F.in[14] + (size_t)j * 2 * 1024;
    if (F.wave < 2) { const int o = F.wave; float a = 0.f;
        for (int t = F.lane; t < NT; t += 64) a += PS[(size_t)t * 4096 + (0 * 2 + o) * 1024 + ch] + PS[(size_t)t * 4096 + (1 * 2 + o) * 1024 + ch];
        a = wave_sum(a); if (F.lane == 0) red[o] = a; }
    { const bf16* hr = HYT + (size_t)ch * M + sb; const float w0 = cw[0 * 3072 + ch], w1 = cw[1 * 3072 + ch], w2 = cw[2 * 3072 + ch], b = cb[ch];
      for (int i = F.tid; i < L; i += 512) { const float xm = i > 0 ? bf2f(hr[i - 1]) : 0.f, x0 = bf2f(hr[i]), xp = i < L - 1 ? bf2f(hr[i + 1]) : 0.f; vb[i] = (bf16)f2bf(b + w0 * xm + w1 * x0 + w2 * xp); } }
    __syncthreads();
#pragma unroll 1
    for (int o = 0; o < 2; ++o) {
        const bf16* tg = TAPS + (size_t)(o * 1024 + ch) * (2 * L);
        for (int i = F.tid; i < 2 * L / 8; i += 512) ((LAS v4u*)tp)[i] = ((const v4u*)tg)[i];
        __syncthreads();
        const LAS bf16* src = o == 0 ? vb : zb;
        float acc[NQ];
#pragma unroll
        for (int q = 0; q < NQ; ++q) acc[q] = 0.f;
        for (int jj = 0; jj < L; ++jj) { const float uj = bf2f(src[jj]); const LAS bf16* tq = tp + (L - F.tid + jj);
#pragma unroll
            for (int q = 0; q < NQ; ++q) acc[q] += bf2f(tq[-512 * q]) * uj; }
        const float invS = 1.f / red[o]; const float bias = hb[o * 1024 + ch];
        const int gch = (o == 0 ? 1024 : 2048) + ch;
        const bf16* hr = HYT + (size_t)gch * M + sb; const float w0 = cw[0 * 3072 + gch], w1 = cw[1 * 3072 + gch], w2 = cw[2 * 3072 + gch], b = cb[gch];
#pragma unroll
        for (int q = 0; q < NQ; ++q) { const int i = 512 * q + F.tid;
            const float xm = i > 0 ? bf2f(hr[i - 1]) : 0.f, x0 = bf2f(hr[i]), xp = i < L - 1 ? bf2f(hr[i + 1]) : 0.f; const float xg = b + w0 * xm + w1 * x0 + w2 * xp;
            const float y = acc[q] * invS + bias * bf2f(src[i]); const float z = xg * y;
            if (o == 0) zb[i] = (bf16)f2bf(z); else ZT[(size_t)ch * M + sb + i] = (bf16)f2bf(z); }
        __syncthreads();
    }
}


typedef float f32x16 __attribute__((ext_vector_type(16)));
typedef short s16x4 __attribute__((ext_vector_type(4)));
typedef unsigned u32x4_t __attribute__((ext_vector_type(4)));
template <int L, int TPW> __device__ __forceinline__ void hyena_unit_mfma(Frame& F, int j, int s, int ch0) {
    constexpr int NB = L / 32, NT = NB / 32, WPC = NT / TPW, NCH = NWAVES / WPC, cls = (L == 4096) ? 1 : 0, NTL = L / 64;
    constexpr int UBYTES = (NB + 64) * 80, TSTG = TPW * 2304;
    static_assert(NCH * UBYTES + NWAVES * TSTG <= RING_BYTES, "hyena LDS");
    const int sb = seq_base(s);
    const int w = F.wave, cidx = w / WPC, wl = w % WPC, lane = F.lane, i0 = lane & 31, h = lane >> 5;
    const int ch = ch0 + cidx;
    LAS unsigned char* Ub = F.lds + RING_OFF + cidx * UBYTES;
    LAS unsigned char* Tb = F.lds + RING_OFF + NCH * UBYTES + w * TSTG;
    LAS float* red = (LAS float*)(F.lds + LDSCTL_OFF + 64);
    const bf16* HYT = (const bf16*)(F.ws + WS_BIG + B_HYT); bf16* ZT = (bf16*)(F.ws + WS_BIG + B_ZT);
    const bf16* TAPS = (const bf16*)(F.ws + WS_BIG + (cls ? B_TAP1 : B_TAP0));
    const float* PS = (const float*)(F.ws + WS_BIG + B_PSUM) + (cls ? (size_t)256 * 4096 : 0);
    const float* cw = F.in[4] + (size_t)j * 3 * 3072; const float* cb = F.in[5] + (size_t)j * 3072; const float* hb = F.in[14] + (size_t)j * 2 * 1024;
    if (w < 2 * NCH) { const int cc = w >> 1, o = w & 1, chh = ch0 + cc; float a = 0.f;
        for (int t = lane; t < NTL; t += 64) a += PS[(size_t)t * 4096 + (0 * 2 + o) * 1024 + chh] + PS[(size_t)t * 4096 + (1 * 2 + o) * 1024 + chh];
        a = wave_sum(a); if (lane == 0) red[w] = a; }
#pragma unroll 1
    for (int cc = 0; cc < NCH; ++cc) { const int chh = ch0 + cc; LAS bf16* Ue = (LAS bf16*)(F.lds + RING_OFF + cc * UBYTES);
        const bf16* hr = HYT + (size_t)chh * M + sb; const float w0 = cw[0 * 3072 + chh], w1 = cw[1 * 3072 + chh], w2 = cw[2 * 3072 + chh], b = cb[chh];
        for (int el = F.tid; el < (NB + 64) * 40; el += 512) { const int blk = el / 40, j0 = el - blk * 40, p = (blk - 32) * 32 + j0; float val = 0.f;
            if (j0 < 32 && p >= 0 && p < L) { const float xm = p > 0 ? bf2f(hr[p - 1]) : 0.f, x0 = bf2f(hr[p]), xp = p < L - 1 ? bf2f(hr[p + 1]) : 0.f; val = b + w0 * xm + w1 * x0 + w2 * xp; }
            Ue[el] = (bf16)f2bf(val); } }
    __syncthreads();
    const int c4 = i0 & 3;
    const int abase = c4 * 576 + 16 * h - 2 * (i0 & ~3);
    const int bbase = (i0 + 32) * 80 + 16 * h;
    unsigned zpk[TPW][4][2];
#pragma unroll 1
    for (int o = 0; o < 2; ++o) {
        f32x16 acc[TPW];
#pragma unroll
        for (int t = 0; t < TPW; ++t)
#pragma unroll
            for (int r = 0; r < 16; ++r) acc[t][r] = 0.f;
        const bf16* TRg = TAPS + (size_t)(o * 1024 + ch) * (2 * L);
#pragma unroll 1
        for (int e0 = -NB; e0 < 32; e0 += 8) {
#pragma unroll
            for (int t = 0; t < TPW; ++t) { const int n0 = 32 * (wl * TPW + t), wbase = L - 32 * (n0 + e0 + 8);
                if (lane < 36) { int xi = wbase + 8 * lane, pi = xi - 8; xi = xi < 0 ? 0 : (xi > 2 * L - 8 ? 2 * L - 8 : xi); pi = pi < 0 ? 0 : (pi > 2 * L - 8 ? 2 * L - 8 : pi);
                    const v4u X = *(const v4u*)(TRg + xi), P = *(const v4u*)(TRg + pi);
                    const unsigned a0 = __builtin_amdgcn_alignbit(X.x, P.w, 16), a1 = __builtin_amdgcn_alignbit(X.y, X.x, 16), a2 = __builtin_amdgcn_alignbit(X.z, X.y, 16), a3 = __builtin_amdgcn_alignbit(X.w, X.z, 16), a4 = __builtin_amdgcn_alignbit(P.w, P.z, 16);
                    LAS unsigned char* dst = Tb + t * 2304 + 16 * lane;
                    *(LAS v4u*)(dst) = X;
                    *(LAS v4u*)(dst + 576) = (v4u){a0, a1, a2, a3};
                    *(LAS v4u*)(dst + 1152) = (v4u){P.w, X.x, X.y, X.z};
                    *(LAS v4u*)(dst + 1728) = (v4u){a4, a0, a1, a2}; } }
            const LAS unsigned char* bp = Ub + bbase - (e0 + 7) * 80;
#pragma unroll
            for (int dl = 0; dl < 8; ++dl)
#pragma unroll
                for (int ks = 0; ks < 2; ++ks) {
                    const bf16x8 Bf = *(const LAS bf16x8*)(bp + 80 * (7 - dl) + 32 * ks);
#pragma unroll
                    for (int t = 0; t < TPW; ++t) { const LAS unsigned char* ap = Tb + t * 2304 + abase + 64 * (8 - dl) + 32 * ks;
                        const s16x4 lo = *(const LAS s16x4*)ap, hi = *(const LAS s16x4*)(ap + 8);
                        const bf16x8 Af = __builtin_shufflevector(lo, hi, 0, 1, 2, 3, 4, 5, 6, 7);
                        acc[t] = __builtin_amdgcn_mfma_f32_32x32x16_bf16(Af, Bf, acc[t], 0, 0, 0); }
                }
        }
        int i0e = i0, he = h; asm volatile("" : "+v"(i0e), "+v"(he));
        const float invS = 1.f / red[2 * cidx + o]; const float bias = hb[o * 1024 + ch];
        const int gch = (o == 0 ? 1024 : 2048) + ch;
        const bf16* hr = HYT + (size_t)gch * M + sb; const float w0 = cw[0 * 3072 + gch], w1 = cw[1 * 3072 + gch], w2 = cw[2 * 3072 + gch], b = cb[gch];
#pragma unroll
        for (int t = 0; t < TPW; ++t) { const int n0 = 32 * (wl * TPW + t);
#pragma unroll
            for (int rg = 0; rg < 4; ++rg) { const int p = 32 * (n0 + i0e) + 8 * rg + 4 * he;
                const s16x4 uu = *(const LAS s16x4*)(Ub + ((p >> 5) + 32) * 80 + (p & 31) * 2);
                float hx[6];
#pragma unroll
                for (int q = 0; q < 6; ++q) { const int pp = p - 1 + q; hx[q] = (pp >= 0 && pp < L) ? bf2f(hr[pp]) : 0.f; }
                float z[4];
#pragma unroll
                for (int q = 0; q < 4; ++q) { const float gate = b + w0 * hx[q] + w1 * hx[q + 1] + w2 * hx[q + 2];
                    const float y = acc[t][4 * rg + q] * invS + bias * bf2f((unsigned short)uu[q]); z[q] = gate * y; }
                if (o == 0) { zpk[t][rg][0] = pk2(z[0], z[1]); zpk[t][rg][1] = pk2(z[2], z[3]); }
                else { unsigned long long wv = (unsigned long long)pk2(z[0], z[1]) | ((unsigned long long)pk2(z[2], z[3]) << 32); *(unsigned long long*)(ZT + (size_t)ch * M + sb + p) = wv; }
                asm volatile("" ::: "memory"); }
        }
        __syncthreads();
        if (o == 0) {
#pragma unroll
            for (int t = 0; t < TPW; ++t) { const int n0 = 32 * (wl * TPW + t);
#pragma unroll
                for (int rg = 0; rg < 4; ++rg) { const int p = 32 * (n0 + i0e) + 8 * rg + 4 * he;
                    *(LAS unsigned long long*)(Ub + ((p >> 5) + 32) * 80 + (p & 31) * 2) = (unsigned long long)zpk[t][rg][0] | ((unsigned long long)zpk[t][rg][1] << 32); } }
            __syncthreads();
        }
    }
}


typedef short v4i16_t __attribute__((ext_vector_type(4)));
typedef float f32x2_t __attribute__((ext_vector_type(2))); typedef __bf16 bf16x2_t __attribute__((ext_vector_type(2)));
__device__ __forceinline__ unsigned cvtpk_rne(float lo, float hi) { f32x2_t v = {lo, hi}; bf16x2_t b = __builtin_convertvector(v, bf16x2_t); return __builtin_bit_cast(unsigned, b); }
__device__ __forceinline__ s16x4 vtr_read(const LAS unsigned char* p) { return __builtin_bit_cast(s16x4, __builtin_amdgcn_ds_read_tr16_b64_v4i16((LAS v4i16_t*)p)); }
__device__ __forceinline__ int crow32(int r, int h) { return (r & 3) + 8 * (r >> 2) + 4 * h; }
template <int NR, int CPR, int LP> __device__ __forceinline__ void stage_rows(LAS unsigned char* dst, const bf16* base, size_t gp, int wr0, int lo, int hi, int tid) {
    for (int idx = tid; idx < NR * CPR; idx += 512) { const int r = idx / CPR, ck = idx % CPR, grow = wr0 + r;
        v4u v = {0u, 0u, 0u, 0u}; if (grow >= lo && grow < hi) v = *(const v4u*)(base + (size_t)grow * gp + ck * 8);
        *(LAS v4u*)(dst + r * LP + ck * 16) = v; }
}
template <int HD, int NT, int RAD, int KP> __device__ __forceinline__ void attn_scores(f32x16 (&S)[NT], const LAS unsigned char* Kw, const bf16x8 (&Qf)[HD / 16], int q, int h, int ki0, int lo, int hi, float scale_l2, float sink_l2, bool has_sink, float& m_out, float& den_out) {
#pragma unroll
    for (int t = 0; t < NT; ++t) {
#pragma unroll
        for (int r = 0; r < 16; ++r) S[t][r] = 0.f;
#pragma unroll
        for (int ks = 0; ks < HD / 16; ++ks) { const bf16x8 Af = *(const LAS bf16x8*)(Kw + (32 * t + q) * KP + 32 * ks + 16 * h); S[t] = __builtin_amdgcn_mfma_f32_32x32x16_bf16(Af, Qf[ks], S[t], 0, 0, 0); }
    }
    float m = has_sink ? sink_l2 : -1e30f;
#pragma unroll
    for (int t = 0; t < NT; ++t)
#pragma unroll
        for (int r = 0; r < 16; ++r) { const int kv = 32 * t + crow32(r, h); const int rel = kv - RAD - q; const int ki = ki0 + kv;
            const bool ok = (rel >= -RAD) && (rel <= RAD) && (ki >= lo) && (ki < hi);
            const float sv = ok ? S[t][r] * scale_l2 : -1e30f; S[t][r] = sv; m = fmaxf(m, sv); }
    m = fmaxf(m, __shfl_xor(m, 32));
    float den = 0.f;
#pragma unroll
    for (int t = 0; t < NT; ++t)
#pragma unroll
        for (int r = 0; r < 16; ++r) { const float p = __builtin_amdgcn_exp2f(S[t][r] - m); S[t][r] = p; den += p; }
    den += __shfl_xor(den, 32);
    if (has_sink) den += __builtin_amdgcn_exp2f(sink_l2 - m);
    m_out = m; den_out = den;
}
template <int HD, int NT, int VP> __device__ __forceinline__ void attn_pv(f32x16 (&O)[HD / 32], const f32x16 (&S)[NT], const LAS unsigned char* Vw, int lane) {
    const int G = lane >> 4, i = lane & 15, h = lane >> 5;
    const LAS unsigned char* vb = Vw + (4 * h + (i >> 2)) * VP + (16 * (G & 1) + 4 * (i & 3)) * 2;
#pragma unroll
    for (int db = 0; db < HD / 32; ++db)
#pragma unroll
        for (int r = 0; r < 16; ++r) O[db][r] = 0.f;
#pragma unroll
    for (int t = 0; t < NT; ++t)
#pragma unroll
        for (int s2 = 0; s2 < 2; ++s2) {
            u32x4_t pw; pw.x = cvtpk_rne(S[t][8 * s2 + 0], S[t][8 * s2 + 1]); pw.y = cvtpk_rne(S[t][8 * s2 + 2], S[t][8 * s2 + 3]); pw.z = cvtpk_rne(S[t][8 * s2 + 4], S[t][8 * s2 + 5]); pw.w = cvtpk_rne(S[t][8 * s2 + 6], S[t][8 * s2 + 7]);
            const bf16x8 Pf = __builtin_bit_cast(bf16x8, pw);
#pragma unroll
            for (int db = 0; db < HD / 32; ++db) { const LAS unsigned char* vp = vb + (32 * t + 16 * s2) * VP + 64 * db;
                const s16x4 lo = vtr_read(vp), hi4 = vtr_read(vp + 8 * VP);
                const bf16x8 Af = __builtin_shufflevector(lo, hi4, 0, 1, 2, 3, 4, 5, 6, 7);
                O[db] = __builtin_amdgcn_mfma_f32_32x32x16_bf16(Af, Pf, O[db], 0, 0, 0); }
        }
}


template <int HD, int NT, int RAD, int KP, int VP> __device__ __forceinline__ void attn_online(f32x16 (&O)[HD / 32], const LAS unsigned char* Kw, const LAS unsigned char* Vw, const bf16x8 (&Qf)[HD / 16], int lane, int ki0, int lo, int hi, float scale_l2, float m0, float& m_out, float& den_out) {
    const int q = lane & 31, h = lane >> 5, G = lane >> 4, i = lane & 15;
    const LAS unsigned char* vb = Vw + (4 * h + (i >> 2)) * VP + (16 * (G & 1) + 4 * (i & 3)) * 2;
    float m = m0, den = 0.f;
#pragma unroll
    for (int db = 0; db < HD / 32; ++db)
#pragma unroll
        for (int r = 0; r < 16; ++r) O[db][r] = 0.f;
#pragma unroll
    for (int t = 0; t < NT; ++t) {
        f32x16 St;
#pragma unroll
        for (int r = 0; r < 16; ++r) St[r] = 0.f;
#pragma unroll
        for (int ks = 0; ks < HD / 16; ++ks) { const bf16x8 Af = *(const LAS bf16x8*)(Kw + (32 * t + q) * KP + 32 * ks + 16 * h); St = __builtin_amdgcn_mfma_f32_32x32x16_bf16(Af, Qf[ks], St, 0, 0, 0); }
        float tm = -1e30f;
#pragma unroll
        for (int r = 0; r < 16; ++r) { const int kv = 32 * t + crow32(r, h); const int rel = kv - RAD - q; const int ki = ki0 + kv;
            const bool ok = (rel >= -RAD) && (rel <= RAD) && (ki >= lo) && (ki < hi);
            const float sv = ok ? St[r] * scale_l2 : -1e30f; St[r] = sv; tm = fmaxf(tm, sv); }
        tm = fmaxf(tm, __shfl_xor(tm, 32));
        const float mn = fmaxf(m, tm), alpha = __builtin_amdgcn_exp2f(m - mn); m = mn;
        float ps = 0.f;
#pragma unroll
        for (int r = 0; r < 16; ++r) { const float p = __builtin_amdgcn_exp2f(St[r] - m); St[r] = p; ps += p; }
        den = den * alpha + ps;
#pragma unroll
        for (int db = 0; db < HD / 32; ++db)
#pragma unroll
            for (int r = 0; r < 16; ++r) O[db][r] *= alpha;
#pragma unroll
        for (int s2 = 0; s2 < 2; ++s2) {
            u32x4_t pw; pw.x = cvtpk_rne(St[8 * s2 + 0], St[8 * s2 + 1]); pw.y = cvtpk_rne(St[8 * s2 + 2], St[8 * s2 + 3]); pw.z = cvtpk_rne(St[8 * s2 + 4], St[8 * s2 + 5]); pw.w = cvtpk_rne(St[8 * s2 + 6], St[8 * s2 + 7]);
            const bf16x8 Pf = __builtin_bit_cast(bf16x8, pw);
#pragma unroll
            for (int db = 0; db < HD / 32; ++db) { const LAS unsigned char* vp = vb + (32 * t + 16 * s2) * VP + 64 * db;
                const s16x4 lo4 = vtr_read(vp), hi4 = vtr_read(vp + 8 * VP);
                const bf16x8 Af = __builtin_shufflevector(lo4, hi4, 0, 1, 2, 3, 4, 5, 6, 7);
                O[db] = __builtin_amdgcn_mfma_f32_32x32x16_bf16(Af, Pf, O[db], 0, 0, 0); }
        }
    }
    den += __shfl_xor(den, 32);
    m_out = m; den_out = den;
}

__device__ __forceinline__ void attn_odd_unit(Frame& F, int g, int head, int R0) {
    constexpr int KP = 272, VP = 320, NT = 5, RAD = 64;
    bf16* QKV = (bf16*)(F.ws + WS_BIG); float* LSE = (float*)(F.ws + WS_LSE);
    bf16* Qg = QKV + ((size_t)((0 * 3 + g) * 16 + head) * M) * 128; const bf16* Kg = QKV + ((size_t)((1 * 3 + g) * 16 + head) * M) * 128; const bf16* Vg = QKV + ((size_t)((2 * 3 + g) * 16 + head) * M) * 128;
    const int sb = pg8::seq_base_of_row(R0), L = sb == 0 ? 16384 : 4096, ls = L >> (2 * g);
    const int seglo = sb + ((R0 - sb) / ls) * ls, seghi = seglo + ls;
    LAS unsigned char* img = F.lds + RING_OFF;
    int lane = F.lane; asm volatile("" : "+v"(lane));
    const int q = lane & 31, h = lane >> 5, w = F.wave;
    stage_rows<384, 16, KP>(img, Kg, 128, R0 - 64, seglo, seghi, F.tid);
    const int qrow = R0 + 32 * w + q;
    bf16x8 Qf[8];
#pragma unroll
    for (int ks = 0; ks < 8; ++ks) Qf[ks] = *(const bf16x8*)(Qg + (size_t)qrow * 128 + 16 * ks + 8 * h);
    __syncthreads();
    f32x16 S[NT]; float m, den;
    attn_scores<128, NT, RAD, KP>(S, img + (32 * w) * KP, Qf, q, h, R0 + 32 * w - 64, seglo, seghi, 0.08838834764831845f * 1.4426950408889634f, 0.f, false, m, den);
    __syncthreads();
    stage_rows<384, 16, VP>(img, Vg, 128, R0 - 64, seglo, seghi, F.tid);
    __syncthreads();
    f32x16 O[4];
    attn_pv<128, NT, VP>(O, S, img + (32 * w) * VP, lane);
    const float inv = 1.f / den;
#pragma unroll
    for (int db = 0; db < 4; ++db)
#pragma unroll
        for (int rg = 0; rg < 4; ++rg) { const unsigned long long wv = (unsigned long long)cvtpk_rne(O[db][4 * rg] * inv, O[db][4 * rg + 1] * inv) | ((unsigned long long)cvtpk_rne(O[db][4 * rg + 2] * inv, O[db][4 * rg + 3] * inv) << 32);
            *(unsigned long long*)(Qg + (size_t)qrow * 128 + 32 * db + 8 * rg + 4 * h) = wv; }
    if (h == 0) LSE[((size_t)g * M + qrow) * 16 + head] = (m + __builtin_amdgcn_logf(den)) * 0.6931471805599453f;
    __syncthreads();
}
__device__ __forceinline__ void p_attn_odd_mfma(Frame& F) {
    for (int u = F.bx; u < 3 * 16 * (M / 256); u += F.G) { const int rb = u % (M / 256), gh = u / (M / 256); attn_odd_unit(F, gh >> 4, gh & 15, rb * 256); }
}

__device__ __forceinline__ void attn_even_unit(Frame& F, int j, int kvh, int R0) {
    constexpr int KP = 144, VP = 192, NT = 9, RAD = 128;
    const bf16* Q = (const bf16*)(F.ws + WS_BIG + B_Q); const bf16* Kb = (const bf16*)(F.ws + WS_BIG + B_K); const bf16* Vb = (const bf16*)(F.ws + WS_BIG + B_V);
    bf16* AO = (bf16*)(F.ws + WS_XB);
    const int sb = pg8::seq_base_of_row(R0), L = sb == 0 ? 16384 : 4096;
    LAS unsigned char* kimg = F.lds + RING_OFF; LAS unsigned char* vimg = kimg + 288 * KP;
    int lane = F.lane; asm volatile("" : "+v"(lane));
    const int q = lane & 31, h = lane >> 5, w = F.wave, head = kvh * 8 + w;
    stage_rows<288, 8, KP>(kimg, Kb + kvh * 64, 128, R0 - 128, sb, sb + L, F.tid);
    stage_rows<288, 8, VP>(vimg, Vb + kvh * 64, 128, R0 - 128, sb, sb + L, F.tid);
    const int qrow = R0 + q;
    bf16x8 Qf[4];
#pragma unroll
    for (int ks = 0; ks < 4; ++ks) Qf[ks] = *(const bf16x8*)(Q + (size_t)qrow * 1024 + head * 64 + 16 * ks + 8 * h);
    const float sink_l2 = (F.in[3] + j * 16)[head] * 1.4426950408889634f;
    __syncthreads();
    float m, den; f32x16 O[2];
    attn_online<64, NT, RAD, KP, VP>(O, kimg, vimg, Qf, lane, R0 - 128, sb, sb + L, 0.125f * 1.4426950408889634f, sink_l2, m, den);
    den += __builtin_amdgcn_exp2f(sink_l2 - m);
    const float inv = 1.f / den;
#pragma unroll
    for (int db = 0; db < 2; ++db)
#pragma unroll
        for (int rg = 0; rg < 4; ++rg) { const unsigned long long wv = (unsigned long long)cvtpk_rne(O[db][4 * rg] * inv, O[db][4 * rg + 1] * inv) | ((unsigned long long)cvtpk_rne(O[db][4 * rg + 2] * inv, O[db][4 * rg + 3] * inv) << 32);
            *(unsigned long long*)(AO + (size_t)qrow * D + head * 64 + 32 * db + 8 * rg + 4 * h) = wv; }
    __syncthreads();
}
__device__ __forceinline__ void p_attn_even_mfma(Frame& F, int j) {
    for (int u = F.bx; u < 2 * (M / 32); u += F.G) attn_even_unit(F, j, u & 1, (u >> 1) * 32);
}

__device__ __forceinline__ void p_zt_transpose(Frame& F) {
    const bf16* ZT = (const bf16*)(F.ws + WS_BIG + B_ZT); bf16* AO = (bf16*)(F.ws + WS_XB);
    for (int it = F.bx * 512 + F.tid; it < M * 128; it += F.G * 512) {
        const int tok = it % M, cg = it / M;
        unsigned short v[8];
#pragma unroll
        for (int e = 0; e < 8; ++e) v[e] = ZT[(size_t)(cg * 8 + e) * M + tok];
        v4u o; o.x = v[0] | ((unsigned)v[1] << 16); o.y = v[2] | ((unsigned)v[3] << 16); o.z = v[4] | ((unsigned)v[5] << 16); o.w = v[6] | ((unsigned)v[7] << 16);
        *(v4u*)(AO + (size_t)tok * D + 1024 + cg * 8) = o;
    }
}

#ifndef MK_ATTN_NAIVE
#define MK_ATTN_NAIVE 0
#endif
#ifndef MK_HYENA_NAIVE
#define MK_HYENA_NAIVE 0
#endif
#ifndef MK_MASK
#define MK_MASK 0xFFFFF
#endif
#define HAS(b) ((MK_MASK >> (b)) & 1)
struct Args { const float* in[25]; float* out; unsigned char* ws; int ph_lo, ph_hi; };
__global__ void __launch_bounds__(NWAVES * 64, 2) mk_fwd(Args args) {
    extern __shared__ __attribute__((aligned(16))) unsigned char lds[];
    Frame F;
    F.lds = (LAS unsigned char*)lds;
    F.MISC = (volatile LAS unsigned*)(F.lds + MISC_OFF);
    F.tid = threadIdx.x; F.lane = F.tid & 63; F.wave = __builtin_amdgcn_readfirstlane(F.tid >> 6);
    F.G = gridDim.x; F.bx = blockIdx.x;
    F.ws = args.ws; F.ctl = (gu32*)(args.ws + WS_CTL); F.X = args.out;
    for (int u = F.tid; u < (LDS_BYTES - LDSCTL_OFF) / 4; u += NWAVES * 64) ((LAS unsigned*)(F.lds + LDSCTL_OFF))[u] = 0u;
    __syncthreads();
    const int lo = args.ph_lo, hi = args.ph_hi;
    XcdBarrier bar; bar.bar = (unsigned*)(F.ctl + CW_BAR); bar.x = 0; bar.st = nullptr;
    if (hi - lo > 1) bar = xcd_barrier_post((unsigned*)(F.ctl + CW_BAR), F.MISC + 8);
#define IN(k) (lo <= (k) && (k) < hi)
#define SEAM(k) do { if ((k) + 1 < hi) xcd_barrier(bar); } while (0)
#define XB ((bf16*)(F.ws + WS_XB))
#define Wb ((bf16*)(F.ws + WS_W))
#define BIG (F.ws + WS_BIG)

    if (HAS(0) && IN(0)) p_input(F);
    for (int layer = 0; layer < DEPTH; ++layer) {
        const int pb = layer * PH_PER_LAYER; const bool even = !(layer & 1); const int j = layer >> 1;
#define FRESH() do { int l_; asm volatile("v_mbcnt_lo_u32_b32 %0, -1, 0\n\tv_mbcnt_hi_u32_b32 %0, -1, %0" : "=v"(l_)); int bx_ = blockIdx.x; asm volatile("" : "+s"(bx_)); F.bx = bx_; F.lane = l_; F.tid = F.wave * 64 + l_; unsigned char* w_ = args.ws; float* x_ = args.out; asm volatile("" : "+s"(w_), "+s"(x_)); F.ws = w_; F.X = x_; } while (0)
        if (HAS(0) && IN(pb + 0)) { FRESH();
            p_convert_weights(F, layer);
            __syncthreads();
            if (even) { for (int t = F.bx; t < 320; t += F.G) { if (t < 256) taps_tile(F, j, 0, t); else taps_tile(F, j, 1, t - 256); } }
            SEAM(pb + 0);
        }
        if (HAS(1) && IN(pb + 1)) { FRESH();
            if (HAS(9) && even) {
                { pg8::Gemm g{XB, (const bf16*)((unsigned char*)Wb + W_IN), M, 1280, D}; pg8::StaticOrder S; S.init(M, 1280, F.G, F.bx);
                  pg8::EpiEvenQKV E{(bf16*)(BIG + B_Q), (bf16*)(BIG + B_K), (bf16*)(BIG + B_V), (const float*)(F.ws + WS_COSE), (const float*)(F.ws + WS_SINE)};
                  pg8::gemm_phase<pg8::EpiEvenQKV, pg8::StaticOrder, true, true>(F.lds + RING_OFF, g, S, E, F.wave); }
                { pg8::Gemm g{(const bf16*)((unsigned char*)Wb + W_IN) + (size_t)1280 * D, XB, 3072, M, D}; pg8::StaticOrder S; S.init(3072, M, F.G, (int)(((unsigned)F.bx + 128u) % (unsigned)F.G));
                  pg8::EpiPlainBf16 E{(bf16*)(BIG + B_HYT), M};
                  pg8::gemm_phase<pg8::EpiPlainBf16, pg8::StaticOrder, true, true>(F.lds + RING_OFF, g, S, E, F.wave); }
            } else if (HAS(10)) {
                pg8::Gemm g{XB, (const bf16*)((unsigned char*)Wb + W_IN), M, O_PROJ, D}; pg8::StaticOrder S; S.init(M, O_PROJ, F.G, F.bx);
                pg8::EpiOddQKV E{(bf16*)BIG, (const float*)(F.ws + WS_COSO), (const float*)(F.ws + WS_SINO), M};
                pg8::gemm_phase<pg8::EpiOddQKV, pg8::StaticOrder, true, true>(F.lds + RING_OFF, g, S, E, F.wave);
            }
            SEAM(pb + 1);
        }
        if (HAS(2) && IN(pb + 2)) { FRESH();
            if (even) {
#if MK_HYENA_NAIVE
                for (int u = F.bx; u < 3072; u += F.G) { if (u < 1024) hyena_unit_naive<16384>(F, j, 0, u); else hyena_unit_naive<4096>(F, j, 1 + ((u - 1024) >> 10), (u - 1024) & 1023); }
#else
                for (int u = F.bx; u < 2048; u += F.G) { if (u < 1024) hyena_unit_mfma<16384, 2>(F, j, 0, u); else hyena_unit_mfma<4096, 1>(F, j, 1 + ((u - 1024) >> 9), 2 * ((u - 1024) & 511)); }
#endif
                if (MK_ATTN_NAIVE & 1) p_attn_even_naive(F, j); else p_attn_even_mfma(F, j);
            } else { if (MK_ATTN_NAIVE & 2) p_attn_odd_naive(F); else p_attn_odd_mfma(F); }
            SEAM(pb + 2);
        }
        if (HAS(3) && IN(pb + 3)) { FRESH();
            if (even) p_zt_transpose(F); else p_combine_odd(F);
            SEAM(pb + 3);
        }
        if (HAS(4) && IN(pb + 4)) { FRESH();
            pg8::Gemm g{XB, (const bf16*)((unsigned char*)Wb + W_OUT), M, D, D}; pg8::StaticOrder S; S.init(M, D, F.G, F.bx);
            pg8::EpiResid E{F.X, D, ALPHA};
            pg8::gemm_phase<pg8::EpiResid, pg8::StaticOrder, true, true>(F.lds + RING_OFF, g, S, E, F.wave);
            SEAM(pb + 4);
        }
        if (HAS(5) && IN(pb + 5)) { FRESH(); p_layernorm(F, F.in[21] + (size_t)layer * D, F.in[22] + (size_t)layer * D); SEAM(pb + 5); }
        if (HAS(6) && IN(pb + 6)) { FRESH();
            pg8::Gemm g{XB, (const bf16*)((unsigned char*)Wb + W_GU), M, 2 * DFF, D}; pg8::StaticOrder S; S.init(M, 2 * DFF, F.G, F.bx);
            pg8::EpiSwiGLU E{(bf16*)BIG, DFF};
            pg8::gemm_phase<pg8::EpiSwiGLU, pg8::StaticOrder, true, true>(F.lds + RING_OFF, g, S, E, F.wave);
            SEAM(pb + 6);
        }
        if (HAS(7) && IN(pb + 7)) { FRESH();
            pg8::Gemm g{(const bf16*)BIG, (const bf16*)((unsigned char*)Wb + W_DN), M, D, DFF}; pg8::StaticOrder S; S.init(M, D, F.G, F.bx);
            pg8::EpiResid E{F.X, D, ALPHA};
            pg8::gemm_phase<pg8::EpiResid, pg8::StaticOrder, true, true>(F.lds + RING_OFF, g, S, E, F.wave);
            SEAM(pb + 7);
        }
        if (HAS(8) && IN(pb + 8)) { FRESH(); p_layernorm(F, F.in[23] + (size_t)layer * D, F.in[24] + (size_t)layer * D); SEAM(pb + 8); }
    }
#undef IN
#undef SEAM
#undef FRESH
#undef XB
#undef Wb
#undef BIG
}

#ifndef MK_ONE_LAUNCH
#define MK_ONE_LAUNCH 1
#endif
extern "C" void kernel_launch(void* const* d_in, const int* in_sizes, int n_in, void* d_out, int out_size, void* d_ws, size_t ws_size, hipStream_t stream) {
    static int grid = 0;
    if (grid == 0) {
        if (n_in != 25 || out_size != M * D || ws_size < WS_END) { fprintf(stderr, "kernel_launch: unexpected shapes (n_in %d, out %d, ws %zu < %zu)\n", n_in, out_size, ws_size, (size_t)WS_END); grid = -1; return; }
        int dev = 0, cus = 0, per_cu = 0;
        if (hipGetDevice(&dev) != hipSuccess || hipDeviceGetAttribute(&cus, hipDeviceAttributeMultiprocessorCount, dev) != hipSuccess) { grid = -1; return; }
        if (hipFuncSetAttribute((const void*)mk_fwd, hipFuncAttributeMaxDynamicSharedMemorySize, LDS_BYTES) != hipSuccess) { fprintf(stderr, "kernel_launch: hipFuncSetAttribute failed\n"); grid = -1; return; }
        if (hipOccupancyMaxActiveBlocksPerMultiprocessor(&per_cu, (const void*)mk_fwd, NWAVES * 64, LDS_BYTES) != hipSuccess || per_cu < 1) { fprintf(stderr, "kernel_launch: occupancy query says %d\n", per_cu); }
        (void)hipGetLastError();
        grid = cus;
    }
    if (grid < 0) return;
    (void)hipMemsetAsync((char*)d_ws + WS_CTL, 0, CTL_ZERO_BYTES, stream);
    Args a{};
    for (int i = 0; i < 25; ++i) a.in[i] = (const float*)d_in[i];
    a.out = (float*)d_out; a.ws = (unsigned char*)d_ws;
#if MK_ONE_LAUNCH
    a.ph_lo = 0; a.ph_hi = NPHASE;
    hipLaunchKernelGGL(mk_fwd, dim3(grid), dim3(NWAVES * 64), LDS_BYTES, stream, a);
#else
    for (int ph = 0; ph < NPHASE; ++ph) { a.ph_lo = ph; a.ph_hi = ph + 1; hipLaunchKernelGGL(mk_fwd, dim3(grid), dim3(NWAVES * 64), LDS_BYTES, stream, a); }
#endif
}
```

```cpp
#include <hip/hip_runtime.h>
#include <cstdio>
#include <cstdint>
#include <cmath>
namespace pg8 {
#define PG8_LAS __attribute__((address_space(3)))
typedef unsigned short bf16_t;
typedef short bf16x8 __attribute__((ext_vector_type(8)));
typedef float f32x4 __attribute__((ext_vector_type(4)));
typedef unsigned u32x4 __attribute__((ext_vector_type(4)));
constexpr int BM = 256, BK = 64, HALF = 128, HTB = HALF * BK * 2  , STAGE_BYTES = 8 * HTB, NXCD = 8, WGM = 8;

__host__ __device__ __forceinline__ int lds_byte(int r, int c) { const int st = (r >> 4) * 2 + (c >> 5), rr = r & 15, cc = c & 31, ob = rr * 64 + cc * 2; return st * 1024 + (ob ^ (((ob >> 9) & 1) << 5)); }
__host__ __device__ __forceinline__ void stage_rc(int b, int& R, int& C) { const int st = b / 1024, sb = b % 1024, swz = sb ^ (((sb >> 9) & 1) << 5); R = (st >> 1) * 16 + swz / 64; C = (st & 1) * 32 + (swz % 64) / 2; }
__host__ __device__ __forceinline__ int perm32(int rho) { const int n = rho >> 4, i = rho & 15; return 8 * (i >> 2) + 4 * n + (i & 3); }

struct Unit { int pm, pn; };
struct Gemm { const bf16_t* A; const bf16_t* Bt; int M, N, K; };

struct StaticOrder {
    int nM, nN, nwg, G, c;
    __host__ __device__ void init(int M, int N, int G_, int c_) { nM = M / BM; nN = N / BM; nwg = nM * nN; G = G_; c = c_; }
    __host__ __device__ bool next(int i, Unit& u) const {
        const long L = (long)i * G + c; if (L >= nwg) return false;
        int wgid = (int)L; { const int q = nwg / NXCD, r = nwg % NXCD, xcd = wgid % NXCD, off = wgid / NXCD; wgid = (xcd < r ? xcd * (q + 1) : r * (q + 1) + (xcd - r) * q) + off; }
        const int nig = WGM * nN, gid = wgid / nig, fm = gid * WGM, gsz = (nM - fm) < WGM ? (nM - fm) : WGM;
        u.pm = fm + ((wgid % nig) % gsz); u.pn = (wgid % nig) / gsz; return true;
    }
    __device__ __forceinline__ void a_ready(const Unit&) const {}
    __device__ __forceinline__ void done(const Unit&) const {}
};

__device__ __forceinline__ unsigned cvt_pk_bf16(float lo, float hi) { unsigned r; asm volatile("v_cvt_pk_bf16_f32 %0, %1, %2" : "=v"(r) : "v"(lo), "v"(hi)); return r; }
__device__ __forceinline__ u32x4 pack8(const f32x4& v0, const f32x4& v1) { u32x4 w; w.x = cvt_pk_bf16(v0[0], v0[1]); w.y = cvt_pk_bf16(v0[2], v0[3]); w.z = cvt_pk_bf16(v1[0], v1[1]); w.w = cvt_pk_bf16(v1[2], v1[3]); return w; }
__device__ __forceinline__ f32x4 shfl_xor4(const f32x4& v, int m) { f32x4 r; r[0] = __shfl_xor(v[0], m); r[1] = __shfl_xor(v[1], m); r[2] = __shfl_xor(v[2], m); r[3] = __shfl_xor(v[3], m); return r; }
__device__ __forceinline__ int seq_base_of_row(int row) { return row < 16384 ? 0 : (row < 20480 ? 16384 : 20480); }

struct EpiPlainBf16 {
    static constexpr bool PERM = true, AFTER_DRAIN = false;
    bf16_t* O; int ldc;
    __device__ __forceinline__ void operator()(const f32x4 (&acc)[2][2][4][2], const Unit& u, int wr, int wc, int fr_, int fq_) const {
        int fr = fr_, fq = fq_; asm volatile("" : "+v"(fr), "+v"(fq));
        const int row0 = u.pm * BM + wr * 64 + fr, col0 = u.pn * BM + wc * 32 + 8 * fq;
#pragma unroll
        for (int ai = 0; ai < 2; ++ai)
#pragma unroll
            for (int m = 0; m < 4; ++m) { bf16_t* rowp = O + (size_t)(row0 + ai * HALF + m * 16) * ldc + col0;
#pragma unroll
                for (int bj = 0; bj < 2; ++bj) *(u32x4*)(rowp + bj * HALF) = pack8(acc[ai][bj][m][0], acc[ai][bj][m][1]); }
    }
};

struct EpiEvenQKV {
    static constexpr bool PERM = true, AFTER_DRAIN = false;
    bf16_t* Q; bf16_t* Kb; bf16_t* Vb; const float* cosT; const float* sinT;
    __device__ __forceinline__ void operator()(const f32x4 (&acc)[2][2][4][2], const Unit& u, int wr, int wc, int fr_, int fq_) const {
        int fr = fr_, fq = fq_; asm volatile("" : "+v"(fr), "+v"(fq));
        const int row0 = u.pm * BM + wr * 64 + fr; const int sbase = seq_base_of_row(u.pm * BM);
        const bool ropew = ((wc & 1) == 0);
        const float sgn = (fq & 1) ? 1.f : -1.f;
#pragma unroll
        for (int ai = 0; ai < 2; ++ai)
#pragma unroll
            for (int m = 0; m < 4; ++m) { const int row = row0 + ai * HALF + m * 16; const int pos = row - sbase;
                f32x4 c0 = {1.f, 1.f, 1.f, 1.f}, c1 = c0, s0 = {0.f, 0.f, 0.f, 0.f}, s1 = s0;
                if (ropew && fq < 2) { c0 = *(const f32x4*)(cosT + (size_t)pos * 8); c1 = *(const f32x4*)(cosT + (size_t)pos * 8 + 4); s0 = *(const f32x4*)(sinT + (size_t)pos * 8); s1 = *(const f32x4*)(sinT + (size_t)pos * 8 + 4); }
#pragma unroll
                for (int bj = 0; bj < 2; ++bj) { f32x4 v0 = acc[ai][bj][m][0], v1 = acc[ai][bj][m][1];
                    const bool is_v = (u.pn == 4 && bj == 1);
                    if (ropew && !is_v) { const f32x4 p0 = shfl_xor4(v0, 16), p1 = shfl_xor4(v1, 16);
                        v0 = v0 * c0 + (p0 * s0) * sgn; v1 = v1 * c1 + (p1 * s1) * sgn; }
                    bf16_t* dst;
                    if (u.pn < 4) dst = Q + (size_t)row * 1024 + u.pn * 256 + bj * HALF + wc * 32 + 8 * fq;
                    else dst = (bj == 0 ? Kb : Vb) + (size_t)row * 128 + wc * 32 + 8 * fq;
                    *(u32x4*)dst = pack8(v0, v1); }
                asm volatile("" ::: "memory"); }
    }
};

struct EpiOddQKV {
    static constexpr bool PERM = true, AFTER_DRAIN = false;
    bf16_t* O; const float* cosT; const float* sinT; int Mtot;
    __device__ __forceinline__ void operator()(const f32x4 (&acc)[2][2][4][2], const Unit& u, int wr, int wc, int fr_, int fq_) const {
        int fr = fr_, fq = fq_; asm volatile("" : "+v"(fr), "+v"(fq));
        const int row0 = u.pm * BM + wr * 64 + fr; const int sbase = seq_base_of_row(u.pm * BM); const int L = sbase == 0 ? 16384 : 4096;
        const int sg = u.pn >> 3, s = sg / 3, g = sg - 3 * s; const int dsh = 2 * g;
        const int ls = L >> dsh;
        const bool ropew = (wc == 0) && (s < 2);
        const float sgn = (fq & 2) ? 1.f : -1.f;
        const int tb = (fq & 1) * 8;
#pragma unroll
        for (int ai = 0; ai < 2; ++ai)
#pragma unroll
            for (int m = 0; m < 4; ++m) { const int row = row0 + ai * HALF + m * 16; const int pos = row - sbase;
                const int prow = sbase + (pos & ((1 << dsh) - 1)) * ls + (pos >> dsh);
                f32x4 c0 = {1.f, 1.f, 1.f, 1.f}, c1 = c0, s0 = {0.f, 0.f, 0.f, 0.f}, s1 = s0;
                if (ropew) { const float* cp = cosT + (size_t)pos * 16 + tb; const float* sp = sinT + (size_t)pos * 16 + tb; c0 = *(const f32x4*)cp; c1 = *(const f32x4*)(cp + 4); s0 = *(const f32x4*)sp; s1 = *(const f32x4*)(sp + 4); }
#pragma unroll
                for (int bj = 0; bj < 2; ++bj) { f32x4 v0 = acc[ai][bj][m][0], v1 = acc[ai][bj][m][1];
                    if (ropew) { const f32x4 p0 = shfl_xor4(v0, 32), p1 = shfl_xor4(v1, 32);
                        v0 = v0 * c0 + (p0 * s0) * sgn; v1 = v1 * c1 + (p1 * s1) * sgn; }
                    const int head = 2 * (u.pn & 7) + bj;
                    bf16_t* dst = O + ((size_t)(sg * 16 + head) * Mtot + prow) * 128 + wc * 32 + 8 * fq;
                    *(u32x4*)dst = pack8(v0, v1); }
                asm volatile("" ::: "memory"); }
    }
};

struct EpiResid {
    static constexpr bool PERM = false, AFTER_DRAIN = false;
    float* X; int ldc; float alpha;
    __device__ __forceinline__ void operator()(const f32x4 (&acc)[2][2][4][2], const Unit& u, int wr, int wc, int fr_, int fq_) const {
        int fr = fr_, fq = fq_; asm volatile("" : "+v"(fr), "+v"(fq));
        const int row0 = u.pm * BM + wr * 64 + fr, col0 = u.pn * BM + wc * 32 + 4 * fq;
#pragma unroll
        for (int ai = 0; ai < 2; ++ai)
#pragma unroll
            for (int m = 0; m < 4; ++m) { float* rowp = X + (size_t)(row0 + ai * HALF + m * 16) * ldc + col0;
#pragma unroll
                for (int bj = 0; bj < 2; ++bj)
#pragma unroll
                    for (int n = 0; n < 2; ++n) { f32x4* p = (f32x4*)(rowp + bj * HALF + n * 16); const f32x4 x = *p; *p = x * alpha + acc[ai][bj][m][n]; }
                if (m & 1) asm volatile("" ::: "memory"); }
    }
};

struct EpiSwiGLU {
    static constexpr bool PERM = true, AFTER_DRAIN = false;
    bf16_t* H; int ldh;
    static __device__ __forceinline__ float silu_mul(float g, float up) { const float e = __builtin_amdgcn_exp2f(g * -1.4426950408889634f); return g * __builtin_amdgcn_rcpf(1.0f + e) * up; }
    __device__ __forceinline__ void operator()(const f32x4 (&acc)[2][2][4][2], const Unit& u, int wr, int wc, int fr_, int fq_) const {
        int fr = fr_, fq = fq_; asm volatile("" : "+v"(fr), "+v"(fq));
        const int row0 = u.pm * BM + wr * 64 + fr, col0 = u.pn * HALF + wc * 32 + 8 * fq;
#pragma unroll
        for (int ai = 0; ai < 2; ++ai)
#pragma unroll
            for (int m = 0; m < 4; ++m) { bf16_t* dst = H + (size_t)(row0 + ai * HALF + m * 16) * ldh + col0;
                f32x4 h0, h1;
#pragma unroll
                for (int e = 0; e < 4; ++e) { h0[e] = silu_mul(acc[ai][0][m][0][e], acc[ai][1][m][0][e]); h1[e] = silu_mul(acc[ai][0][m][1][e], acc[ai][1][m][1][e]); }
                *(u32x4*)dst = pack8(h0, h1); }
    }
};

template <class Epi, class Sched, bool ALIGN_EPI = false, bool SP2 = false>
__device__ __forceinline__ void gemm_phase(PG8_LAS unsigned char* lds, const Gemm g, const Sched& S, const Epi& E, const int wave_id) {
    int tid_; asm volatile("v_mbcnt_lo_u32_b32 %0, -1, 0\n\tv_mbcnt_hi_u32_b32 %0, -1, %0" : "=v"(tid_)); tid_ += wave_id * 64;
    const int tid = tid_, wid = __builtin_amdgcn_readfirstlane(tid >> 6), lane = tid & 63, wr = wid >> 2, wc = wid & 3, fr = lane & 15, fq = lane >> 4;
    const int K = g.K, nt = K / BK;
    unsigned voffA[2], voffB[2];
#pragma unroll
    for (int i = 0; i < 2; ++i) { int R, C; stage_rc(tid * 16 + i * 8192, R, C); const int Rb = Epi::PERM ? ((R & ~31) + perm32(R & 31)) : R;
        voffA[i] = (unsigned)(R * K + C) * 2u; voffB[i] = (unsigned)(Rb * K + C) * 2u; }
    const size_t kstep = (size_t)(BK * 2);
    const size_t hstep = (size_t)HALF * K * 2;
    const size_t tstep = 2 * hstep;
    const unsigned ldsw = (unsigned)wid * 1024u;
    const int aoff = lds_byte(wr * 64 + fr, fq * 8), boff = lds_byte(wc * 32 + fr, fq * 8);
#define PG8_SA(b, h) (((b) * 2 + (h)) * HTB)
#define PG8_SB(b, h) ((4 + (b) * 2 + (h)) * HTB)
#define PG8_STAGE(bufoff, gbase, voff) do { _Pragma("unroll") for (int _i = 0; _i < 2; ++_i) \
        __builtin_amdgcn_global_load_lds((const unsigned*)((const char*)(gbase) + (voff)[_i]), (PG8_LAS unsigned*)(lds + (bufoff) + ldsw + _i * 8192), 16, 0, 0); } while (0)
#define PG8_LDA(dst, b, h) do { _Pragma("unroll") for (int m = 0; m < 4; ++m) _Pragma("unroll") for (int k = 0; k < 2; ++k) dst[m][k] = *(const PG8_LAS bf16x8*)(lds + PG8_SA(b, h) + aoff + m * 2048 + k * 1024); } while (0)
#define PG8_LDB(dst, b, h) do { _Pragma("unroll") for (int n = 0; n < 2; ++n) _Pragma("unroll") for (int k = 0; k < 2; ++k) dst[n][k] = *(const PG8_LAS bf16x8*)(lds + PG8_SB(b, h) + boff + n * 2048 + k * 1024); } while (0)
#define PG8_MMA(ai, bj, At, Bt) do { __builtin_amdgcn_s_setprio(1); _Pragma("unroll") for (int m = 0; m < 4; ++m) _Pragma("unroll") for (int n = 0; n < 2; ++n) _Pragma("unroll") for (int k = 0; k < 2; ++k) \
        acc[ai][bj][m][n] = __builtin_amdgcn_mfma_f32_16x16x32_bf16(Bt[n][k], At[m][k], acc[ai][bj][m][n], 0, 0, 0); __builtin_amdgcn_s_setprio(0); } while (0)
#define PG8_WAIT_V(n) asm volatile("s_waitcnt vmcnt(" #n ")" ::: "memory")
#define PG8_WAIT_L(n) asm volatile("s_waitcnt lgkmcnt(" #n ")" ::: "memory")
#define PG8_BAR __builtin_amdgcn_s_barrier()
#define PG8_SCHED __builtin_amdgcn_sched_barrier(0)
    Unit cur, nxt; int ui = 0;
    if (!S.next(0, cur)) return;
    f32x4 acc[2][2][4][2];
#pragma unroll
    for (int a = 0; a < 2; ++a)
#pragma unroll
        for (int b = 0; b < 2; ++b)
#pragma unroll
            for (int m = 0; m < 4; ++m)
#pragma unroll
                for (int n = 0; n < 2; ++n) acc[a][b][m][n] = (f32x4){0.f, 0.f, 0.f, 0.f};
    bf16x8 At[4][2], B0[2][2], B1[2][2];
    const char* cA = (const char*)g.A + (size_t)cur.pm * tstep; const char* cB = (const char*)g.Bt + (size_t)cur.pn * tstep;
    S.a_ready(cur);
    if constexpr (SP2) {
        PG8_STAGE(PG8_SB(0, 0), cB, voffB); PG8_STAGE(PG8_SB(0, 1), cB + hstep, voffB); PG8_STAGE(PG8_SA(0, 0), cA, voffA); PG8_STAGE(PG8_SA(0, 1), cA + hstep, voffA);
        if (wr == 1) PG8_BAR;
        PG8_WAIT_V(2); PG8_BAR;
        PG8_STAGE(PG8_SB(1, 0), cB + kstep, voffB); PG8_STAGE(PG8_SA(1, 0), cA + kstep, voffA); PG8_STAGE(PG8_SB(1, 1), cB + hstep + kstep, voffB);
        PG8_WAIT_V(6); PG8_BAR;
    } else {
        PG8_STAGE(PG8_SB(0, 0), cB, voffB); PG8_STAGE(PG8_SA(0, 0), cA, voffA); PG8_STAGE(PG8_SB(0, 1), cB + hstep, voffB); PG8_STAGE(PG8_SA(0, 1), cA + hstep, voffA);
        if (wr == 1) PG8_BAR;
        PG8_WAIT_V(4); PG8_BAR;
        PG8_STAGE(PG8_SB(1, 0), cB + kstep, voffB); PG8_STAGE(PG8_SA(1, 0), cA + kstep, voffA); PG8_STAGE(PG8_SB(1, 1), cB + hstep + kstep, voffB);
        PG8_WAIT_V(6); PG8_BAR;
    }
    for (;;) {
        const bool has_next = S.next(ui + 1, nxt);
        const char* nA = has_next ? (const char*)g.A + (size_t)nxt.pm * tstep : cA; const char* nB = has_next ? (const char*)g.Bt + (size_t)nxt.pn * tstep : cB;
        for (int t = 0; t < nt; t += 2) {
            const bool last = (t == nt - 2);
            const char* a1 = cA + (size_t)(t + 1) * kstep;
            const char* a2 = last ? nA : cA + (size_t)(t + 2) * kstep; const char* b2 = last ? nB : cB + (size_t)(t + 2) * kstep;
            const char* a3 = a2 + kstep; const char* b3 = b2 + kstep;
            if (last && has_next) S.a_ready(nxt);
            if constexpr (SP2) {
            PG8_LDB(B0, 0, 0); PG8_LDB(B1, 0, 1); PG8_SCHED; PG8_LDA(At, 0, 0); PG8_STAGE(PG8_SA(1, 1), a1 + hstep, voffA);
            PG8_WAIT_V(8); PG8_WAIT_L(0); PG8_BAR; PG8_MMA(0, 0, At, B0); PG8_MMA(0, 1, At, B1); PG8_BAR; PG8_SCHED;
            PG8_LDA(At, 0, 1); PG8_STAGE(PG8_SB(0, 0), b2, voffB); PG8_STAGE(PG8_SB(0, 1), b2 + hstep, voffB); PG8_STAGE(PG8_SA(0, 0), a2, voffA);
            PG8_WAIT_V(8); PG8_WAIT_L(0); PG8_BAR; PG8_MMA(1, 0, At, B0); PG8_MMA(1, 1, At, B1); PG8_BAR; PG8_SCHED;
            PG8_LDB(B0, 1, 0); PG8_LDB(B1, 1, 1); PG8_SCHED; PG8_LDA(At, 1, 0); PG8_STAGE(PG8_SA(0, 1), a2 + hstep, voffA);
            PG8_WAIT_V(8); PG8_WAIT_L(0); PG8_BAR; PG8_MMA(0, 0, At, B0); PG8_MMA(0, 1, At, B1); PG8_BAR; PG8_SCHED;
            PG8_LDA(At, 1, 1); PG8_STAGE(PG8_SB(1, 0), b3, voffB); PG8_STAGE(PG8_SB(1, 1), b3 + hstep, voffB); PG8_STAGE(PG8_SA(1, 0), a3, voffA);
            PG8_WAIT_V(8); PG8_WAIT_L(0); PG8_BAR; PG8_MMA(1, 0, At, B0); PG8_MMA(1, 1, At, B1); PG8_BAR; PG8_SCHED;
            } else {
            PG8_LDB(B0, 0, 0); PG8_SCHED; PG8_LDA(At, 0, 0); PG8_STAGE(PG8_SA(1, 1), a1 + hstep, voffA);
            PG8_WAIT_L(8); PG8_BAR; PG8_WAIT_L(0); PG8_MMA(0, 0, At, B0); PG8_BAR; PG8_SCHED;
            PG8_LDB(B1, 0, 1); PG8_STAGE(PG8_SB(0, 0), b2, voffB);
            PG8_BAR; PG8_WAIT_L(0); PG8_MMA(0, 1, At, B1); PG8_BAR;
            PG8_LDA(At, 0, 1); PG8_STAGE(PG8_SA(0, 0), a2, voffA);
            PG8_BAR; PG8_WAIT_L(0); PG8_MMA(1, 0, At, B0); PG8_BAR; PG8_SCHED;
            PG8_STAGE(PG8_SB(0, 1), b2 + hstep, voffB);
            PG8_WAIT_V(6); PG8_BAR; PG8_MMA(1, 1, At, B1); PG8_BAR;
            PG8_LDB(B0, 1, 0); PG8_SCHED; PG8_LDA(At, 1, 0); PG8_STAGE(PG8_SA(0, 1), a2 + hstep, voffA);
            PG8_WAIT_L(8); PG8_BAR; PG8_WAIT_L(0); PG8_MMA(0, 0, At, B0); PG8_BAR; PG8_SCHED;
            PG8_LDB(B1, 1, 1); PG8_STAGE(PG8_SB(1, 0), b3, voffB);
            PG8_BAR; PG8_WAIT_L(0); PG8_MMA(0, 1, At, B1); PG8_BAR;
            PG8_LDA(At, 1, 1); PG8_STAGE(PG8_SA(1, 0), a3, voffA);
            PG8_BAR; PG8_WAIT_L(0); PG8_MMA(1, 0, At, B0); PG8_BAR; PG8_SCHED;
            PG8_STAGE(PG8_SB(1, 1), b3 + hstep, voffB);
            PG8_WAIT_V(6); PG8_BAR; PG8_MMA(1, 1, At, B1); PG8_BAR;
            }
        }
        if constexpr (ALIGN_EPI) { if (wr == 0) PG8_BAR; }
        if constexpr (!Epi::AFTER_DRAIN) { E(acc, cur, wr, wc, fr, fq); S.done(cur); }
        if (!has_next) break;
#pragma unroll
        for (int a = 0; a < 2; ++a)
#pragma unroll
            for (int b = 0; b < 2; ++b)
#pragma unroll
                for (int m = 0; m < 4; ++m)
#pragma unroll
                    for (int n = 0; n < 2; ++n) acc[a][b][m][n] = (f32x4){0.f, 0.f, 0.f, 0.f};
        cur = nxt; cA = nA; cB = nB; ++ui;
        if constexpr (ALIGN_EPI) { if (wr == 1) PG8_BAR; }
    }
    PG8_WAIT_V(0);
    if constexpr (!ALIGN_EPI) { if (wr == 0) PG8_BAR; }
    PG8_BAR;
    if constexpr (Epi::AFTER_DRAIN) { E.fused(acc, cur, wr, wc, fr, fq, lds, wid, lane); S.done(cur); }
#undef PG8_SA
#undef PG8_SB
#undef PG8_STAGE
#undef PG8_LDA
#undef PG8_LDB
#undef PG8_MMA
#undef PG8_WAIT_V
#undef PG8_WAIT_L
#undef PG8_BAR
#undef PG8_SCHED
}
}
#define GAS __attribute__((address_space(1)))
#define LAS __attribute__((address_space(3)))
typedef unsigned short bf16;
typedef unsigned v4u __attribute__((ext_vector_type(4)));
typedef float f32x4 __attribute__((ext_vector_type(4)));
typedef short bf16x8 __attribute__((ext_vector_type(8)));
typedef GAS unsigned gu32;
typedef GAS unsigned long long gu64;
#define RLX_AGENT __ATOMIC_RELAXED, __HIP_MEMORY_SCOPE_AGENT
#define LDS_WAIT() asm volatile("s_waitcnt lgkmcnt(0)" ::: "memory")
#define VM_WAIT() asm volatile("s_waitcnt vmcnt(0)" ::: "memory")
__device__ __forceinline__ unsigned long long rt() { return __builtin_amdgcn_s_memrealtime(); }
__device__ __forceinline__ unsigned f2bf(float f) { unsigned u = __builtin_bit_cast(unsigned, f); return (u + 0x7fffu + ((u >> 16) & 1u)) >> 16; }
__device__ __forceinline__ unsigned pk2(float lo, float hi) { return f2bf(lo) | (f2bf(hi) << 16); }

#define XB_TMO      128
#define XB_XCNT(j)  (256  + 64 * (j))
#define XB_XSUB(j)  (1280 + 64 * (j))
#define XB_XGEN(j)  (2304 + 64 * (j))
#define XB_TOP      3328
#define XB_TOPGEN   3392
#define XCD_BAR_WORDS 3456
#define XB_SPIN_CAP (1u << 22)

__device__ __forceinline__ unsigned xb_ld(unsigned* p)              { return __hip_atomic_load(p, __ATOMIC_RELAXED, __HIP_MEMORY_SCOPE_AGENT); }
__device__ __forceinline__ unsigned xb_add(unsigned* p, unsigned v) { return __hip_atomic_fetch_add(p, v, __ATOMIC_RELAXED, __HIP_MEMORY_SCOPE_AGENT); }
__device__ __forceinline__ unsigned xb_xcc_id() { return (unsigned)__builtin_amdgcn_s_getreg((3 << 11) | 20) & 0xFu; }
#define XB_SPIN(cond, bar) do { unsigned _sp = 0; while (cond) { __builtin_amdgcn_s_sleep(1); \
    if ((++_sp & 255u) == 0u) { if (xb_ld(&(bar)[XB_TMO])) break; if (_sp > XB_SPIN_CAP) { atomicAdd(&(bar)[XB_TMO], 1u); break; } } } } while (0)

struct XcdBarrier {
    unsigned* bar; unsigned x;
    volatile LAS unsigned* st;
};

__device__ __forceinline__ XcdBarrier xcd_barrier_post(unsigned* bar, volatile LAS unsigned* st) {
    XcdBarrier b; b.bar = bar; b.x = xb_xcc_id(); b.st = st;
    if (threadIdx.x == 0) (void)xb_add(&bar[XB_XCNT(b.x)], 1u);
    return b;
}
__device__ __forceinline__ void xcd_barrier_complete(unsigned* bar, unsigned x, unsigned& nloc, unsigned& nx) {
    const unsigned G = gridDim.x * gridDim.y * gridDim.z;
    unsigned sum, cnt, mine, sp = 0u;
    for (;;) {
        sum = 0u; cnt = 0u; mine = 0u;
#pragma unroll
        for (unsigned j = 0; j < 16; ++j) { const unsigned c = xb_ld(&bar[XB_XCNT(j)]); sum += c; cnt += (c > 0u) ? 1u : 0u; mine = (j == x) ? c : mine; }
        if (sum == G) break;
        __builtin_amdgcn_s_sleep(1);
        if ((++sp & 255u) == 0u) { if (xb_ld(&bar[XB_TMO])) break; if (sp > XB_SPIN_CAP) { atomicAdd(&bar[XB_TMO], 1u); break; } }
    }
    nloc = mine > 0u ? mine : 1u; nx = cnt > 0u ? cnt : 1u;
}

__device__ __forceinline__ void xcd_barrier(const XcdBarrier& b) {
    asm volatile("s_waitcnt vmcnt(0)" ::: "memory");
    __syncthreads();
    if (threadIdx.x == 0) {
        unsigned* bar = b.bar;
        __builtin_amdgcn_s_waitcnt(0);
        unsigned nloc = b.st[0], nx = b.st[1];
        if (nloc == 0u) { xcd_barrier_complete(bar, b.x, nloc, nx); b.st[0] = nloc; b.st[1] = nx; }
        const unsigned old = xb_add(&bar[XB_XSUB(b.x)], 1u);
        const unsigned gen = old / nloc;
        if (old + 1u == (gen + 1u) * nloc) {
            __builtin_amdgcn_fence(__ATOMIC_RELEASE, "agent");
            asm volatile("s_waitcnt vmcnt(0)" ::: "memory");
            const unsigned og = xb_add(&bar[XB_TOP], 1u);
            const unsigned tg = og / nx;
            if (og + 1u == (tg + 1u) * nx) xb_add(&bar[XB_TOPGEN], 1u);
            else XB_SPIN(xb_ld(&bar[XB_TOPGEN]) == tg, bar);
            __builtin_amdgcn_fence(__ATOMIC_ACQUIRE, "agent");
            xb_add(&bar[XB_XGEN(b.x)], 1u);
            asm volatile("s_waitcnt vmcnt(0)" ::: "memory");
        } else {
            XB_SPIN(xb_ld(&bar[XB_XGEN(b.x)]) == gen, bar);
            __builtin_amdgcn_fence(__ATOMIC_ACQUIRE, "agent");
            asm volatile("s_waitcnt vmcnt(0)" ::: "memory");
        }
    }
    __syncthreads();
}

constexpr int NWAVES = 8;
constexpr int M = 24576, D = 2048, DFF = 5632, DEPTH = 4;
constexpr int NSEQ = 3;
__host__ __device__ __forceinline__ int seq_base(int s) { return s == 0 ? 0 : (s == 1 ? 16384 : 20480); }
__host__ __device__ __forceinline__ int seq_len(int s) { return s == 0 ? 16384 : 4096; }
constexpr int E_PROJ = 4352, O_PROJ = 18432;
constexpr float LN_EPS = 1e-5f;
constexpr float ALPHA = 1.6817928305074290861f;
constexpr int PH_PER_LAYER = 9, NPHASE = DEPTH * PH_PER_LAYER;

constexpr size_t MiB = 1u << 20;
constexpr size_t WS_CTL = 0, CTL_ZERO_BYTES = 1 * MiB;
constexpr size_t WS_COSE = 1 * MiB, WS_SINE = WS_COSE + 512 * 1024, WS_COSO = 2 * MiB, WS_SINO = 3 * MiB;
constexpr size_t WS_LSE = 8 * MiB;
constexpr size_t WS_XB = 16 * MiB;
constexpr size_t WS_W = 112 * MiB;
constexpr size_t WS_BIG = 258 * MiB;
constexpr size_t WS_END = WS_BIG + 864 * MiB;
constexpr size_t W_IN = 0;
constexpr size_t W_OUT = 72 * MiB;
constexpr size_t W_GU = 80 * MiB;
constexpr size_t W_DN = 124 * MiB;
constexpr size_t B_Q = 0, B_K = 48 * MiB, B_V = 54 * MiB, B_HYT = 60 * MiB, B_TAP0 = 204 * MiB, B_TAP1 = 332 * MiB, B_ZT = 364 * MiB, B_PSUM = 412 * MiB;
constexpr int CW_BAR = 4096;

constexpr int RING_OFF = 0, RING_BYTES = 131072;
constexpr int LDSCTL_OFF = RING_BYTES, MISC_OFF = LDSCTL_OFF + 320;
constexpr int LDS_BYTES = 147456;

struct InTab { __device__ __forceinline__ const float* operator[](int i) const {
    const unsigned char __attribute__((address_space(4)))* k = (const unsigned char __attribute__((address_space(4)))*)__builtin_amdgcn_kernarg_segment_ptr();
    asm volatile("" : "+s"(k));
    return *(const float* const __attribute__((address_space(4)))*)(k + 8 * i); } };
struct Frame {
    LAS unsigned char* lds;
    volatile LAS unsigned* MISC;
    gu32* ctl;
    int tid, lane, wave;
    int G, bx;
    unsigned char* ws;
    float* X;
    InTab in;
};
__device__ __forceinline__ float bf2f(unsigned short b) { return __builtin_bit_cast(float, (unsigned)b << 16); }
__device__ __forceinline__ float wave_sum(float v) {
#pragma unroll
    for (int o = 1; o < 64; o <<= 1) v += __shfl_xor(v, o);
    return v;
}
__device__ __forceinline__ float wave_max(float v) {
#pragma unroll
    for (int o = 1; o < 64; o <<= 1) v = fmaxf(v, __shfl_xor(v, o));
    return v;
}


__device__ __forceinline__ void sincos_d(double x, double& sn, double& cs) {
    const double k = __builtin_rint(x * 0.63661977236758134308);
    double r = __builtin_fma(-k, 1.57079632679489655800, x); r = __builtin_fma(-k, 6.12323399573676603587e-17, r);
    const double r2 = r * r;
    double sp = -7.6471637318198164759e-13; sp = sp * r2 + 1.6059043836821614599e-10; sp = sp * r2 - 2.5052108385441718775e-08; sp = sp * r2 + 2.7557319223985890653e-06;
    sp = sp * r2 - 1.9841269841269841270e-04; sp = sp * r2 + 8.3333333333333333333e-03; sp = sp * r2 - 1.6666666666666666667e-01; const double s = r + r * r2 * sp;
    double cp = 4.7794773323873852974e-14; cp = cp * r2 - 1.1470745597729724714e-11; cp = cp * r2 + 2.0876756987868098979e-09; cp = cp * r2 - 2.7557319223985890653e-07;
    cp = cp * r2 + 2.4801587301587301587e-05; cp = cp * r2 - 1.3888888888888888889e-03; cp = cp * r2 + 4.1666666666666666667e-02; cp = cp * r2 - 0.5; const double c = 1.0 + r2 * cp;
    const int q = ((int)k) & 3;
    sn = (q == 0) ? s : (q == 1) ? c : (q == 2) ? -s : -c;
    cs = (q == 0) ? c : (q == 1) ? -s : (q == 2) ? -c : s;
}
__device__ __forceinline__ void sincos_f(float x, float& sn, float& cs) {
    const float k = __builtin_rintf(x * 0.636619772367581343f);
    float r = __builtin_fmaf(-k, 1.5703125f, x); r = __builtin_fmaf(-k, 4.837512969970703125e-4f, r); r = __builtin_fmaf(-k, 7.54978995489188216e-8f, r);
    const float r2 = r * r;
    float sp = 2.7557319224e-06f; sp = sp * r2 - 1.9841269841e-04f; sp = sp * r2 + 8.3333333333e-03f; sp = sp * r2 - 1.6666666667e-01f; const float s = r + r * r2 * sp;
    float cp = -2.7557319224e-07f; cp = cp * r2 + 2.4801587302e-05f; cp = cp * r2 - 1.3888888889e-03f; cp = cp * r2 + 4.1666666667e-02f; cp = cp * r2 - 0.5f; const float c = 1.0f + r2 * cp;
    const int q = ((int)k) & 3;
    sn = (q == 0) ? s : (q == 1) ? c : (q == 2) ? -s : -c;
    cs = (q == 0) ? c : (q == 1) ? -s : (q == 2) ? -c : s;
}
__device__ __forceinline__ float sin_f(float x) { float s, c; sincos_f(x, s, c); return s; }

__device__ __forceinline__ void transpose_item(const float* W, int K, int ldn, int c0, bf16* WT, int r0, LAS float* scr, int kb, int nb, int lane) {
    const int k0 = 64 * kb, n0 = 32 * nb;
#pragma unroll 8
    for (int i = 0; i < 32; ++i) { const int kk = 2 * i + (lane >> 5); scr[kk * 33 + (lane & 31)] = W[(size_t)(k0 + kk) * ldn + c0 + n0 + (lane & 31)]; }
    LDS_WAIT(); asm volatile("" ::: "memory");
    const int c = lane & 7;
#pragma unroll
    for (int j = 0; j < 4; ++j) { const int n = (lane >> 3) + 8 * j; const LAS float* s = scr + (8 * c) * 33 + n;
        v4u o; o.x = pk2(s[0 * 33], s[1 * 33]); o.y = pk2(s[2 * 33], s[3 * 33]); o.z = pk2(s[4 * 33], s[5 * 33]); o.w = pk2(s[6 * 33], s[7 * 33]);
        *(GAS v4u*)(WT + (size_t)(r0 + n0 + n) * K + k0 + 8 * c) = o; }
    LDS_WAIT(); asm volatile("" ::: "memory");
}
__device__ __forceinline__ void convert_segment(Frame& F, const float* W, int K, int ldn, int c0, int cnt, bf16* WT, int r0) {
    LAS float* scr = (LAS float*)(F.lds + RING_OFF + F.wave * 16384);
    const int gw = F.bx * NWAVES + F.wave, NGW = F.G * NWAVES;
    const int nnb = cnt / 32, nit = (K / 64) * nnb;
    for (int it = gw; it < nit; it += NGW) transpose_item(W, K, ldn, c0, WT, r0, scr, it / nnb, it % nnb, F.lane);
}

__device__ __forceinline__ void p_input(Frame& F) {
    const float* xp = F.in[0]; const float* xs = F.in[1];
    bf16* XB = (bf16*)(F.ws + WS_XB);
    const size_t n4 = (size_t)M * D / 4, np4 = (size_t)16384 * D / 4;
    for (size_t i = (size_t)F.bx * 512 + F.tid; i < n4; i += (size_t)F.G * 512) {
        const f32x4 v = i < np4 ? ((const f32x4*)xp)[i] : ((const f32x4*)xs)[i - np4];
        ((f32x4*)F.X)[i] = v;
        unsigned long long w = (unsigned long long)pk2(v[0], v[1]) | ((unsigned long long)pk2(v[2], v[3]) << 32);
        ((unsigned long long*)XB)[i] = w;
    }
    float* cE = (float*)(F.ws + WS_COSE); float* sE = (float*)(F.ws + WS_SINE); float* cO = (float*)(F.ws + WS_COSO); float* sO = (float*)(F.ws + WS_SINO);
    for (int i = F.bx * 512 + F.tid; i < 16384 * 24; i += F.G * 512) {
        const int pos = i / 24, f = i % 24;
        const float inv16[16] = {1.f, 0.440366596f, 0.193922743f, 0.0853971019f, 0.0376060307f, 0.016560439f, 0.00729266461f, 0.00321144587f, 0.00141421356f, 0.000622772379f, 0.000274248188f, 0.000120769735f, 5.3182961e-05f, 2.34199997e-05f, 1.03133862e-05f, 4.54167048e-06f};
        const int ff = f < 8 ? 2 * f : f - 8;
        float inv = 1.f;
#pragma unroll
        for (int q = 0; q < 16; ++q) inv = (ff == q) ? inv16[q] : inv;
        const float ang = (float)pos * inv; double sn, cs; sincos_d((double)ang, sn, cs);
        if (f < 8) { cE[pos * 8 + f] = (float)cs; sE[pos * 8 + f] = (float)sn; } else { cO[pos * 16 + (f - 8)] = (float)cs; sO[pos * 16 + (f - 8)] = (float)sn; }
    }
}

__device__ __forceinline__ void p_convert_weights(Frame& F, int layer) {
    const int j = layer >> 1; const bool even = !(layer & 1);
    bf16* Wb = (bf16*)(F.ws + WS_W);
    if (even) {
        const float* w_in = F.in[2] + (size_t)j * D * E_PROJ;
        convert_segment(F, w_in, D, E_PROJ, 0, 1280, (bf16*)((unsigned char*)Wb + W_IN), 0);
        convert_segment(F, w_in, D, E_PROJ, 1280, 3072, (bf16*)((unsigned char*)Wb + W_IN) + (size_t)1280 * D, 0);
        convert_segment(F, F.in[15] + (size_t)j * D * D, D, D, 0, D, (bf16*)((unsigned char*)Wb + W_OUT), 0);
    } else {
        convert_segment(F, F.in[16] + (size_t)j * D * O_PROJ, D, O_PROJ, 0, O_PROJ, (bf16*)((unsigned char*)Wb + W_IN), 0);
        convert_segment(F, F.in[17] + (size_t)j * D * D, D, D, 0, D, (bf16*)((unsigned char*)Wb + W_OUT), 0);
    }
    const float* wg = F.in[18] + (size_t)layer * D * DFF; const float* wu = F.in[19] + (size_t)layer * D * DFF;
    bf16* WGU = (bf16*)((unsigned char*)Wb + W_GU);
    {   LAS float* scr = (LAS float*)(F.lds + RING_OFF + F.wave * 16384);
        const int gw = F.bx * NWAVES + F.wave, NGW = F.G * NWAVES;
        const int nit = (D / 64) * (2 * DFF / 32);
        for (int it = gw; it < nit; it += NGW) { const int kb = it / 352, nb = it % 352;
            const int pn = nb >> 3, half = (nb >> 2) & 1, sub = nb & 3;
            transpose_item(half ? wu : wg, D, DFF, 128 * pn + 32 * sub, WGU, 32 * nb, scr, kb, 0, F.lane); }
    }
    convert_segment(F, F.in[20] + (size_t)layer * DFF * D, DFF, D, 0, D, (bf16*)((unsigned char*)Wb + W_DN), 0);
}

__device__ __forceinline__ void taps_tile(Frame& F, int j, int cls, int tile) {
    const int L = cls ? 4096 : 16384; const int i0 = tile * 64;
    LAS float* zf = (LAS float*)(F.lds + RING_OFF);
    LAS float* h1 = zf + 64 * 33;
    LAS float* h2 = h1 + 64 * 65;
    const float* w1 = F.in[6] + (size_t)j * 33 * 64; const float* b1 = F.in[7] + j * 64; const float* f1 = F.in[8] + j * 64;
    const float* w2 = F.in[9] + (size_t)j * 64 * 64; const float* b2 = F.in[10] + j * 64; const float* f2 = F.in[11] + j * 64;
    const float* w3 = F.in[12] + (size_t)j * 64 * 4096; const float* b3 = F.in[13] + (size_t)j * 4096;
    for (int idx = F.tid; idx < 64 * 33; idx += 512) { const int p = idx / 33, f = idx % 33, i = i0 + p; float val;
        if (f == 0) val = (float)i / (float)(L - 1);
        else { const int mm = (f - 1) & 15; const float band = 1e-4f + (float)mm * ((15.0f - 1e-4f) / 15.0f); const float w = 6.283185307179586f * (float)i / (float)L;
            float sn, cs; sincos_f(band * w, sn, cs); val = f <= 16 ? cs : -sn; }
        zf[p * 33 + f] = val; }
    __syncthreads();
    for (int idx = F.tid; idx < 64 * 64; idx += 512) { const int p = idx >> 6, k = idx & 63; float a = b1[k];
        for (int f = 0; f < 33; ++f) a += zf[p * 33 + f] * w1[f * 64 + k];
        h1[p * 65 + k] = sin_f(f1[k] * a); }
    __syncthreads();
    for (int idx = F.tid; idx < 64 * 64; idx += 512) { const int p = idx >> 6, k = idx & 63; float a = b2[k];
        for (int f = 0; f < 64; ++f) a += h1[p * 65 + f] * w2[f * 64 + k];
        h2[p * 65 + k] = sin_f(f2[k] * a); }
    __syncthreads();
    const int i = i0 + F.lane; const float ti = (float)i / (float)(L - 1);
    bf16* TAPS = (bf16*)(F.ws + WS_BIG + (cls ? B_TAP1 : B_TAP0));
    float* PS = (float*)(F.ws + WS_BIG + B_PSUM) + (cls ? (size_t)256 * 4096 : 0) + (size_t)tile * 4096;
    const float dmin = -3.0701134573253943f  , dmax = -15.350567286626973f  ;
    const LAS float* hrow = h2 + F.lane * 65;
#pragma unroll 1
    for (int cb = 0; cb < 512; cb += 4) { const int col = F.wave * 512 + cb;
        asm volatile("" ::: "memory");
        f32x4 a = *(const f32x4*)(b3 + col);
#pragma unroll 8
        for (int k = 0; k < 64; ++k) { const f32x4 wv = *(const f32x4*)(w3 + (size_t)k * 4096 + col); const float hk = hrow[k]; a += wv * hk; }
        const int dir = col >> 11, o = (col >> 10) & 1, ch0 = col & 1023;
#pragma unroll
        for (int e = 0; e < 4; ++e) { const int ch = ch0 + e; const float delta = fabsf(dmin + (dmax - dmin) * ((float)ch / 1023.0f));
            float val = a[e] * __expf(-ti * delta);
            bf16* tp = TAPS + ((size_t)(o * 1024 + ch)) * (2 * L);
            if (dir == 0) tp[L - i] = (bf16)f2bf(val);
            else { if (i >= 1) tp[L + i] = (bf16)f2bf(val); else { tp[0] = 0; val = 0.f; } }
            const float s = wave_sum(fabsf(val));
            if (F.lane == 0) PS[col + e] = s; }
    }
    __syncthreads();
}

__device__ __forceinline__ void p_layernorm(Frame& F, const float* gam, const float* bet) {
    bf16* XB = (bf16*)(F.ws + WS_XB);
    const int gw = F.bx * NWAVES + F.wave, NGW = F.G * NWAVES;
    f32x4 gv[8], bv[8];
#pragma unroll
    for (int q = 0; q < 8; ++q) { gv[q] = ((const f32x4*)gam)[F.lane + 64 * q]; bv[q] = ((const f32x4*)bet)[F.lane + 64 * q]; }
    for (int m = gw; m < M; m += NGW) {
        f32x4* xr = (f32x4*)(F.X + (size_t)m * D) + F.lane;
        f32x4 v[8]; float s = 0.f;
#pragma unroll
        for (int q = 0; q < 8; ++q) { v[q] = xr[64 * q]; s += (v[q][0] + v[q][1]) + (v[q][2] + v[q][3]); }
        const float mean = wave_sum(s) * (1.f / D); float s2 = 0.f;
#pragma unroll
        for (int q = 0; q < 8; ++q) { v[q] = v[q] - mean; s2 += (v[q][0] * v[q][0] + v[q][1] * v[q][1]) + (v[q][2] * v[q][2] + v[q][3] * v[q][3]); }
        const float rstd = 1.f / sqrtf(wave_sum(s2) * (1.f / D) + LN_EPS);
        unsigned long long* o8 = (unsigned long long*)(XB + (size_t)m * D) + F.lane;
#pragma unroll
        for (int q = 0; q < 8; ++q) { const f32x4 y = v[q] * rstd * gv[q] + bv[q]; xr[64 * q] = y;
            o8[64 * q] = (unsigned long long)pk2(y[0], y[1]) | ((unsigned long long)pk2(y[2], y[3]) << 32); }
    }
}

__device__ __forceinline__ void p_attn_even_naive(Frame& F, int j) {
    const bf16* Q = (const bf16*)(F.ws + WS_BIG + B_Q); const bf16* Kb = (const bf16*)(F.ws + WS_BIG + B_K); const bf16* Vb = (const bf16*)(F.ws + WS_BIG + B_V);
    bf16* AO = (bf16*)(F.ws + WS_XB);
    const float* sink = F.in[3] + j * 16;
    const int gw = F.bx * NWAVES + F.wave, NGW = F.G * NWAVES;
    for (int it = gw; it < M * 16; it += NGW) {
        const int tok = it >> 4, h = it & 15, kvh = h >> 3;
        const int sb = pg8::seq_base_of_row(tok), L = sb == 0 ? 16384 : 4096, pos = tok - sb;
        float sc[5]; bool ok[5];
#pragma unroll
        for (int c = 0; c < 5; ++c) sc[c] = 0.f;
        int kr[5];
#pragma unroll
        for (int c = 0; c < 5; ++c) { const int kp = pos - 128 + F.lane + 64 * c; ok[c] = (kp <= pos + 128) && kp >= 0 && kp < L; kr[c] = ok[c] ? sb + kp : tok; }
        for (int t = 0; t < 8; ++t) {
            const v4u qv = *(const v4u*)(Q + (size_t)tok * 1024 + h * 64 + 8 * t);
            float qf[8];
#pragma unroll
            for (int e = 0; e < 4; ++e) { qf[2 * e] = bf2f((unsigned short)(qv[e] & 0xffff)); qf[2 * e + 1] = bf2f((unsigned short)(qv[e] >> 16)); }
#pragma unroll
            for (int c = 0; c < 5; ++c) { const v4u kv = *(const v4u*)(Kb + (size_t)kr[c] * 128 + kvh * 64 + 8 * t);
#pragma unroll
                for (int e = 0; e < 4; ++e) sc[c] += qf[2 * e] * bf2f((unsigned short)(kv[e] & 0xffff)) + qf[2 * e + 1] * bf2f((unsigned short)(kv[e] >> 16)); }
        }
        const float sk = sink[h];
        float mx = sk;
#pragma unroll
        for (int c = 0; c < 5; ++c) { sc[c] = ok[c] ? sc[c] * 0.125f : -INFINITY; mx = fmaxf(mx, sc[c]); }
        mx = wave_max(mx);
        float p[5]; float ps = 0.f;
#pragma unroll
        for (int c = 0; c < 5; ++c) { p[c] = ok[c] ? __expf(sc[c] - mx) : 0.f; ps += p[c]; }
        const float den = wave_sum(ps) + __expf(sk - mx);
        float o = 0.f;
#pragma unroll
        for (int c = 0; c < 5; ++c)
            for (int l = 0; l < 64; ++l) { const float pl = __shfl(p[c], l); const int kp = pos - 128 + l + 64 * c;
                if (pl != 0.f) o += pl * bf2f(Vb[(size_t)(sb + kp) * 128 + kvh * 64 + F.lane]); }
        AO[(size_t)tok * D + h * 64 + F.lane] = (bf16)f2bf(o / den);
    }
}

__device__ __forceinline__ void p_attn_odd_naive(Frame& F) {
    bf16* QKV = (bf16*)(F.ws + WS_BIG); float* LSE = (float*)(F.ws + WS_LSE);
    const int gw = F.bx * NWAVES + F.wave, NGW = F.G * NWAVES;
    for (int it = gw; it < 3 * 16 * M; it += NGW) {
        const int prow = it % M, gh = it / M, g = gh >> 4, h = gh & 15;
        const int sb = pg8::seq_base_of_row(prow), L = sb == 0 ? 16384 : 4096, ls = L >> (2 * g);
        const int pp = prow - sb, rho = pp / ls, idx = pp - rho * ls;
        bf16* Qg = QKV + ((size_t)((0 * 3 + g) * 16 + h) * M) * 128; const bf16* Kg = QKV + ((size_t)((1 * 3 + g) * 16 + h) * M) * 128; const bf16* Vg = QKV + ((size_t)((2 * 3 + g) * 16 + h) * M) * 128;
        float sc[3]; bool ok[3]; int kr[3];
#pragma unroll
        for (int c = 0; c < 3; ++c) { const int ki = idx - 64 + F.lane + 64 * c; ok[c] = (ki <= idx + 64) && ki >= 0 && ki < ls; kr[c] = ok[c] ? sb + rho * ls + ki : prow; sc[c] = 0.f; }
        for (int t = 0; t < 16; ++t) {
            const v4u qv = *(const v4u*)(Qg + (size_t)prow * 128 + 8 * t);
            float qf[8];
#pragma unroll
            for (int e = 0; e < 4; ++e) { qf[2 * e] = bf2f((unsigned short)(qv[e] & 0xffff)); qf[2 * e + 1] = bf2f((unsigned short)(qv[e] >> 16)); }
#pragma unroll
            for (int c = 0; c < 3; ++c) { const v4u kv = *(const v4u*)(Kg + (size_t)kr[c] * 128 + 8 * t);
#pragma unroll
                for (int e = 0; e < 4; ++e) sc[c] += qf[2 * e] * bf2f((unsigned short)(kv[e] & 0xffff)) + qf[2 * e + 1] * bf2f((unsigned short)(kv[e] >> 16)); }
        }
        float mx = -INFINITY;
#pragma unroll
        for (int c = 0; c < 3; ++c) { sc[c] = ok[c] ? sc[c] * 0.08838834764831845f : -INFINITY; mx = fmaxf(mx, sc[c]); }
        mx = wave_max(mx);
        float p[3]; float ps = 0.f;
#pragma unroll
        for (int c = 0; c < 3; ++c) { p[c] = ok[c] ? __expf(sc[c] - mx) : 0.f; ps += p[c]; }
        const float den = wave_sum(ps);
        float o0 = 0.f, o1 = 0.f;
#pragma unroll
        for (int c = 0; c < 3; ++c)
            for (int l = 0; l < 64; ++l) { const float pl = __shfl(p[c], l); const int ki = idx - 64 + l + 64 * c;
                if (pl != 0.f) { const unsigned vv = *(const unsigned*)(Vg + (size_t)(sb + rho * ls + ki) * 128 + 2 * F.lane); o0 += pl * bf2f((unsigned short)(vv & 0xffff)); o1 += pl * bf2f((unsigned short)(vv >> 16)); } }
        const float inv = 1.f / den;
        *(unsigned*)(Qg + (size_t)prow * 128 + 2 * F.lane) = pk2(o0 * inv, o1 * inv);
        if (F.lane == 0) LSE[((size_t)g * M + prow) * 16 + h] = mx + __logf(den);
    }
}

__device__ __forceinline__ void p_combine_odd(Frame& F) {
    const bf16* QKV = (const bf16*)(F.ws + WS_BIG); const float* LSE = (const float*)(F.ws + WS_LSE); bf16* AO = (bf16*)(F.ws + WS_XB);
    for (int it = F.bx * 512 + F.tid; it < M * 256; it += F.G * 512) {
        const int tok = it >> 8, h = (it >> 4) & 15, ck = it & 15;
        const int sb = pg8::seq_base_of_row(tok), L = sb == 0 ? 16384 : 4096, pos = tok - sb;
        float l[3]; int pr[3];
#pragma unroll
        for (int g = 0; g < 3; ++g) { const int dsh = 2 * g; pr[g] = sb + (pos & ((1 << dsh) - 1)) * (L >> dsh) + (pos >> dsh); l[g] = LSE[((size_t)g * M + pr[g]) * 16 + h]; }
        const float mx = fmaxf(l[0], fmaxf(l[1], l[2]));
        float w[3]; float ws = 0.f;
#pragma unroll
        for (int g = 0; g < 3; ++g) { w[g] = __expf(l[g] - mx); ws += w[g]; }
        const float inv = 1.f / ws;
        float acc[8];
#pragma unroll
        for (int e = 0; e < 8; ++e) acc[e] = 0.f;
#pragma unroll
        for (int g = 0; g < 3; ++g) { const v4u ov = *(const v4u*)(QKV + ((size_t)(g * 16 + h) * M + pr[g]) * 128 + 8 * ck); const float wg = w[g] * inv;
#pragma unroll
            for (int e = 0; e < 4; ++e) { acc[2 * e] += wg * bf2f((unsigned short)(ov[e] & 0xffff)); acc[2 * e + 1] += wg * bf2f((unsigned short)(ov[e] >> 16)); } }
        v4u o; o.x = pk2(acc[0], acc[1]); o.y = pk2(acc[2], acc[3]); o.z = pk2(acc[4], acc[5]); o.w = pk2(acc[6], acc[7]);
        *(v4u*)(AO + (size_t)tok * D + h * 128 + 8 * ck) = o;
    }
}

template <int L> __device__ __forceinline__ void hyena_unit_naive(Frame& F, int j, int s, int ch) {
    constexpr int NQ = L / 512, cls = (L == 4096) ? 1 : 0, NT = L / 64;
    const int sb = seq_base(s);
    LAS bf16* tp = (LAS bf16*)(F.lds + RING_OFF); LAS bf16* vb = tp + 2 * L; LAS bf16* zb = vb + L;
    LAS float* red = (LAS float*)(F.lds + LDSCTL_OFF + 64);
    const bf16* HYT = (const bf16*)(F.ws + WS_BIG + B_HYT); bf16* ZT = (bf16*)(F.ws + WS_BIG + B_ZT);
    const bf16* TAPS = (const bf16*)(F.ws + WS_BIG + (cls ? B_TAP1 : B_TAP0));
    const float* PS = (const float*)(F.ws + WS_BIG + B_PSUM) + (cls ? (size_t)256 * 4096 : 0);
    const float* cw = F.in[4] + (size_t)j * 3 * 3072; const float* cb = F.in[5] + (size_t)j * 3072; const float* hb = F.in[14] + (size_t)j * 2 * 1024;
    if (F.wave < 2) { const int o = F.wave; float a = 0.f;
        for (int t = F.lane; t < NT; t += 64) a += PS[(size_t)t * 4096 + (0 * 2 + o) * 1024 + ch] + PS[(size_t)t * 4096 + (1 * 2 + o) * 1024 + ch];
        a = wave_sum(a); if (F.lane == 0) red[o] = a; }
    { const bf16* hr = HYT + (size_t)ch * M + sb; const float w0 = cw[0 * 3072 + ch], w1 = cw[1 * 3072 + ch], w2 = cw[2 * 3072 + ch], b = cb[ch];
      for (int i = F.tid; i < L; i += 512) { const float xm = i > 0 ? bf2f(hr[i - 1]) : 0.f, x0 = bf2f(hr[i]), xp = i < L - 1 ? bf2f(hr[i + 1]) : 0.f; vb[i] = (bf16)f2bf(b + w0 * xm + w1 * x0 + w2 * xp); } }
    __syncthreads();
#pragma unroll 1
    for (int o = 0; o < 2; ++o) {
        const bf16* tg = TAPS + (size_t)(o * 1024 + ch) * (2 * L);
        for (int i = F.tid; i < 2 * L / 8; i += 512) ((LAS v4u*)tp)[i] = ((const v4u*)tg)[i];
        __syncthreads();
        const LAS bf16* src = o == 0 ? vb : zb;
        float acc[NQ];
#pragma unroll
        for (int q = 0; q < NQ; ++q) acc[q] = 0.f;
        for (int jj = 0; jj < L; ++jj) { const float uj = bf2f(src[jj]); const LAS bf16* tq = tp + (L - F.tid + jj);
#pragma unroll
            for (int q = 0; q < NQ; ++q) acc[q] += bf2f(tq[-512 * q]) * uj; }
        const float invS = 1.f / red[o]; const float bias = hb[o * 1024 + ch];
        const int gch = (o == 0 ? 1024 : 2048) + ch;
        const bf16* hr = HYT + (size_t)gch * M + sb; const float w0 = cw[0 * 3072 + gch], w1 = cw[1 * 3072 + gch], w2 = cw[2 * 3072 + gch], b = cb[gch];
#pragma unroll
        for (int q = 0; q < NQ; ++q) { const int i = 512 * q + F.tid;
            const float xm = i > 0 ? bf2f(hr[i - 1]) : 0.f, x0 = bf2f(hr[i]), xp = i < L - 1 ? bf2f(hr[i + 1]) : 0.f; const float xg = b + w0 * xm + w1 * x0 + w2 * xp;
            const float y = acc[q] * invS + bias * bf2f(src[i]); const float z = xg * y;
            if (o == 0) zb[i] = (bf16)f2bf(z); else ZT[(size_t)ch * M + sb + i] = (bf16)f2bf(z); }
        __syncthreads();
    }
}


typedef float f32x16 __attribute__((ext_vector_type(16)));
typedef short s16x4 __attribute__((ext_vector_type(4)));
typedef unsigned u32x4_t __attribute__((ext_vector_type(4)));
template <int L, int TPW> __device__ __forceinline__ void hyena_unit_mfma(Frame& F, int j, int s, int ch0) {
    constexpr int NB = L / 32, NT = NB / 32, WPC = NT / TPW, NCH = NWAVES / WPC, cls = (L == 4096) ? 1 : 0, NTL = L / 64;
    constexpr int UBYTES = (NB + 64) * 80, TSTG = TPW * 2304;
    static_assert(NCH * UBYTES + NWAVES * TSTG <= RING_BYTES, "hyena LDS");
    const int sb = seq_base(s);
    const int w = F.wave, cidx = w / WPC, wl = w % WPC, lane = F.lane, i0 = lane & 31, h = lane >> 5;
    const int ch = ch0 + cidx;
    LAS unsigned char* Ub = F.lds + RING_OFF + cidx * UBYTES;
    LAS unsigned char* Tb = F.lds + RING_OFF + NCH * UBYTES + w * TSTG;
    LAS float* red = (LAS float*)(F.lds + LDSCTL_OFF + 64);
    const bf16* HYT = (const bf16*)(F.ws + WS_BIG + B_HYT); bf16* ZT = (bf16*)(F.ws + WS_BIG + B_ZT);
    const bf16* TAPS = (const bf16*)(F.ws + WS_BIG + (cls ? B_TAP1 : B_TAP0));
    const float* PS = (const float*)(F.ws + WS_BIG + B_PSUM) + (cls ? (size_t)256 * 4096 : 0);
    const float* cw = F.in[4] + (size_t)j * 3 * 3072; const float* cb = F.in[5] + (size_t)j * 3072; const float* hb = F.in[14] + (size_t)j * 2 * 1024;
    if (w < 2 * NCH) { const int cc = w >> 1, o = w & 1, chh = ch0 + cc; float a = 0.f;
        for (int t = lane; t < NTL; t += 64) a += PS[(size_t)t * 4096 + (0 * 2 + o) * 1024 + chh] + PS[(size_t)t * 4096 + (1 * 2 + o) * 1024 + chh];
        a = wave_sum(a); if (lane == 0) red[w] = a; }
#pragma unroll 1
    for (int cc = 0; cc < NCH; ++cc) { const int chh = ch0 + cc; LAS bf16* Ue = (LAS bf16*)(F.lds + RING_OFF + cc * UBYTES);
        const bf16* hr = HYT + (size_t)chh * M + sb; const float w0 = cw[0 * 3072 + chh], w1 = cw[1 * 3072 + chh], w2 = cw[2 * 3072 + chh], b = cb[chh];
        for (int el = F.tid; el < (NB + 64) * 40; el += 512) { const int blk = el / 40, j0 = el - blk * 40, p = (blk - 32) * 32 + j0; float val = 0.f;
            if (j0 < 32 && p >= 0 && p < L) { const float xm = p > 0 ? bf2f(hr[p - 1]) : 0.f, x0 = bf2f(hr[p]), xp = p < L - 1 ? bf2f(hr[p + 1]) : 0.f; val = b + w0 * xm + w1 * x0 + w2 * xp; }
            Ue[el] = (bf16)f2bf(val); } }
    __syncthreads();
    const int c4 = i0 & 3;
    int o8 = 8, o32 = 32, o40 = 40; asm volatile("" : "+v"(o8), "+v"(o32), "+v"(o40));
    const int abase = c4 * 576 + 16 * h - 2 * (i0 & ~3);
    const int bbase = (i0 + 32) * 80 + 16 * h;
    unsigned zpk[TPW][4][2];
#pragma unroll 1
    for (int o = 0; o < 2; ++o) {
        f32x16 acc[TPW];
#pragma unroll
        for (int t = 0; t < TPW; ++t)
#pragma unroll
            for (int r = 0; r < 16; ++r) acc[t][r] = 0.f;
        const bf16* TRg = TAPS + (size_t)(o * 1024 + ch) * (2 * L);
        v4u Xr[TPW], Pr[TPW];
#pragma unroll
        for (int t = 0; t < TPW; ++t) { const int n0 = 32 * (wl * TPW + t), wbase = L - 32 * (n0 - NB + 8);
            int xi = wbase + 8 * lane, pi = xi - 8; xi = xi < 0 ? 0 : (xi > 2 * L - 8 ? 2 * L - 8 : xi); pi = pi < 0 ? 0 : (pi > 2 * L - 8 ? 2 * L - 8 : pi);
            if (lane < 36) { Xr[t] = *(const v4u*)(TRg + xi); Pr[t] = *(const v4u*)(TRg + pi); } }
#pragma unroll 1
        for (int e0 = -NB; e0 < 32; e0 += 8) {
#pragma unroll
            for (int t = 0; t < TPW; ++t) {
                if (lane < 36) { const v4u X = Xr[t], P = Pr[t];
                    const unsigned a0 = __builtin_amdgcn_alignbit(X.x, P.w, 16), a1 = __builtin_amdgcn_alignbit(X.y, X.x, 16), a2 = __builtin_amdgcn_alignbit(X.z, X.y, 16), a3 = __builtin_amdgcn_alignbit(X.w, X.z, 16), a4 = __builtin_amdgcn_alignbit(P.w, P.z, 16);
                    LAS unsigned char* dst = Tb + t * 2304 + 16 * lane;
                    *(LAS v4u*)(dst) = X;
                    *(LAS v4u*)(dst + 576) = (v4u){a0, a1, a2, a3};
                    *(LAS v4u*)(dst + 1152) = (v4u){P.w, X.x, X.y, X.z};
                    *(LAS v4u*)(dst + 1728) = (v4u){a4, a0, a1, a2}; } }
            if (e0 + 8 < 32) {
#pragma unroll
                for (int t = 0; t < TPW; ++t) { const int n0 = 32 * (wl * TPW + t), wbase = L - 32 * (n0 + e0 + 16);
                    int xi = wbase + 8 * lane, pi = xi - 8; xi = xi < 0 ? 0 : (xi > 2 * L - 8 ? 2 * L - 8 : xi); pi = pi < 0 ? 0 : (pi > 2 * L - 8 ? 2 * L - 8 : pi);
                    if (lane < 36) { Xr[t] = *(const v4u*)(TRg + xi); Pr[t] = *(const v4u*)(TRg + pi); } } }
            const LAS unsigned char* bp = Ub + bbase - (e0 + 7) * 80;
            bf16x8 Bf[2][2]; s16x4 Al[2][TPW][2], Ah[2][TPW][2];
#define HY_LOAD(buf, dl) do { _Pragma("unroll") for (int ks = 0; ks < 2; ++ks) Bf[buf][ks] = *(const LAS bf16x8*)(bp + 80 * (7 - (dl)) + 32 * ks); \
                _Pragma("unroll") for (int t = 0; t < TPW; ++t) { const LAS unsigned char* ap = Tb + t * 2304 + abase + 64 * (8 - (dl)); \
                    Al[buf][t][0] = *(const LAS s16x4*)ap; Ah[buf][t][0] = *(const LAS s16x4*)(ap + o8); Al[buf][t][1] = *(const LAS s16x4*)(ap + o32); Ah[buf][t][1] = *(const LAS s16x4*)(ap + o40); } \
                asm volatile("" ::: "memory"); } while (0)
            HY_LOAD(0, 0);
#pragma unroll
            for (int dl = 0; dl < 8; ++dl) {
                if (dl < 7) HY_LOAD((dl + 1) & 1, dl + 1);
#pragma unroll
                for (int ks = 0; ks < 2; ++ks)
#pragma unroll
                    for (int t = 0; t < TPW; ++t) { const bf16x8 Af = __builtin_shufflevector(Al[dl & 1][t][ks], Ah[dl & 1][t][ks], 0, 1, 2, 3, 4, 5, 6, 7);
                        acc[t] = __builtin_amdgcn_mfma_f32_32x32x16_bf16(Af, Bf[dl & 1][ks], acc[t], 0, 0, 0); }
            }
#undef HY_LOAD
        }
        int i0e = i0, he = h; asm volatile("" : "+v"(i0e), "+v"(he));
        const float invS = 1.f / red[2 * cidx + o]; const float bias = hb[o * 1024 + ch];
        const int gch = (o == 0 ? 1024 : 2048) + ch;
        const bf16* hr = HYT + (size_t)gch * M + sb; const float w0 = cw[0 * 3072 + gch], w1 = cw[1 * 3072 + gch], w2 = cw[2 * 3072 + gch], b = cb[gch];
#pragma unroll
        for (int t = 0; t < TPW; ++t) { const int n0 = 32 * (wl * TPW + t);
#pragma unroll
            for (int rg = 0; rg < 4; ++rg) { const int p = 32 * (n0 + i0e) + 8 * rg + 4 * he;
                const s16x4 uu = *(const LAS s16x4*)(Ub + ((p >> 5) + 32) * 80 + (p & 31) * 2);
                float hx[6];
#pragma unroll
                for (int q = 0; q < 6; ++q) { const int pp = p - 1 + q; hx[q] = (pp >= 0 && pp < L) ? bf2f(hr[pp]) : 0.f; }
                float z[4];
#pragma unroll
                for (int q = 0; q < 4; ++q) { const float gate = b + w0 * hx[q] + w1 * hx[q + 1] + w2 * hx[q + 2];
                    const float y = acc[t][4 * rg + q] * invS + bias * bf2f((unsigned short)uu[q]); z[q] = gate * y; }
                if (o == 0) { zpk[t][rg][0] = pk2(z[0], z[1]); zpk[t][rg][1] = pk2(z[2], z[3]); }
                else { unsigned long long wv = (unsigned long long)pk2(z[0], z[1]) | ((unsigned long long)pk2(z[2], z[3]) << 32); *(unsigned long long*)(ZT + (size_t)ch * M + sb + p) = wv; }
                asm volatile("" ::: "memory"); }
        }
        __syncthreads();
        if (o == 0) {
#pragma unroll
            for (int t = 0; t < TPW; ++t) { const int n0 = 32 * (wl * TPW + t);
#pragma unroll
                for (int rg = 0; rg < 4; ++rg) { const int p = 32 * (n0 + i0e) + 8 * rg + 4 * he;
                    *(LAS unsigned long long*)(Ub + ((p >> 5) + 32) * 80 + (p & 31) * 2) = (unsigned long long)zpk[t][rg][0] | ((unsigned long long)zpk[t][rg][1] << 32); } }
            __syncthreads();
        }
    }
}


typedef short v4i16_t __attribute__((ext_vector_type(4)));
typedef float f32x2_t __attribute__((ext_vector_type(2))); typedef __bf16 bf16x2_t __attribute__((ext_vector_type(2)));
__device__ __forceinline__ unsigned cvtpk_rne(float lo, float hi) { f32x2_t v = {lo, hi}; bf16x2_t b = __builtin_convertvector(v, bf16x2_t); return __builtin_bit_cast(unsigned, b); }
__device__ __forceinline__ s16x4 vtr_read(const LAS unsigned char* p) { return __builtin_bit_cast(s16x4, __builtin_amdgcn_ds_read_tr16_b64_v4i16((LAS v4i16_t*)p)); }
__device__ __forceinline__ int crow32(int r, int h) { return (r & 3) + 8 * (r >> 2) + 4 * h; }
template <int NR, int CPR, int LP> __device__ __forceinline__ void stage_rows(LAS unsigned char* dst, const bf16* base, size_t gp, int wr0, int lo, int hi, int tid) {
    for (int idx = tid; idx < NR * CPR; idx += 512) { const int r = idx / CPR, ck = idx % CPR, grow = wr0 + r;
        v4u v = {0u, 0u, 0u, 0u}; if (grow >= lo && grow < hi) v = *(const v4u*)(base + (size_t)grow * gp + ck * 8);
        *(LAS v4u*)(dst + r * LP + ck * 16) = v; }
}
template <int HD, int NT, int RAD, int KP> __device__ __forceinline__ void attn_scores(f32x16 (&S)[NT], const LAS unsigned char* Kw, const bf16x8 (&Qf)[HD / 16], int q, int h, int ki0, int lo, int hi, float scale_l2, float sink_l2, bool has_sink, float& m_out, float& den_out) {
#pragma unroll
    for (int t = 0; t < NT; ++t) {
#pragma unroll
        for (int r = 0; r < 16; ++r) S[t][r] = 0.f;
#pragma unroll
        for (int ks = 0; ks < HD / 16; ++ks) { const bf16x8 Af = *(const LAS bf16x8*)(Kw + (32 * t + q) * KP + 32 * ks + 16 * h); S[t] = __builtin_amdgcn_mfma_f32_32x32x16_bf16(Af, Qf[ks], S[t], 0, 0, 0); }
    }
    float m = has_sink ? sink_l2 : -1e30f;
#pragma unroll
    for (int t = 0; t < NT; ++t)
#pragma unroll
        for (int r = 0; r < 16; ++r) { const int kv = 32 * t + crow32(r, h); const int rel = kv - RAD - q; const int ki = ki0 + kv;
            const bool ok = (rel >= -RAD) && (rel <= RAD) && (ki >= lo) && (ki < hi);
            const float sv = ok ? S[t][r] * scale_l2 : -1e30f; S[t][r] = sv; m = fmaxf(m, sv); }
    m = fmaxf(m, __shfl_xor(m, 32));
    float den = 0.f;
#pragma unroll
    for (int t = 0; t < NT; ++t)
#pragma unroll
        for (int r = 0; r < 16; ++r) { const float p = __builtin_amdgcn_exp2f(S[t][r] - m); S[t][r] = p; den += p; }
    den += __shfl_xor(den, 32);
    if (has_sink) den += __builtin_amdgcn_exp2f(sink_l2 - m);
    m_out = m; den_out = den;
}
template <int HD, int NT, int VP> __device__ __forceinline__ void attn_pv(f32x16 (&O)[HD / 32], const f32x16 (&S)[NT], const LAS unsigned char* Vw, int lane) {
    const int G = lane >> 4, i = lane & 15, h = lane >> 5;
    const LAS unsigned char* vb = Vw + (4 * h + (i >> 2)) * VP + (16 * (G & 1) + 4 * (i & 3)) * 2;
#pragma unroll
    for (int db = 0; db < HD / 32; ++db)
#pragma unroll
        for (int r = 0; r < 16; ++r) O[db][r] = 0.f;
#pragma unroll
    for (int t = 0; t < NT; ++t)
#pragma unroll
        for (int s2 = 0; s2 < 2; ++s2) {
            u32x4_t pw; pw.x = cvtpk_rne(S[t][8 * s2 + 0], S[t][8 * s2 + 1]); pw.y = cvtpk_rne(S[t][8 * s2 + 2], S[t][8 * s2 + 3]); pw.z = cvtpk_rne(S[t][8 * s2 + 4], S[t][8 * s2 + 5]); pw.w = cvtpk_rne(S[t][8 * s2 + 6], S[t][8 * s2 + 7]);
            const bf16x8 Pf = __builtin_bit_cast(bf16x8, pw);
#pragma unroll
            for (int db = 0; db < HD / 32; ++db) { const LAS unsigned char* vp = vb + (32 * t + 16 * s2) * VP + 64 * db;
                const s16x4 lo = vtr_read(vp), hi4 = vtr_read(vp + 8 * VP);
                const bf16x8 Af = __builtin_shufflevector(lo, hi4, 0, 1, 2, 3, 4, 5, 6, 7);
                O[db] = __builtin_amdgcn_mfma_f32_32x32x16_bf16(Af, Pf, O[db], 0, 0, 0); }
        }
}


template <int HD, int NT, int RAD, int KP, int VP> __device__ __forceinline__ void attn_online(f32x16 (&O)[HD / 32], const LAS unsigned char* Kw, const LAS unsigned char* Vw, const bf16x8 (&Qf)[HD / 16], int lane, int ki0, int lo, int hi, float scale_l2, float m0, float& m_out, float& den_out) {
    const int q = lane & 31, h = lane >> 5, G = lane >> 4, i = lane & 15;
    const LAS unsigned char* vb = Vw + (4 * h + (i >> 2)) * VP + (16 * (G & 1) + 4 * (i & 3)) * 2;
    float m = m0, den = 0.f;
#pragma unroll
    for (int db = 0; db < HD / 32; ++db)
#pragma unroll
        for (int r = 0; r < 16; ++r) O[db][r] = 0.f;
#pragma unroll
    for (int t = 0; t < NT; ++t) {
        f32x16 St;
#pragma unroll
        for (int r = 0; r < 16; ++r) St[r] = 0.f;
#pragma unroll
        for (int ks = 0; ks < HD / 16; ++ks) { const bf16x8 Af = *(const LAS bf16x8*)(Kw + (32 * t + q) * KP + 32 * ks + 16 * h); St = __builtin_amdgcn_mfma_f32_32x32x16_bf16(Af, Qf[ks], St, 0, 0, 0); }
        float tm = -1e30f;
#pragma unroll
        for (int r = 0; r < 16; ++r) { const int kv = 32 * t + crow32(r, h); const int rel = kv - RAD - q; const int ki = ki0 + kv;
            const bool ok = (rel >= -RAD) && (rel <= RAD) && (ki >= lo) && (ki < hi);
            const float sv = ok ? St[r] * scale_l2 : -1e30f; St[r] = sv; tm = fmaxf(tm, sv); }
        tm = fmaxf(tm, __shfl_xor(tm, 32));
        const float mn = fmaxf(m, tm), alpha = __builtin_amdgcn_exp2f(m - mn); m = mn;
        float ps = 0.f;
#pragma unroll
        for (int r = 0; r < 16; ++r) { const float p = __builtin_amdgcn_exp2f(St[r] - m); St[r] = p; ps += p; }
        den = den * alpha + ps;
#pragma unroll
        for (int db = 0; db < HD / 32; ++db)
#pragma unroll
            for (int r = 0; r < 16; ++r) O[db][r] *= alpha;
#pragma unroll
        for (int s2 = 0; s2 < 2; ++s2) {
            u32x4_t pw; pw.x = cvtpk_rne(St[8 * s2 + 0], St[8 * s2 + 1]); pw.y = cvtpk_rne(St[8 * s2 + 2], St[8 * s2 + 3]); pw.z = cvtpk_rne(St[8 * s2 + 4], St[8 * s2 + 5]); pw.w = cvtpk_rne(St[8 * s2 + 6], St[8 * s2 + 7]);
            const bf16x8 Pf = __builtin_bit_cast(bf16x8, pw);
#pragma unroll
            for (int db = 0; db < HD / 32; ++db) { const LAS unsigned char* vp = vb + (32 * t + 16 * s2) * VP + 64 * db;
                const s16x4 lo4 = vtr_read(vp), hi4 = vtr_read(vp + 8 * VP);
                const bf16x8 Af = __builtin_shufflevector(lo4, hi4, 0, 1, 2, 3, 4, 5, 6, 7);
                O[db] = __builtin_amdgcn_mfma_f32_32x32x16_bf16(Af, Pf, O[db], 0, 0, 0); }
        }
    }
    den += __shfl_xor(den, 32);
    m_out = m; den_out = den;
}

__device__ __forceinline__ void attn_odd_unit(Frame& F, int g, int head, int R0) {
    constexpr int KP = 272, VP = 320, NT = 5, RAD = 64;
    bf16* QKV = (bf16*)(F.ws + WS_BIG); float* LSE = (float*)(F.ws + WS_LSE);
    bf16* Qg = QKV + ((size_t)((0 * 3 + g) * 16 + head) * M) * 128; const bf16* Kg = QKV + ((size_t)((1 * 3 + g) * 16 + head) * M) * 128; const bf16* Vg = QKV + ((size_t)((2 * 3 + g) * 16 + head) * M) * 128;
    const int sb = pg8::seq_base_of_row(R0), L = sb == 0 ? 16384 : 4096, ls = L >> (2 * g);
    const int seglo = sb + ((R0 - sb) / ls) * ls, seghi = seglo + ls;
    LAS unsigned char* img = F.lds + RING_OFF;
    int lane = F.lane; asm volatile("" : "+v"(lane));
    const int q = lane & 31, h = lane >> 5, w = F.wave;
    stage_rows<384, 16, KP>(img, Kg, 128, R0 - 64, seglo, seghi, F.tid);
    const int qrow = R0 + 32 * w + q;
    bf16x8 Qf[8];
#pragma unroll
    for (int ks = 0; ks < 8; ++ks) Qf[ks] = *(const bf16x8*)(Qg + (size_t)qrow * 128 + 16 * ks + 8 * h);
    __syncthreads();
    f32x16 S[NT]; float m, den;
    attn_scores<128, NT, RAD, KP>(S, img + (32 * w) * KP, Qf, q, h, R0 + 32 * w - 64, seglo, seghi, 0.08838834764831845f * 1.4426950408889634f, 0.f, false, m, den);
    __syncthreads();
    stage_rows<384, 16, VP>(img, Vg, 128, R0 - 64, seglo, seghi, F.tid);
    __syncthreads();
    f32x16 O[4];
    attn_pv<128, NT, VP>(O, S, img + (32 * w) * VP, lane);
    const float inv = 1.f / den;
#pragma unroll
    for (int db = 0; db < 4; ++db)
#pragma unroll
        for (int rg = 0; rg < 4; ++rg) { const unsigned long long wv = (unsigned long long)cvtpk_rne(O[db][4 * rg] * inv, O[db][4 * rg + 1] * inv) | ((unsigned long long)cvtpk_rne(O[db][4 * rg + 2] * inv, O[db][4 * rg + 3] * inv) << 32);
            *(unsigned long long*)(Qg + (size_t)qrow * 128 + 32 * db + 8 * rg + 4 * h) = wv; }
    if (h == 0) LSE[((size_t)g * M + qrow) * 16 + head] = (m + __builtin_amdgcn_logf(den)) * 0.6931471805599453f;
    __syncthreads();
}
__device__ __forceinline__ void p_attn_odd_mfma(Frame& F) {
    for (int u = F.bx; u < 3 * 16 * (M / 256); u += F.G) { const int rb = u % (M / 256), gh = u / (M / 256); attn_odd_unit(F, gh >> 4, gh & 15, rb * 256); }
}

__device__ __forceinline__ void attn_even_unit(Frame& F, int j, int kvh, int R0) {
    constexpr int KP = 144, VP = 192, NT = 9, RAD = 128;
    const bf16* Q = (const bf16*)(F.ws + WS_BIG + B_Q); const bf16* Kb = (const bf16*)(F.ws + WS_BIG + B_K); const bf16* Vb = (const bf16*)(F.ws + WS_BIG + B_V);
    bf16* AO = (bf16*)(F.ws + WS_XB);
    const int sb = pg8::seq_base_of_row(R0), L = sb == 0 ? 16384 : 4096;
    LAS unsigned char* kimg = F.lds + RING_OFF; LAS unsigned char* vimg = kimg + 288 * KP;
    int lane = F.lane; asm volatile("" : "+v"(lane));
    const int q = lane & 31, h = lane >> 5, w = F.wave, head = kvh * 8 + w;
    stage_rows<288, 8, KP>(kimg, Kb + kvh * 64, 128, R0 - 128, sb, sb + L, F.tid);
    stage_rows<288, 8, VP>(vimg, Vb + kvh * 64, 128, R0 - 128, sb, sb + L, F.tid);
    const int qrow = R0 + q;
    bf16x8 Qf[4];
#pragma unroll
    for (int ks = 0; ks < 4; ++ks) Qf[ks] = *(const bf16x8*)(Q + (size_t)qrow * 1024 + head * 64 + 16 * ks + 8 * h);
    const float sink_l2 = (F.in[3] + j * 16)[head] * 1.4426950408889634f;
    __syncthreads();
    float m, den; f32x16 O[2];
    attn_online<64, NT, RAD, KP, VP>(O, kimg, vimg, Qf, lane, R0 - 128, sb, sb + L, 0.125f * 1.4426950408889634f, sink_l2, m, den);
    den += __builtin_amdgcn_exp2f(sink_l2 - m);
    const float inv = 1.f / den;
#pragma unroll
    for (int db = 0; db < 2; ++db)
#pragma unroll
        for (int rg = 0; rg < 4; ++rg) { const unsigned long long wv = (unsigned long long)cvtpk_rne(O[db][4 * rg] * inv, O[db][4 * rg + 1] * inv) | ((unsigned long long)cvtpk_rne(O[db][4 * rg + 2] * inv, O[db][4 * rg + 3] * inv) << 32);
            *(unsigned long long*)(AO + (size_t)qrow * D + head * 64 + 32 * db + 8 * rg + 4 * h) = wv; }
    __syncthreads();
}
__device__ __forceinline__ void p_attn_even_mfma(Frame& F, int j) {
    for (int u = F.bx; u < 2 * (M / 32); u += F.G) attn_even_unit(F, j, u & 1, (u >> 1) * 32);
}


__device__ __forceinline__ void taps_unit_mfma(Frame& F, int j, int cls, int tile, int cq) {
    const int L = cls ? 4096 : 16384; const int i0 = tile * 64;
    LAS float* zf = (LAS float*)(F.lds + RING_OFF);
    LAS float* h1 = zf + 64 * 33;
    LAS unsigned char* h2b = (LAS unsigned char*)(h1 + 64 * 65);
    const float* w1 = F.in[6] + (size_t)j * 33 * 64; const float* b1 = F.in[7] + j * 64; const float* f1 = F.in[8] + j * 64;
    const float* w2 = F.in[9] + (size_t)j * 64 * 64; const float* b2 = F.in[10] + j * 64; const float* f2 = F.in[11] + j * 64;
    const float* w3 = F.in[12] + (size_t)j * 64 * 4096; const float* b3 = F.in[13] + (size_t)j * 4096;
    for (int idx = F.tid; idx < 64 * 33; idx += 512) { const int p = idx / 33, f = idx % 33, i = i0 + p; float val;
        if (f == 0) val = (float)i / (float)(L - 1);
        else { const int mm = (f - 1) & 15; const float band = 1e-4f + (float)mm * ((15.0f - 1e-4f) / 15.0f); const float w = 6.283185307179586f * (float)i / (float)L;
            float sn, cs; sincos_f(band * w, sn, cs); val = f <= 16 ? cs : -sn; }
        zf[p * 33 + f] = val; }
    __syncthreads();
    for (int idx = F.tid; idx < 64 * 64; idx += 512) { const int p = idx >> 6, k = idx & 63; float a = b1[k];
        for (int f = 0; f < 33; ++f) a += zf[p * 33 + f] * w1[f * 64 + k];
        h1[p * 65 + k] = sin_f(f1[k] * a); }
    __syncthreads();
    for (int idx = F.tid; idx < 64 * 64; idx += 512) { const int p = idx >> 6, k = idx & 63; float a = b2[k];
        for (int f = 0; f < 64; ++f) a += h1[p * 65 + f] * w2[f * 64 + k];
        *(LAS bf16*)(h2b + p * 144 + k * 2) = (bf16)f2bf(sin_f(f2[k] * a)); }
    __syncthreads();
    int lane = F.lane; asm volatile("" : "+v"(lane));
    const int pos = lane & 31, h = lane >> 5;
    bf16* TAPS = (bf16*)(F.ws + WS_BIG + (cls ? B_TAP1 : B_TAP0));
    float* PS = (float*)(F.ws + WS_BIG + B_PSUM) + (cls ? (size_t)256 * 4096 : 0) + (size_t)tile * 4096;
    const float dmin = -3.0701134573253943f, dmax = -15.350567286626973f;
#pragma unroll 1
    for (int cbi = 0; cbi < 4; ++cbi) { const int col0 = cq * 1024 + F.wave * 128 + cbi * 32;
        bf16x8 Af[4];
#pragma unroll
        for (int ks = 0; ks < 4; ++ks) { float wv[8];
#pragma unroll
            for (int q = 0; q < 8; ++q) wv[q] = w3[(size_t)(16 * ks + 8 * h + q) * 4096 + col0 + pos];
            u32x4_t pw; pw.x = cvtpk_rne(wv[0], wv[1]); pw.y = cvtpk_rne(wv[2], wv[3]); pw.z = cvtpk_rne(wv[4], wv[5]); pw.w = cvtpk_rne(wv[6], wv[7]); Af[ks] = __builtin_bit_cast(bf16x8, pw); }
        const int dir = col0 >> 11, o = (col0 >> 10) & 1, chb = col0 & 1023;
        float asum[16];
#pragma unroll
        for (int r = 0; r < 16; ++r) asum[r] = 0.f;
#pragma unroll
        for (int pt = 0; pt < 2; ++pt) { f32x16 acc;
#pragma unroll
            for (int r = 0; r < 16; ++r) acc[r] = 0.f;
#pragma unroll
            for (int ks = 0; ks < 4; ++ks) { const bf16x8 Bf = *(const LAS bf16x8*)(h2b + (pt * 32 + pos) * 144 + 32 * ks + 16 * h); acc = __builtin_amdgcn_mfma_f32_32x32x16_bf16(Af[ks], Bf, acc, 0, 0, 0); }
            const int i = i0 + pt * 32 + pos; const float ti = (float)i / (float)(L - 1) * 1.4426950408889634f;
#pragma unroll
            for (int r = 0; r < 16; ++r) { const int cl = crow32(r, h), col = col0 + cl, ch = chb + cl;
                const float delta = fabsf(dmin + (dmax - dmin) * ((float)ch / 1023.0f));
                float val = (acc[r] + b3[col]) * __builtin_amdgcn_exp2f(-ti * delta);
                bf16* tp = TAPS + ((size_t)(o * 1024 + ch)) * (2 * L);
                if (dir == 0) tp[L - i] = (bf16)f2bf(val);
                else { if (i >= 1) tp[L + i] = (bf16)f2bf(val); else { tp[0] = 0; val = 0.f; } }
                asum[r] += fabsf(val); }
        }
#pragma unroll
        for (int r = 0; r < 16; ++r) { float s = asum[r]; s += __shfl_xor(s, 1); s += __shfl_xor(s, 2); s += __shfl_xor(s, 4); s += __shfl_xor(s, 8); s += __shfl_xor(s, 16);
            if (pos == 0) PS[col0 + crow32(r, h)] = s; }
    }
    __syncthreads();
}

__device__ __forceinline__ void p_zt_transpose(Frame& F) {
    const bf16* ZT = (const bf16*)(F.ws + WS_BIG + B_ZT); bf16* AO = (bf16*)(F.ws + WS_XB);
    for (int it = F.bx * 512 + F.tid; it < M * 128; it += F.G * 512) {
        const int tok = it % M, cg = it / M;
        unsigned short v[8];
#pragma unroll
        for (int e = 0; e < 8; ++e) v[e] = ZT[(size_t)(cg * 8 + e) * M + tok];
        v4u o; o.x = v[0] | ((unsigned)v[1] << 16); o.y = v[2] | ((unsigned)v[3] << 16); o.z = v[4] | ((unsigned)v[5] << 16); o.w = v[6] | ((unsigned)v[7] << 16);
        *(v4u*)(AO + (size_t)tok * D + 1024 + cg * 8) = o;
    }
}

#ifndef MK_TAPS_NAIVE
#define MK_TAPS_NAIVE 0
#endif
#ifndef MK_PROBE_REP
#define MK_PROBE_REP -1
#endif
#ifndef MK_ATTN_NAIVE
#define MK_ATTN_NAIVE 0
#endif
#ifndef MK_HYENA_NAIVE
#define MK_HYENA_NAIVE 0
#endif
#ifndef MK_MASK
#define MK_MASK 0xFFFFF
#endif
#define HAS(b) ((MK_MASK >> (b)) & 1)
struct Args { const float* in[25]; float* out; unsigned char* ws; int ph_lo, ph_hi; };
__global__ void __launch_bounds__(NWAVES * 64, 2) mk_fwd(Args args) {
    extern __shared__ __attribute__((aligned(16))) unsigned char lds[];
    Frame F;
    F.lds = (LAS unsigned char*)lds;
    F.MISC = (volatile LAS unsigned*)(F.lds + MISC_OFF);
    F.tid = threadIdx.x; F.lane = F.tid & 63; F.wave = __builtin_amdgcn_readfirstlane(F.tid >> 6);
    F.G = gridDim.x; F.bx = blockIdx.x;
    F.ws = args.ws; F.ctl = (gu32*)(args.ws + WS_CTL); F.X = args.out;
    for (int u = F.tid; u < (LDS_BYTES - LDSCTL_OFF) / 4; u += NWAVES * 64) ((LAS unsigned*)(F.lds + LDSCTL_OFF))[u] = 0u;
    __syncthreads();
    const int lo = args.ph_lo, hi = args.ph_hi;
    XcdBarrier bar; bar.bar = (unsigned*)(F.ctl + CW_BAR); bar.x = 0; bar.st = nullptr;
    if (hi - lo > 1) bar = xcd_barrier_post((unsigned*)(F.ctl + CW_BAR), F.MISC + 8);
#define IN(k) (lo <= (k) && (k) < hi)
#define SEAM(k) do { if ((k) + 1 < hi) xcd_barrier(bar); } while (0)
#define XB ((bf16*)(F.ws + WS_XB))
#define Wb ((bf16*)(F.ws + WS_W))
#define BIG (F.ws + WS_BIG)

    if (HAS(0) && IN(0)) p_input(F);
    for (int layer = 0; layer < DEPTH; ++layer) {
        const int pb = layer * PH_PER_LAYER; const bool even = !(layer & 1); const int j = layer >> 1;
#define FRESH() do { int l_; asm volatile("v_mbcnt_lo_u32_b32 %0, -1, 0\n\tv_mbcnt_hi_u32_b32 %0, -1, %0" : "=v"(l_)); int bx_ = blockIdx.x; asm volatile("" : "+s"(bx_)); F.bx = bx_; F.lane = l_; F.tid = F.wave * 64 + l_; unsigned char* w_ = args.ws; float* x_ = args.out; asm volatile("" : "+s"(w_), "+s"(x_)); F.ws = w_; F.X = x_; } while (0)
#define BODY0 do { p_convert_weights(F, layer); __syncthreads(); \
            if (even) { if (MK_TAPS_NAIVE) { for (int t = F.bx; t < 320; t += F.G) { if (t < 256) taps_tile(F, j, 0, t); else taps_tile(F, j, 1, t - 256); } } \
                        else { for (int u = F.bx; u < 1280; u += F.G) { const int t = u >> 2; if (t < 256) taps_unit_mfma(F, j, 0, t, u & 3); else taps_unit_mfma(F, j, 1, t - 256, u & 3); } } } } while (0)
#define BODY1 do { if (even) { \
                { pg8::Gemm g{XB, (const bf16*)((unsigned char*)Wb + W_IN), M, 1280, D}; pg8::StaticOrder S; S.init(M, 1280, F.G, F.bx); \
                  pg8::EpiEvenQKV E{(bf16*)(BIG + B_Q), (bf16*)(BIG + B_K), (bf16*)(BIG + B_V), (const float*)(F.ws + WS_COSE), (const float*)(F.ws + WS_SINE)}; \
                  pg8::gemm_phase<pg8::EpiEvenQKV, pg8::StaticOrder, true, true>(F.lds + RING_OFF, g, S, E, F.wave); } \
                { pg8::Gemm g{(const bf16*)((unsigned char*)Wb + W_IN) + (size_t)1280 * D, XB, 3072, M, D}; pg8::StaticOrder S; S.init(3072, M, F.G, (int)(((unsigned)F.bx + 128u) % (unsigned)F.G)); \
                  pg8::EpiPlainBf16 E{(bf16*)(BIG + B_HYT), M}; \
                  pg8::gemm_phase<pg8::EpiPlainBf16, pg8::StaticOrder, true, true>(F.lds + RING_OFF, g, S, E, F.wave); } \
            } else { \
                pg8::Gemm g{XB, (const bf16*)((unsigned char*)Wb + W_IN), M, O_PROJ, D}; pg8::StaticOrder S; S.init(M, O_PROJ, F.G, F.bx); \
                pg8::EpiOddQKV E{(bf16*)BIG, (const float*)(F.ws + WS_COSO), (const float*)(F.ws + WS_SINO), M}; \
                pg8::gemm_phase<pg8::EpiOddQKV, pg8::StaticOrder, true, true>(F.lds + RING_OFF, g, S, E, F.wave); } } while (0)
#define BODY2 do { if (even) { \
                if (MK_HYENA_NAIVE) { for (int u = F.bx; u < 3072; u += F.G) { if (u < 1024) hyena_unit_naive<16384>(F, j, 0, u); else hyena_unit_naive<4096>(F, j, 1 + ((u - 1024) >> 10), (u - 1024) & 1023); } } \
                else { for (int u = F.bx; u < 2048; u += F.G) { if (u < 1024) hyena_unit_mfma<16384, 2>(F, j, 0, u); else hyena_unit_mfma<4096, 1>(F, j, 1 + ((u - 1024) >> 9), 2 * ((u - 1024) & 511)); } } \
                if (MK_ATTN_NAIVE & 1) p_attn_even_naive(F, j); else p_attn_even_mfma(F, j); \
            } else { if (MK_ATTN_NAIVE & 2) p_attn_odd_naive(F); else p_attn_odd_mfma(F); } } while (0)
#define BODY3 do { if (even) p_zt_transpose(F); else p_combine_odd(F); } while (0)
#define BODY4 do { pg8::Gemm g{XB, (const bf16*)((unsigned char*)Wb + W_OUT), M, D, D}; pg8::StaticOrder S; S.init(M, D, F.G, F.bx); \
            pg8::EpiResid E{F.X, D, ALPHA}; \
            pg8::gemm_phase<pg8::EpiResid, pg8::StaticOrder, true, true>(F.lds + RING_OFF, g, S, E, F.wave); } while (0)
#define BODY5 do { p_layernorm(F, F.in[21] + (size_t)layer * D, F.in[22] + (size_t)layer * D); } while (0)
#define BODY6 do { pg8::Gemm g{XB, (const bf16*)((unsigned char*)Wb + W_GU), M, 2 * DFF, D}; pg8::StaticOrder S; S.init(M, 2 * DFF, F.G, F.bx); \
            pg8::EpiSwiGLU E{(bf16*)BIG, DFF}; \
            pg8::gemm_phase<pg8::EpiSwiGLU, pg8::StaticOrder, true, true>(F.lds + RING_OFF, g, S, E, F.wave); } while (0)
#define BODY7 do { pg8::Gemm g{(const bf16*)BIG, (const bf16*)((unsigned char*)Wb + W_DN), M, D, DFF}; pg8::StaticOrder S; S.init(M, D, F.G, F.bx); \
            pg8::EpiResid E{F.X, D, ALPHA}; \
            pg8::gemm_phase<pg8::EpiResid, pg8::StaticOrder, true, true>(F.lds + RING_OFF, g, S, E, F.wave); } while (0)
#define BODY8 do { p_layernorm(F, F.in[23] + (size_t)layer * D, F.in[24] + (size_t)layer * D); } while (0)
#define SITE(k, BODY) if (HAS(k) && IN(pb + (k))) { FRESH(); BODY; if (MK_PROBE_REP == (k) && ((k) != 2 || even)) { __syncthreads(); FRESH(); BODY; } SEAM(pb + (k)); }
        SITE(0, BODY0)
        SITE(1, BODY1)
        SITE(2, BODY2)
        SITE(3, BODY3)
        SITE(4, BODY4)
        SITE(5, BODY5)
        SITE(6, BODY6)
        SITE(7, BODY7)
        SITE(8, BODY8)
    }
#undef IN
#undef SEAM
#undef FRESH
#undef XB
#undef Wb
#undef BIG
}

#ifndef MK_ONE_LAUNCH
#define MK_ONE_LAUNCH 1
#endif
extern "C" void kernel_launch(void* const* d_in, const int* in_sizes, int n_in, void* d_out, int out_size, void* d_ws, size_t ws_size, hipStream_t stream) {
    static int grid = 0;
    if (grid == 0) {
        if (n_in != 25 || out_size != M * D || ws_size < WS_END) { fprintf(stderr, "kernel_launch: unexpected shapes (n_in %d, out %d, ws %zu < %zu)\n", n_in, out_size, ws_size, (size_t)WS_END); grid = -1; return; }
        int dev = 0, cus = 0, per_cu = 0;
        if (hipGetDevice(&dev) != hipSuccess || hipDeviceGetAttribute(&cus, hipDeviceAttributeMultiprocessorCount, dev) != hipSuccess) { grid = -1; return; }
        if (hipFuncSetAttribute((const void*)mk_fwd, hipFuncAttributeMaxDynamicSharedMemorySize, LDS_BYTES) != hipSuccess) { fprintf(stderr, "kernel_launch: hipFuncSetAttribute failed\n"); grid = -1; return; }
        if (hipOccupancyMaxActiveBlocksPerMultiprocessor(&per_cu, (const void*)mk_fwd, NWAVES * 64, LDS_BYTES) != hipSuccess || per_cu < 1) { fprintf(stderr, "kernel_launch: occupancy query says %d\n", per_cu); }
        (void)hipGetLastError();
        grid = cus;
    }
    if (grid < 0) return;
    (void)hipMemsetAsync((char*)d_ws + WS_CTL, 0, CTL_ZERO_BYTES, stream);
    Args a{};
    for (int i = 0; i < 25; ++i) a.in[i] = (const float*)d_in[i];
    a.out = (float*)d_out; a.ws = (unsigned char*)d_ws;
#if MK_ONE_LAUNCH
    a.ph_lo = 0; a.ph_hi = NPHASE;
    hipLaunchKernelGGL(mk_fwd, dim3(grid), dim3(NWAVES * 64), LDS_BYTES, stream, a);
#else
    for (int ph = 0; ph < NPHASE; ++ph) { a.ph_lo = ph; a.ph_hi = ph + 1; hipLaunchKernelGGL(mk_fwd, dim3(grid), dim3(NWAVES * 64), LDS_BYTES, stream, a); }
#endif
}
```

```cpp
#include <hip/hip_runtime.h>
#include <cstdio>
#include <cstdint>
#include <cmath>
#ifndef MK_PROBE_REP
#define MK_PROBE_REP -1
#endif
namespace pg8 {
#define PG8_LAS __attribute__((address_space(3)))
typedef unsigned short bf16_t;
typedef short bf16x8 __attribute__((ext_vector_type(8)));
typedef float f32x4 __attribute__((ext_vector_type(4)));
typedef unsigned u32x4 __attribute__((ext_vector_type(4)));
constexpr int BM = 256, BK = 64, HALF = 128, HTB = HALF * BK * 2  , STAGE_BYTES = 8 * HTB, NXCD = 8, WGM = 8;

__host__ __device__ __forceinline__ int lds_byte(int r, int c) { const int st = (r >> 4) * 2 + (c >> 5), rr = r & 15, cc = c & 31, ob = rr * 64 + cc * 2; return st * 1024 + (ob ^ (((ob >> 9) & 1) << 5)); }
__host__ __device__ __forceinline__ void stage_rc(int b, int& R, int& C) { const int st = b / 1024, sb = b % 1024, swz = sb ^ (((sb >> 9) & 1) << 5); R = (st >> 1) * 16 + swz / 64; C = (st & 1) * 32 + (swz % 64) / 2; }
__host__ __device__ __forceinline__ int perm32(int rho) { const int n = rho >> 4, i = rho & 15; return 8 * (i >> 2) + 4 * n + (i & 3); }

struct Unit { int pm, pn; };
struct Gemm { const bf16_t* A; const bf16_t* Bt; int M, N, K; };

struct StaticOrder {
    int nM, nN, nwg, G, c;
    __host__ __device__ void init(int M, int N, int G_, int c_) { nM = M / BM; nN = N / BM; nwg = nM * nN; G = G_; c = c_; }
    __host__ __device__ bool next(int i, Unit& u) const {
        const long L = (long)i * G + c; if (L >= nwg) return false;
        int wgid = (int)L; { const int q = nwg / NXCD, r = nwg % NXCD, xcd = wgid % NXCD, off = wgid / NXCD; wgid = (xcd < r ? xcd * (q + 1) : r * (q + 1) + (xcd - r) * q) + off; }
        const int nig = WGM * nN, gid = wgid / nig, fm = gid * WGM, gsz = (nM - fm) < WGM ? (nM - fm) : WGM;
        u.pm = fm + ((wgid % nig) % gsz); u.pn = (wgid % nig) / gsz; return true;
    }
    __device__ __forceinline__ void a_ready(const Unit&) const {}
    __device__ __forceinline__ void done(const Unit&) const {}
};

__device__ __forceinline__ unsigned cvt_pk_bf16(float lo, float hi) { unsigned r; asm volatile("v_cvt_pk_bf16_f32 %0, %1, %2" : "=v"(r) : "v"(lo), "v"(hi)); return r; }
typedef float f32x2 __attribute__((ext_vector_type(2)));
__device__ __forceinline__ u32x4 pack8(const f32x4& v0, const f32x4& v1) { u32x4 w; w.x = cvt_pk_bf16(v0[0], v0[1]); w.y = cvt_pk_bf16(v0[2], v0[3]); w.z = cvt_pk_bf16(v1[0], v1[1]); w.w = cvt_pk_bf16(v1[2], v1[3]); return w; }
__device__ __forceinline__ f32x4 shfl_xor4(const f32x4& v, int m) { f32x4 r; r[0] = __shfl_xor(v[0], m); r[1] = __shfl_xor(v[1], m); r[2] = __shfl_xor(v[2], m); r[3] = __shfl_xor(v[3], m); return r; }
__device__ __forceinline__ int seq_base_of_row(int row) { return row < 16384 ? 0 : (row < 20480 ? 16384 : 20480); }

struct EpiPlainBf16 {
    static constexpr bool PERM = true, AFTER_DRAIN = false;
    bf16_t* O; int ldc;
    __device__ __forceinline__ void operator()(const f32x4 (&acc)[2][2][4][2], const Unit& u, int wr, int wc, int fr_, int fq_) const {
        int fr = fr_, fq = fq_; asm volatile("" : "+v"(fr), "+v"(fq));
        const int row0 = u.pm * BM + wr * 64 + fr, col0 = u.pn * BM + wc * 32 + 8 * fq;
#pragma unroll
        for (int ai = 0; ai < 2; ++ai)
#pragma unroll
            for (int m = 0; m < 4; ++m) { bf16_t* rowp = O + (size_t)(row0 + ai * HALF + m * 16) * ldc + col0;
#pragma unroll
                for (int bj = 0; bj < 2; ++bj) *(u32x4*)(rowp + bj * HALF) = pack8(acc[ai][bj][m][0], acc[ai][bj][m][1]); }
    }
};

struct EpiEvenQKV {
    static constexpr bool PERM = true, AFTER_DRAIN = false;
    bf16_t* Q; bf16_t* Kb; bf16_t* Vb; const float* cosT; const float* sinT;
    __device__ __forceinline__ void operator()(const f32x4 (&acc)[2][2][4][2], const Unit& u, int wr, int wc, int fr_, int fq_) const {
        int fr = fr_, fq = fq_; asm volatile("" : "+v"(fr), "+v"(fq));
        const int row0 = u.pm * BM + wr * 64 + fr; const int sbase = seq_base_of_row(u.pm * BM);
        const bool ropew = ((wc & 1) == 0);
        const float sgn = (fq & 1) ? 1.f : -1.f;
#pragma unroll
        for (int ai = 0; ai < 2; ++ai)
#pragma unroll
            for (int m = 0; m < 4; ++m) { const int row = row0 + ai * HALF + m * 16; const int pos = row - sbase;
                f32x4 c0 = {1.f, 1.f, 1.f, 1.f}, c1 = c0, s0 = {0.f, 0.f, 0.f, 0.f}, s1 = s0;
                if (ropew && fq < 2) { c0 = *(const f32x4*)(cosT + (size_t)pos * 8); c1 = *(const f32x4*)(cosT + (size_t)pos * 8 + 4); s0 = *(const f32x4*)(sinT + (size_t)pos * 8); s1 = *(const f32x4*)(sinT + (size_t)pos * 8 + 4); }
#pragma unroll
                for (int bj = 0; bj < 2; ++bj) { f32x4 v0 = acc[ai][bj][m][0], v1 = acc[ai][bj][m][1];
                    const bool is_v = (u.pn == 4 && bj == 1);
                    if (ropew && !is_v) { const f32x4 p0 = shfl_xor4(v0, 16), p1 = shfl_xor4(v1, 16);
                        v0 = v0 * c0 + (p0 * s0) * sgn; v1 = v1 * c1 + (p1 * s1) * sgn; }
                    bf16_t* dst;
                    if (u.pn < 4) dst = Q + (size_t)row * 1024 + u.pn * 256 + bj * HALF + wc * 32 + 8 * fq;
                    else dst = (bj == 0 ? Kb : Vb) + (size_t)row * 128 + wc * 32 + 8 * fq;
                    *(u32x4*)dst = pack8(v0, v1); }
                asm volatile("" ::: "memory"); }
    }
};

struct EpiOddQKV {
    static constexpr bool PERM = true, AFTER_DRAIN = false;
    bf16_t* O; const float* cosT; const float* sinT; int Mtot;
    __device__ __forceinline__ void operator()(const f32x4 (&acc)[2][2][4][2], const Unit& u, int wr, int wc, int fr_, int fq_) const {
        int fr = fr_, fq = fq_; asm volatile("" : "+v"(fr), "+v"(fq));
        const int row0 = u.pm * BM + wr * 64 + fr; const int sbase = seq_base_of_row(u.pm * BM); const int L = sbase == 0 ? 16384 : 4096;
        const int sg = u.pn >> 3, s = sg / 3, g = sg - 3 * s; const int dsh = 2 * g;
        const int ls = L >> dsh;
        const bool ropew = (wc == 0) && (s < 2);
        const float sgn = (fq & 2) ? 1.f : -1.f;
        const int tb = (fq & 1) * 8;
#pragma unroll
        for (int ai = 0; ai < 2; ++ai)
#pragma unroll
            for (int m = 0; m < 4; ++m) { const int row = row0 + ai * HALF + m * 16; const int pos = row - sbase;
                const int prow = sbase + (pos & ((1 << dsh) - 1)) * ls + (pos >> dsh);
                f32x4 c0 = {1.f, 1.f, 1.f, 1.f}, c1 = c0, s0 = {0.f, 0.f, 0.f, 0.f}, s1 = s0;
                if (ropew) { const float* cp = cosT + (size_t)pos * 16 + tb; const float* sp = sinT + (size_t)pos * 16 + tb; c0 = *(const f32x4*)cp; c1 = *(const f32x4*)(cp + 4); s0 = *(const f32x4*)sp; s1 = *(const f32x4*)(sp + 4); }
#pragma unroll
                for (int bj = 0; bj < 2; ++bj) { f32x4 v0 = acc[ai][bj][m][0], v1 = acc[ai][bj][m][1];
                    if (ropew) { const f32x4 p0 = shfl_xor4(v0, 32), p1 = shfl_xor4(v1, 32);
                        v0 = v0 * c0 + (p0 * s0) * sgn; v1 = v1 * c1 + (p1 * s1) * sgn; }
                    const int head = 2 * (u.pn & 7) + bj;
                    bf16_t* dst = O + ((size_t)(sg * 16 + head) * Mtot + prow) * 128 + wc * 32 + 8 * fq;
                    *(u32x4*)dst = pack8(v0, v1); }
                asm volatile("" ::: "memory"); }
    }
};

struct EpiResid {
    static constexpr bool PERM = false, AFTER_DRAIN = false;
    float* X; int ldc; float alpha; const float* stat; const float* g; const float* bt; float* Xout;
    __device__ __forceinline__ void operator()(const f32x4 (&acc)[2][2][4][2], const Unit& u, int wr, int wc, int fr_, int fq_) const {
        int fr = fr_, fq = fq_; asm volatile("" : "+v"(fr), "+v"(fq));
        const int row0 = u.pm * BM + wr * 64 + fr, col0 = u.pn * BM + wc * 32 + 4 * fq;
        f32x4 gv[2][2], bv[2][2];
#pragma unroll
        for (int bj = 0; bj < 2; ++bj)
#pragma unroll
            for (int n = 0; n < 2; ++n) { gv[bj][n] = (f32x4){1.f, 1.f, 1.f, 1.f}; bv[bj][n] = (f32x4){0.f, 0.f, 0.f, 0.f};
                if (stat) { gv[bj][n] = *(const f32x4*)(g + col0 + bj * HALF + n * 16); bv[bj][n] = *(const f32x4*)(bt + col0 + bj * HALF + n * 16); } }
#pragma unroll
        for (int ai = 0; ai < 2; ++ai)
#pragma unroll
            for (int m = 0; m < 4; ++m) { const int row = row0 + ai * HALF + m * 16; float* rowp = X + (size_t)row * ldc + col0;
                float mean = 0.f, rstd = 1.f; if (stat) { const f32x2 st = *(const f32x2*)(stat + 2 * (size_t)row); mean = st.x; rstd = st.y; }
#pragma unroll
                for (int bj = 0; bj < 2; ++bj)
#pragma unroll
                    for (int n = 0; n < 2; ++n) { f32x4* p = (f32x4*)(rowp + bj * HALF + n * 16); const f32x4 t = *p; const f32x4 x = (t - mean) * rstd * gv[bj][n] + bv[bj][n]; *(f32x4*)((float*)p + (Xout - X)) = x * alpha + acc[ai][bj][m][n]; }
                if (m == 3) asm volatile("" ::: "memory"); }
    }
};

struct EpiSwiGLU {
    static constexpr bool PERM = true, AFTER_DRAIN = false;
    bf16_t* H; int ldh;
    static __device__ __forceinline__ float silu_mul(float g, float up) { const float e = __builtin_amdgcn_exp2f(g * -1.4426950408889634f); return g * __builtin_amdgcn_rcpf(1.0f + e) * up; }
    __device__ __forceinline__ void operator()(const f32x4 (&acc)[2][2][4][2], const Unit& u, int wr, int wc, int fr_, int fq_) const {
        int fr = fr_, fq = fq_; asm volatile("" : "+v"(fr), "+v"(fq));
        const int row0 = u.pm * BM + wr * 64 + fr, col0 = u.pn * HALF + wc * 32 + 8 * fq;
#pragma unroll
        for (int ai = 0; ai < 2; ++ai)
#pragma unroll
            for (int m = 0; m < 4; ++m) { bf16_t* dst = H + (size_t)(row0 + ai * HALF + m * 16) * ldh + col0;
                f32x4 h0, h1;
#pragma unroll
                for (int e = 0; e < 4; ++e) { h0[e] = silu_mul(acc[ai][0][m][0][e], acc[ai][1][m][0][e]); h1[e] = silu_mul(acc[ai][0][m][1][e], acc[ai][1][m][1][e]); }
                *(u32x4*)dst = pack8(h0, h1); }
    }
};

template <class Epi, class Sched, bool ALIGN_EPI = false, bool SP2 = false>
__device__ __forceinline__ void gemm_phase(PG8_LAS unsigned char* lds, const Gemm g, const Sched& S, const Epi& E, const int wave_id) {
    int tid_; asm volatile("v_mbcnt_lo_u32_b32 %0, -1, 0\n\tv_mbcnt_hi_u32_b32 %0, -1, %0" : "=v"(tid_)); tid_ += wave_id * 64;
    const int tid = tid_, wid = __builtin_amdgcn_readfirstlane(tid >> 6), lane = tid & 63, wr = wid >> 2, wc = wid & 3, fr = lane & 15, fq = lane >> 4;
    const int K = g.K, nt = K / BK;
    unsigned voffA[2], voffB[2];
#pragma unroll
    for (int i = 0; i < 2; ++i) { int R, C; stage_rc(tid * 16 + i * 8192, R, C); const int Rb = Epi::PERM ? ((R & ~31) + perm32(R & 31)) : R;
        voffA[i] = (unsigned)(R * K + C) * 2u; voffB[i] = (unsigned)(Rb * K + C) * 2u; }
    const size_t kstep = (size_t)(BK * 2);
    const size_t hstep = (size_t)HALF * K * 2;
    const size_t tstep = 2 * hstep;
    const unsigned ldsw = (unsigned)wid * 1024u;
    const int aoff = lds_byte(wr * 64 + fr, fq * 8), boff = lds_byte(wc * 32 + fr, fq * 8);
#define PG8_SA(b, h) (((b) * 2 + (h)) * HTB)
#define PG8_SB(b, h) ((4 + (b) * 2 + (h)) * HTB)
#define PG8_STAGE(bufoff, gbase, voff) do { _Pragma("unroll") for (int _i = 0; _i < 2; ++_i) \
        __builtin_amdgcn_global_load_lds((const unsigned*)((const char*)(gbase) + (voff)[_i]), (PG8_LAS unsigned*)(lds + (bufoff) + ldsw + _i * 8192), 16, 0, 0); } while (0)
#define PG8_LDA(dst, b, h) do { _Pragma("unroll") for (int m = 0; m < 4; ++m) _Pragma("unroll") for (int k = 0; k < 2; ++k) dst[m][k] = *(const PG8_LAS bf16x8*)(lds + PG8_SA(b, h) + aoff + m * 2048 + k * 1024); } while (0)
#define PG8_LDB(dst, b, h) do { _Pragma("unroll") for (int n = 0; n < 2; ++n) _Pragma("unroll") for (int k = 0; k < 2; ++k) dst[n][k] = *(const PG8_LAS bf16x8*)(lds + PG8_SB(b, h) + boff + n * 2048 + k * 1024); } while (0)
#define PG8_MMA(ai, bj, At, Bt) do { __builtin_amdgcn_s_setprio(1); _Pragma("unroll") for (int m = 0; m < 4; ++m) _Pragma("unroll") for (int n = 0; n < 2; ++n) _Pragma("unroll") for (int k = 0; k < 2; ++k) \
        acc[ai][bj][m][n] = __builtin_amdgcn_mfma_f32_16x16x32_bf16(Bt[n][k], At[m][k], acc[ai][bj][m][n], 0, 0, 0); __builtin_amdgcn_s_setprio(0); } while (0)
#define PG8_WAIT_V(n) asm volatile("s_waitcnt vmcnt(" #n ")" ::: "memory")
#define PG8_WAIT_L(n) asm volatile("s_waitcnt lgkmcnt(" #n ")" ::: "memory")
#define PG8_BAR __builtin_amdgcn_s_barrier()
#define PG8_SCHED __builtin_amdgcn_sched_barrier(0)
    Unit cur, nxt; int ui = 0;
    if (!S.next(0, cur)) return;
    f32x4 acc[2][2][4][2];
#pragma unroll
    for (int a = 0; a < 2; ++a)
#pragma unroll
        for (int b = 0; b < 2; ++b)
#pragma unroll
            for (int m = 0; m < 4; ++m)
#pragma unroll
                for (int n = 0; n < 2; ++n) acc[a][b][m][n] = (f32x4){0.f, 0.f, 0.f, 0.f};
    bf16x8 At[4][2], B0[2][2], B1[2][2];
    const char* cA = (const char*)g.A + (size_t)cur.pm * tstep; const char* cB = (const char*)g.Bt + (size_t)cur.pn * tstep;
    S.a_ready(cur);
    if constexpr (SP2) {
        PG8_STAGE(PG8_SB(0, 0), cB, voffB); PG8_STAGE(PG8_SB(0, 1), cB + hstep, voffB); PG8_STAGE(PG8_SA(0, 0), cA, voffA); PG8_STAGE(PG8_SA(0, 1), cA + hstep, voffA);
        if (wr == 1) PG8_BAR;
        PG8_WAIT_V(2); PG8_BAR;
        PG8_STAGE(PG8_SB(1, 0), cB + kstep, voffB); PG8_STAGE(PG8_SA(1, 0), cA + kstep, voffA); PG8_STAGE(PG8_SB(1, 1), cB + hstep + kstep, voffB);
        PG8_WAIT_V(6); PG8_BAR;
    } else {
        PG8_STAGE(PG8_SB(0, 0), cB, voffB); PG8_STAGE(PG8_SA(0, 0), cA, voffA); PG8_STAGE(PG8_SB(0, 1), cB + hstep, voffB); PG8_STAGE(PG8_SA(0, 1), cA + hstep, voffA);
        if (wr == 1) PG8_BAR;
        PG8_WAIT_V(4); PG8_BAR;
        PG8_STAGE(PG8_SB(1, 0), cB + kstep, voffB); PG8_STAGE(PG8_SA(1, 0), cA + kstep, voffA); PG8_STAGE(PG8_SB(1, 1), cB + hstep + kstep, voffB);
        PG8_WAIT_V(6); PG8_BAR;
    }
    for (;;) {
        const bool has_next = S.next(ui + 1, nxt);
        const char* nA = has_next ? (const char*)g.A + (size_t)nxt.pm * tstep : cA; const char* nB = has_next ? (const char*)g.Bt + (size_t)nxt.pn * tstep : cB;
        for (int t = 0; t < nt; t += 2) {
            const bool last = (t == nt - 2);
            const char* a1 = cA + (size_t)(t + 1) * kstep;
            const char* a2 = last ? nA : cA + (size_t)(t + 2) * kstep; const char* b2 = last ? nB : cB + (size_t)(t + 2) * kstep;
            const char* a3 = a2 + kstep; const char* b3 = b2 + kstep;
            if (last && has_next) S.a_ready(nxt);
            if constexpr (SP2) {
            PG8_LDB(B0, 0, 0); PG8_LDB(B1, 0, 1); PG8_SCHED; PG8_LDA(At, 0, 0); PG8_STAGE(PG8_SA(1, 1), a1 + hstep, voffA);
            PG8_WAIT_V(8); PG8_WAIT_L(0); PG8_BAR; PG8_MMA(0, 0, At, B0); PG8_MMA(0, 1, At, B1); PG8_BAR; PG8_SCHED;
            PG8_LDA(At, 0, 1); PG8_STAGE(PG8_SB(0, 0), b2, voffB); PG8_STAGE(PG8_SB(0, 1), b2 + hstep, voffB); PG8_STAGE(PG8_SA(0, 0), a2, voffA);
            PG8_WAIT_V(8); PG8_WAIT_L(0); PG8_BAR; PG8_MMA(1, 0, At, B0); PG8_MMA(1, 1, At, B1); PG8_BAR; PG8_SCHED;
            PG8_LDB(B0, 1, 0); PG8_LDB(B1, 1, 1); PG8_SCHED; PG8_LDA(At, 1, 0); PG8_STAGE(PG8_SA(0, 1), a2 + hstep, voffA);
            PG8_WAIT_V(8); PG8_WAIT_L(0); PG8_BAR; PG8_MMA(0, 0, At, B0); PG8_MMA(0, 1, At, B1); PG8_BAR; PG8_SCHED;
            PG8_LDA(At, 1, 1); PG8_STAGE(PG8_SB(1, 0), b3, voffB); PG8_STAGE(PG8_SB(1, 1), b3 + hstep, voffB); PG8_STAGE(PG8_SA(1, 0), a3, voffA);
            PG8_WAIT_V(8); PG8_WAIT_L(0); PG8_BAR; PG8_MMA(1, 0, At, B0); PG8_MMA(1, 1, At, B1); PG8_BAR; PG8_SCHED;
            } else {
            PG8_LDB(B0, 0, 0); PG8_SCHED; PG8_LDA(At, 0, 0); PG8_STAGE(PG8_SA(1, 1), a1 + hstep, voffA);
            PG8_WAIT_L(8); PG8_BAR; PG8_WAIT_L(0); PG8_MMA(0, 0, At, B0); PG8_BAR; PG8_SCHED;
            PG8_LDB(B1, 0, 1); PG8_STAGE(PG8_SB(0, 0), b2, voffB);
            PG8_BAR; PG8_WAIT_L(0); PG8_MMA(0, 1, At, B1); PG8_BAR;
            PG8_LDA(At, 0, 1); PG8_STAGE(PG8_SA(0, 0), a2, voffA);
            PG8_BAR; PG8_WAIT_L(0); PG8_MMA(1, 0, At, B0); PG8_BAR; PG8_SCHED;
            PG8_STAGE(PG8_SB(0, 1), b2 + hstep, voffB);
            PG8_WAIT_V(6); PG8_BAR; PG8_MMA(1, 1, At, B1); PG8_BAR;
            PG8_LDB(B0, 1, 0); PG8_SCHED; PG8_LDA(At, 1, 0); PG8_STAGE(PG8_SA(0, 1), a2 + hstep, voffA);
            PG8_WAIT_L(8); PG8_BAR; PG8_WAIT_L(0); PG8_MMA(0, 0, At, B0); PG8_BAR; PG8_SCHED;
            PG8_LDB(B1, 1, 1); PG8_STAGE(PG8_SB(1, 0), b3, voffB);
            PG8_BAR; PG8_WAIT_L(0); PG8_MMA(0, 1, At, B1); PG8_BAR;
            PG8_LDA(At, 1, 1); PG8_STAGE(PG8_SA(1, 0), a3, voffA);
            PG8_BAR; PG8_WAIT_L(0); PG8_MMA(1, 0, At, B0); PG8_BAR; PG8_SCHED;
            PG8_STAGE(PG8_SB(1, 1), b3 + hstep, voffB);
            PG8_WAIT_V(6); PG8_BAR; PG8_MMA(1, 1, At, B1); PG8_BAR;
            }
        }
        if constexpr (ALIGN_EPI) { if (wr == 0) PG8_BAR; }
        if constexpr (!Epi::AFTER_DRAIN) { E(acc, cur, wr, wc, fr, fq); S.done(cur); }
        if (!has_next) break;
#pragma unroll
        for (int a = 0; a < 2; ++a)
#pragma unroll
            for (int b = 0; b < 2; ++b)
#pragma unroll
                for (int m = 0; m < 4; ++m)
#pragma unroll
                    for (int n = 0; n < 2; ++n) acc[a][b][m][n] = (f32x4){0.f, 0.f, 0.f, 0.f};
        cur = nxt; cA = nA; cB = nB; ++ui;
        if constexpr (ALIGN_EPI) { if (wr == 1) PG8_BAR; }
    }
    PG8_WAIT_V(0);
    if constexpr (!ALIGN_EPI) { if (wr == 0) PG8_BAR; }
    PG8_BAR;
    if constexpr (Epi::AFTER_DRAIN) { E.fused(acc, cur, wr, wc, fr, fq, lds, wid, lane); S.done(cur); }
#undef PG8_SA
#undef PG8_SB
#undef PG8_STAGE
#undef PG8_LDA
#undef PG8_LDB
#undef PG8_MMA
#undef PG8_WAIT_V
#undef PG8_WAIT_L
#undef PG8_BAR
#undef PG8_SCHED
}
}
#define GAS __attribute__((address_space(1)))
#define LAS __attribute__((address_space(3)))
typedef unsigned short bf16;
typedef unsigned v4u __attribute__((ext_vector_type(4)));
typedef float f32x4 __attribute__((ext_vector_type(4)));
typedef short bf16x8 __attribute__((ext_vector_type(8)));
typedef GAS unsigned gu32;
typedef GAS unsigned long long gu64;
#define RLX_AGENT __ATOMIC_RELAXED, __HIP_MEMORY_SCOPE_AGENT
#define LDS_WAIT() asm volatile("s_waitcnt lgkmcnt(0)" ::: "memory")
#define VM_WAIT() asm volatile("s_waitcnt vmcnt(0)" ::: "memory")
__device__ __forceinline__ unsigned long long rt() { return __builtin_amdgcn_s_memrealtime(); }
__device__ __forceinline__ unsigned f2bf(float f) { unsigned u = __builtin_bit_cast(unsigned, f); return (u + 0x7fffu + ((u >> 16) & 1u)) >> 16; }
__device__ __forceinline__ unsigned pk2(float lo, float hi) { return f2bf(lo) | (f2bf(hi) << 16); }

#define XB_TMO      128
#define XB_XCNT(j)  (256  + 64 * (j))
#define XB_XSUB(j)  (1280 + 64 * (j))
#define XB_XGEN(j)  (2304 + 64 * (j))
#define XB_TOP      3328
#define XB_TOPGEN   3392
#define XCD_BAR_WORDS 3456
#define XB_SPIN_CAP (1u << 22)

__device__ __forceinline__ unsigned xb_ld(unsigned* p)              { return __hip_atomic_load(p, __ATOMIC_RELAXED, __HIP_MEMORY_SCOPE_AGENT); }
__device__ __forceinline__ unsigned xb_add(unsigned* p, unsigned v) { return __hip_atomic_fetch_add(p, v, __ATOMIC_RELAXED, __HIP_MEMORY_SCOPE_AGENT); }
__device__ __forceinline__ unsigned xb_xcc_id() { return (unsigned)__builtin_amdgcn_s_getreg((3 << 11) | 20) & 0xFu; }
#define XB_SPIN(cond, bar) do { unsigned _sp = 0; while (cond) { __builtin_amdgcn_s_sleep(1); \
    if ((++_sp & 255u) == 0u) { if (xb_ld(&(bar)[XB_TMO])) break; if (_sp > XB_SPIN_CAP) { atomicAdd(&(bar)[XB_TMO], 1u); break; } } } } while (0)

struct XcdBarrier {
    unsigned* bar; unsigned x;
    volatile LAS unsigned* st;
};

__device__ __forceinline__ XcdBarrier xcd_barrier_post(unsigned* bar, volatile LAS unsigned* st) {
    XcdBarrier b; b.bar = bar; b.x = xb_xcc_id(); b.st = st;
    if (threadIdx.x == 0) (void)xb_add(&bar[XB_XCNT(b.x)], 1u);
    return b;
}
__device__ __forceinline__ void xcd_barrier_complete(unsigned* bar, unsigned x, unsigned& nloc, unsigned& nx) {
    const unsigned G = gridDim.x * gridDim.y * gridDim.z;
    unsigned sum, cnt, mine, sp = 0u;
    for (;;) {
        sum = 0u; cnt = 0u; mine = 0u;
#pragma unroll
        for (unsigned j = 0; j < 16; ++j) { const unsigned c = xb_ld(&bar[XB_XCNT(j)]); sum += c; cnt += (c > 0u) ? 1u : 0u; mine = (j == x) ? c : mine; }
        if (sum == G) break;
        __builtin_amdgcn_s_sleep(1);
        if ((++sp & 255u) == 0u) { if (xb_ld(&bar[XB_TMO])) break; if (sp > XB_SPIN_CAP) { atomicAdd(&bar[XB_TMO], 1u); break; } }
    }
    nloc = mine > 0u ? mine : 1u; nx = cnt > 0u ? cnt : 1u;
}

__device__ __forceinline__ void xcd_barrier(const XcdBarrier& b) {
    asm volatile("s_waitcnt vmcnt(0)" ::: "memory");
    __syncthreads();
    if (threadIdx.x == 0) {
        unsigned* bar = b.bar;
        __builtin_amdgcn_s_waitcnt(0);
        unsigned nloc = b.st[0], nx = b.st[1];
        if (nloc == 0u) { xcd_barrier_complete(bar, b.x, nloc, nx); b.st[0] = nloc; b.st[1] = nx; }
        const unsigned old = xb_add(&bar[XB_XSUB(b.x)], 1u);
        const unsigned gen = old / nloc;
        if (old + 1u == (gen + 1u) * nloc) {
            __builtin_amdgcn_fence(__ATOMIC_RELEASE, "agent");
            asm volatile("s_waitcnt vmcnt(0)" ::: "memory");
            const unsigned og = xb_add(&bar[XB_TOP], 1u);
            const unsigned tg = og / nx;
            if (og + 1u == (tg + 1u) * nx) xb_add(&bar[XB_TOPGEN], 1u);
            else XB_SPIN(xb_ld(&bar[XB_TOPGEN]) == tg, bar);
            __builtin_amdgcn_fence(__ATOMIC_ACQUIRE, "agent");
            xb_add(&bar[XB_XGEN(b.x)], 1u);
            asm volatile("s_waitcnt vmcnt(0)" ::: "memory");
        } else {
            XB_SPIN(xb_ld(&bar[XB_XGEN(b.x)]) == gen, bar);
            __builtin_amdgcn_fence(__ATOMIC_ACQUIRE, "agent");
            asm volatile("s_waitcnt vmcnt(0)" ::: "memory");
        }
    }
    __syncthreads();
}

constexpr int NWAVES = 8;
constexpr int M = 24576, D = 2048, DFF = 5632, DEPTH = 4;
constexpr int NSEQ = 3;
__host__ __device__ __forceinline__ int seq_base(int s) { return s == 0 ? 0 : (s == 1 ? 16384 : 20480); }
__host__ __device__ __forceinline__ int seq_len(int s) { return s == 0 ? 16384 : 4096; }
constexpr int E_PROJ = 4352, O_PROJ = 18432;
constexpr float LN_EPS = 1e-5f;
constexpr float ALPHA = 1.6817928305074290861f;
constexpr int PH_PER_LAYER = 9, NPHASE = DEPTH * PH_PER_LAYER;

constexpr size_t MiB = 1u << 20;
constexpr size_t WS_CTL = 0, CTL_ZERO_BYTES = 1 * MiB;
constexpr size_t WS_COSE = 1 * MiB, WS_SINE = WS_COSE + 512 * 1024, WS_COSO = 2 * MiB, WS_SINO = 3 * MiB;
constexpr size_t WS_STAT = 4 * MiB;
constexpr size_t WS_LSE = 8 * MiB;
constexpr size_t WS_XB = 16 * MiB;
constexpr size_t WS_W = 112 * MiB;
constexpr size_t WS_BIG = 258 * MiB;
constexpr size_t WS_END = WS_BIG + 864 * MiB;
constexpr size_t W_IN = 0;
constexpr size_t W_OUT = 72 * MiB;
constexpr size_t W_GU = 80 * MiB;
constexpr size_t W_DN = 124 * MiB;
constexpr size_t B_Q = 0, B_K = 48 * MiB, B_V = 54 * MiB, B_HYT = 60 * MiB, B_TAP0 = 204 * MiB, B_TAP1 = 332 * MiB, B_ZT = 364 * MiB, B_PSUM = 412 * MiB;
constexpr int CW_BAR = 4096;

constexpr int RING_OFF = 0, RING_BYTES = 131072;
constexpr int LDSCTL_OFF = RING_BYTES, MISC_OFF = LDSCTL_OFF + 320;
constexpr int LDS_BYTES = 147456;

struct InTab { __device__ __forceinline__ const float* operator[](int i) const {
    const unsigned char __attribute__((address_space(4)))* k = (const unsigned char __attribute__((address_space(4)))*)__builtin_amdgcn_kernarg_segment_ptr();
    asm volatile("" : "+s"(k));
    return *(const float* const __attribute__((address_space(4)))*)(k + 8 * i); } };
struct Frame {
    LAS unsigned char* lds;
    volatile LAS unsigned* MISC;
    gu32* ctl;
    int tid, lane, wave;
    int G, bx;
    unsigned char* ws;
    float* X;
    InTab in;
};
__device__ __forceinline__ float bf2f(unsigned short b) { return __builtin_bit_cast(float, (unsigned)b << 16); }
__device__ __forceinline__ float wave_sum(float v) {
#pragma unroll
    for (int o = 1; o < 64; o <<= 1) v += __shfl_xor(v, o);
    return v;
}
__device__ __forceinline__ float wave_max(float v) {
#pragma unroll
    for (int o = 1; o < 64; o <<= 1) v = fmaxf(v, __shfl_xor(v, o));
    return v;
}


__device__ __forceinline__ void sincos_d(double x, double& sn, double& cs) {
    const double k = __builtin_rint(x * 0.63661977236758134308);
    double r = __builtin_fma(-k, 1.57079632679489655800, x); r = __builtin_fma(-k, 6.12323399573676603587e-17, r);
    const double r2 = r * r;
    double sp = -7.6471637318198164759e-13; sp = sp * r2 + 1.6059043836821614599e-10; sp = sp * r2 - 2.5052108385441718775e-08; sp = sp * r2 + 2.7557319223985890653e-06;
    sp = sp * r2 - 1.9841269841269841270e-04; sp = sp * r2 + 8.3333333333333333333e-03; sp = sp * r2 - 1.6666666666666666667e-01; const double s = r + r * r2 * sp;
    double cp = 4.7794773323873852974e-14; cp = cp * r2 - 1.1470745597729724714e-11; cp = cp * r2 + 2.0876756987868098979e-09; cp = cp * r2 - 2.7557319223985890653e-07;
    cp = cp * r2 + 2.4801587301587301587e-05; cp = cp * r2 - 1.3888888888888888889e-03; cp = cp * r2 + 4.1666666666666666667e-02; cp = cp * r2 - 0.5; const double c = 1.0 + r2 * cp;
    const int q = ((int)k) & 3;
    sn = (q == 0) ? s : (q == 1) ? c : (q == 2) ? -s : -c;
    cs = (q == 0) ? c : (q == 1) ? -s : (q == 2) ? -c : s;
}
__device__ __forceinline__ void sincos_f(float x, float& sn, float& cs) {
    const float k = __builtin_rintf(x * 0.636619772367581343f);
    float r = __builtin_fmaf(-k, 1.5703125f, x); r = __builtin_fmaf(-k, 4.837512969970703125e-4f, r); r = __builtin_fmaf(-k, 7.54978995489188216e-8f, r);
    const float r2 = r * r;
    float sp = 2.7557319224e-06f; sp = sp * r2 - 1.9841269841e-04f; sp = sp * r2 + 8.3333333333e-03f; sp = sp * r2 - 1.6666666667e-01f; const float s = r + r * r2 * sp;
    float cp = -2.7557319224e-07f; cp = cp * r2 + 2.4801587302e-05f; cp = cp * r2 - 1.3888888889e-03f; cp = cp * r2 + 4.1666666667e-02f; cp = cp * r2 - 0.5f; const float c = 1.0f + r2 * cp;
    const int q = ((int)k) & 3;
    sn = (q == 0) ? s : (q == 1) ? c : (q == 2) ? -s : -c;
    cs = (q == 0) ? c : (q == 1) ? -s : (q == 2) ? -c : s;
}
__device__ __forceinline__ float sin_f(float x) { float s, c; sincos_f(x, s, c); return s; }

__device__ __forceinline__ void transpose_item(const float* W, int K, int ldn, int c0, bf16* WT, int r0, LAS float* scr, int kb, int nb, int lane) {
    const int k0 = 64 * kb, n0 = 32 * nb;
    float wv[32];
    const float* wp = W + (size_t)(k0 + (lane >> 5)) * ldn + c0 + n0 + (lane & 31);
#pragma unroll
    for (int i = 0; i < 32; ++i) wv[i] = __builtin_nontemporal_load(wp + (size_t)(2 * i) * ldn);
#pragma unroll
    for (int i = 0; i < 32; ++i) { const int kk = 2 * i + (lane >> 5); scr[kk * 33 + (lane & 31)] = wv[i]; }
    LDS_WAIT(); asm volatile("" ::: "memory");
    const int c = lane & 7;
#pragma unroll
    for (int j = 0; j < 4; ++j) { const int n = (lane >> 3) + 8 * j; const LAS float* s = scr + (8 * c) * 33 + n;
        v4u o; o.x = pk2(s[0 * 33], s[1 * 33]); o.y = pk2(s[2 * 33], s[3 * 33]); o.z = pk2(s[4 * 33], s[5 * 33]); o.w = pk2(s[6 * 33], s[7 * 33]);
        *(GAS v4u*)(WT + (size_t)(r0 + n0 + n) * K + k0 + 8 * c) = o; }
    LDS_WAIT(); asm volatile("" ::: "memory");
}
__device__ __forceinline__ void convert_segment(Frame& F, const float* W, int K, int ldn, int c0, int cnt, bf16* WT, int r0) {
    LAS float* scr = (LAS float*)(F.lds + RING_OFF + F.wave * 16384);
    const int gw = F.bx * NWAVES + F.wave, NGW = F.G * NWAVES;
    const int nnb = cnt / 32, nit = (K / 64) * nnb;
    for (int it = gw; it < nit; it += NGW) transpose_item(W, K, ldn, c0, WT, r0, scr, it / nnb, it % nnb, F.lane);
}

__device__ __forceinline__ void p_input(Frame& F) {
    const float* xp = F.in[0]; const float* xs = F.in[1];
    bf16* XB = (bf16*)(F.ws + WS_XB);
    const size_t n4 = (size_t)M * D / 4, np4 = (size_t)16384 * D / 4;
    for (size_t i = (size_t)F.bx * 512 + F.tid; i < n4; i += (size_t)F.G * 512) {
        const f32x4 v = i < np4 ? ((const f32x4*)xp)[i] : ((const f32x4*)xs)[i - np4];
        ((f32x4*)F.X)[i] = v;
        unsigned long long w = (unsigned long long)pk2(v[0], v[1]) | ((unsigned long long)pk2(v[2], v[3]) << 32);
        ((unsigned long long*)XB)[i] = w;
    }
    float* cE = (float*)(F.ws + WS_COSE); float* sE = (float*)(F.ws + WS_SINE); float* cO = (float*)(F.ws + WS_COSO); float* sO = (float*)(F.ws + WS_SINO);
    for (int i = F.bx * 512 + F.tid; i < 16384 * 24; i += F.G * 512) {
        const int pos = i / 24, f = i % 24;
        const float inv16[16] = {1.f, 0.440366596f, 0.193922743f, 0.0853971019f, 0.0376060307f, 0.016560439f, 0.00729266461f, 0.00321144587f, 0.00141421356f, 0.000622772379f, 0.000274248188f, 0.000120769735f, 5.3182961e-05f, 2.34199997e-05f, 1.03133862e-05f, 4.54167048e-06f};
        const int ff = f < 8 ? 2 * f : f - 8;
        float inv = 1.f;
#pragma unroll
        for (int q = 0; q < 16; ++q) inv = (ff == q) ? inv16[q] : inv;
        const float ang = (float)pos * inv; double sn, cs; sincos_d((double)ang, sn, cs);
        if (f < 8) { cE[pos * 8 + f] = (float)cs; sE[pos * 8 + f] = (float)sn; } else { cO[pos * 16 + (f - 8)] = (float)cs; sO[pos * 16 + (f - 8)] = (float)sn; }
    }
}

__device__ __forceinline__ void p_convert_weights(Frame& F, int layer) {
    const int j = layer >> 1; const bool even = !(layer & 1);
    bf16* Wb = (bf16*)(F.ws + WS_W);
    if (even) {
        const float* w_in = F.in[2] + (size_t)j * D * E_PROJ;
        convert_segment(F, w_in, D, E_PROJ, 0, 1280, (bf16*)((unsigned char*)Wb + W_IN), 0);
        convert_segment(F, w_in, D, E_PROJ, 1280, 3072, (bf16*)((unsigned char*)Wb + W_IN) + (size_t)1280 * D, 0);
        convert_segment(F, F.in[15] + (size_t)j * D * D, D, D, 0, D, (bf16*)((unsigned char*)Wb + W_OUT), 0);
    } else {
        convert_segment(F, F.in[16] + (size_t)j * D * O_PROJ, D, O_PROJ, 0, O_PROJ, (bf16*)((unsigned char*)Wb + W_IN), 0);
        convert_segment(F, F.in[17] + (size_t)j * D * D, D, D, 0, D, (bf16*)((unsigned char*)Wb + W_OUT), 0);
    }
    const float* wg = F.in[18] + (size_t)layer * D * DFF; const float* wu = F.in[19] + (size_t)layer * D * DFF;
    bf16* WGU = (bf16*)((unsigned char*)Wb + W_GU);
    {   LAS float* scr = (LAS float*)(F.lds + RING_OFF + F.wave * 16384);
        const int gw = F.bx * NWAVES + F.wave, NGW = F.G * NWAVES;
        const int nit = (D / 64) * (2 * DFF / 32);
        for (int it = gw; it < nit; it += NGW) { const int kb = it / 352, nb = it % 352;
            const int pn = nb >> 3, half = (nb >> 2) & 1, sub = nb & 3;
            transpose_item(half ? wu : wg, D, DFF, 128 * pn + 32 * sub, WGU, 32 * nb, scr, kb, 0, F.lane); }
    }
    convert_segment(F, F.in[20] + (size_t)layer * DFF * D, DFF, D, 0, D, (bf16*)((unsigned char*)Wb + W_DN), 0);
}

__device__ __forceinline__ void taps_tile(Frame& F, int j, int cls, int tile) {
    const int L = cls ? 4096 : 16384; const int i0 = tile * 64;
    LAS float* zf = (LAS float*)(F.lds + RING_OFF);
    LAS float* h1 = zf + 64 * 33;
    LAS float* h2 = h1 + 64 * 65;
    const float* w1 = F.in[6] + (size_t)j * 33 * 64; const float* b1 = F.in[7] + j * 64; const float* f1 = F.in[8] + j * 64;
    const float* w2 = F.in[9] + (size_t)j * 64 * 64; const float* b2 = F.in[10] + j * 64; const float* f2 = F.in[11] + j * 64;
    const float* w3 = F.in[12] + (size_t)j * 64 * 4096; const float* b3 = F.in[13] + (size_t)j * 4096;
    for (int idx = F.tid; idx < 64 * 33; idx += 512) { const int p = idx / 33, f = idx % 33, i = i0 + p; float val;
        if (f == 0) val = (float)i / (float)(L - 1);
        else { const int mm = (f - 1) & 15; const float band = 1e-4f + (float)mm * ((15.0f - 1e-4f) / 15.0f); const float w = 6.283185307179586f * (float)i / (float)L;
            float sn, cs; sincos_f(band * w, sn, cs); val = f <= 16 ? cs : -sn; }
        zf[p * 33 + f] = val; }
    __syncthreads();
    for (int idx = F.tid; idx < 64 * 64; idx += 512) { const int p = idx >> 6, k = idx & 63; float a = b1[k];
        for (int f = 0; f < 33; ++f) a += zf[p * 33 + f] * w1[f * 64 + k];
        h1[p * 65 + k] = sin_f(f1[k] * a); }
    __syncthreads();
    for (int idx = F.tid; idx < 64 * 64; idx += 512) { const int p = idx >> 6, k = idx & 63; float a = b2[k];
        for (int f = 0; f < 64; ++f) a += h1[p * 65 + f] * w2[f * 64 + k];
        h2[p * 65 + k] = sin_f(f2[k] * a); }
    __syncthreads();
    const int i = i0 + F.lane; const float ti = (float)i / (float)(L - 1);
    bf16* TAPS = (bf16*)(F.ws + WS_BIG + (cls ? B_TAP1 : B_TAP0));
    float* PS = (float*)(F.ws + WS_BIG + B_PSUM) + (cls ? (size_t)256 * 4096 : 0) + (size_t)tile * 4096;
    const float dmin = -3.0701134573253943f  , dmax = -15.350567286626973f  ;
    const LAS float* hrow = h2 + F.lane * 65;
#pragma unroll 1
    for (int cb = 0; cb < 512; cb += 4) { const int col = F.wave * 512 + cb;
        asm volatile("" ::: "memory");
        f32x4 a = *(const f32x4*)(b3 + col);
#pragma unroll 8
        for (int k = 0; k < 64; ++k) { const f32x4 wv = *(const f32x4*)(w3 + (size_t)k * 4096 + col); const float hk = hrow[k]; a += wv * hk; }
        const int dir = col >> 11, o = (col >> 10) & 1, ch0 = col & 1023;
#pragma unroll
        for (int e = 0; e < 4; ++e) { const int ch = ch0 + e; const float delta = fabsf(dmin + (dmax - dmin) * ((float)ch / 1023.0f));
            float val = a[e] * __expf(-ti * delta);
            bf16* tp = TAPS + ((size_t)(o * 1024 + ch)) * (2 * L);
            if (dir == 0) tp[L - i] = (bf16)f2bf(val);
            else { if (i >= 1) tp[L + i] = (bf16)f2bf(val); else { tp[0] = 0; val = 0.f; } }
            const float s = wave_sum(fabsf(val));
            if (F.lane == 0) PS[col + e] = s; }
    }
    __syncthreads();
}

__device__ __forceinline__ void p_layernorm(Frame& F, const float* gam, const float* bet, bool final) {
    bf16* XB = (bf16*)(F.ws + WS_XB); float* STAT = (float*)(F.ws + WS_STAT);
    const int gw = F.bx * NWAVES + F.wave, NGW = F.G * NWAVES;
    f32x4 gv[8], bv[8];
#pragma unroll
    for (int q = 0; q < 8; ++q) { gv[q] = ((const f32x4*)gam)[F.lane + 64 * q]; bv[q] = ((const f32x4*)bet)[F.lane + 64 * q]; }
    for (int m = gw; m < M; m += NGW) {
        f32x4* xr = (f32x4*)(F.X + (size_t)m * D) + F.lane;
        f32x4 v[8]; float s = 0.f;
#pragma unroll
        for (int q = 0; q < 8; ++q) { v[q] = xr[64 * q]; s += (v[q][0] + v[q][1]) + (v[q][2] + v[q][3]); }
        const float mean = wave_sum(s) * (1.f / D); float s2 = 0.f;
#pragma unroll
        for (int q = 0; q < 8; ++q) { v[q] = v[q] - mean; s2 += (v[q][0] * v[q][0] + v[q][1] * v[q][1]) + (v[q][2] * v[q][2] + v[q][3] * v[q][3]); }
        const float rstd = 1.f / sqrtf(wave_sum(s2) * (1.f / D) + LN_EPS);
        unsigned long long* o8 = (unsigned long long*)(XB + (size_t)m * D) + F.lane;
        if (!final && F.lane == 0) { STAT[2 * (size_t)m] = mean; STAT[2 * (size_t)m + 1] = rstd; }
#pragma unroll
        for (int q = 0; q < 8; ++q) { const f32x4 y = v[q] * rstd * gv[q] + bv[q];
            if (final) xr[64 * q] = y;
            else o8[64 * q] = (unsigned long long)pk2(y[0], y[1]) | ((unsigned long long)pk2(y[2], y[3]) << 32); }
    }
}

__device__ __forceinline__ void p_attn_even_naive(Frame& F, int j) {
    const bf16* Q = (const bf16*)(F.ws + WS_BIG + B_Q); const bf16* Kb = (const bf16*)(F.ws + WS_BIG + B_K); const bf16* Vb = (const bf16*)(F.ws + WS_BIG + B_V);
    bf16* AO = (bf16*)(F.ws + WS_XB);
    const float* sink = F.in[3] + j * 16;
    const int gw = F.bx * NWAVES + F.wave, NGW = F.G * NWAVES;
    for (int it = gw; it < M * 16; it += NGW) {
        const int tok = it >> 4, h = it & 15, kvh = h >> 3;
        const int sb = pg8::seq_base_of_row(tok), L = sb == 0 ? 16384 : 4096, pos = tok - sb;
        float sc[5]; bool ok[5];
#pragma unroll
        for (int c = 0; c < 5; ++c) sc[c] = 0.f;
        int kr[5];
#pragma unroll
        for (int c = 0; c < 5; ++c) { const int kp = pos - 128 + F.lane + 64 * c; ok[c] = (kp <= pos + 128) && kp >= 0 && kp < L; kr[c] = ok[c] ? sb + kp : tok; }
        for (int t = 0; t < 8; ++t) {
            const v4u qv = *(const v4u*)(Q + (size_t)tok * 1024 + h * 64 + 8 * t);
            float qf[8];
#pragma unroll
            for (int e = 0; e < 4; ++e) { qf[2 * e] = bf2f((unsigned short)(qv[e] & 0xffff)); qf[2 * e + 1] = bf2f((unsigned short)(qv[e] >> 16)); }
#pragma unroll
            for (int c = 0; c < 5; ++c) { const v4u kv = *(const v4u*)(Kb + (size_t)kr[c] * 128 + kvh * 64 + 8 * t);
#pragma unroll
                for (int e = 0; e < 4; ++e) sc[c] += qf[2 * e] * bf2f((unsigned short)(kv[e] & 0xffff)) + qf[2 * e + 1] * bf2f((unsigned short)(kv[e] >> 16)); }
        }
        const float sk = sink[h];
        float mx = sk;
#pragma unroll
        for (int c = 0; c < 5; ++c) { sc[c] = ok[c] ? sc[c] * 0.125f : -INFINITY; mx = fmaxf(mx, sc[c]); }
        mx = wave_max(mx);
        float p[5]; float ps = 0.f;
#pragma unroll
        for (int c = 0; c < 5; ++c) { p[c] = ok[c] ? __expf(sc[c] - mx) : 0.f; ps += p[c]; }
        const float den = wave_sum(ps) + __expf(sk - mx);
        float o = 0.f;
#pragma unroll
        for (int c = 0; c < 5; ++c)
            for (int l = 0; l < 64; ++l) { const float pl = __shfl(p[c], l); const int kp = pos - 128 + l + 64 * c;
                if (pl != 0.f) o += pl * bf2f(Vb[(size_t)(sb + kp) * 128 + kvh * 64 + F.lane]); }
        AO[(size_t)tok * D + h * 64 + F.lane] = (bf16)f2bf(o / den);
    }
}

__device__ __forceinline__ void p_attn_odd_naive(Frame& F) {
    bf16* QKV = (bf16*)(F.ws + WS_BIG); float* LSE = (float*)(F.ws + WS_LSE);
    const int gw = F.bx * NWAVES + F.wave, NGW = F.G * NWAVES;
    for (int it = gw; it < 3 * 16 * M; it += NGW) {
        const int prow = it % M, gh = it / M, g = gh >> 4, h = gh & 15;
        const int sb = pg8::seq_base_of_row(prow), L = sb == 0 ? 16384 : 4096, ls = L >> (2 * g);
        const int pp = prow - sb, rho = pp / ls, idx = pp - rho * ls;
        bf16* Qg = QKV + ((size_t)((0 * 3 + g) * 16 + h) * M) * 128; const bf16* Kg = QKV + ((size_t)((1 * 3 + g) * 16 + h) * M) * 128; const bf16* Vg = QKV + ((size_t)((2 * 3 + g) * 16 + h) * M) * 128;
        float sc[3]; bool ok[3]; int kr[3];
#pragma unroll
        for (int c = 0; c < 3; ++c) { const int ki = idx - 64 + F.lane + 64 * c; ok[c] = (ki <= idx + 64) && ki >= 0 && ki < ls; kr[c] = ok[c] ? sb + rho * ls + ki : prow; sc[c] = 0.f; }
        for (int t = 0; t < 16; ++t) {
            const v4u qv = *(const v4u*)(Qg + (size_t)prow * 128 + 8 * t);
            float qf[8];
#pragma unroll
            for (int e = 0; e < 4; ++e) { qf[2 * e] = bf2f((unsigned short)(qv[e] & 0xffff)); qf[2 * e + 1] = bf2f((unsigned short)(qv[e] >> 16)); }
#pragma unroll
            for (int c = 0; c < 3; ++c) { const v4u kv = *(const v4u*)(Kg + (size_t)kr[c] * 128 + 8 * t);
#pragma unroll
                for (int e = 0; e < 4; ++e) sc[c] += qf[2 * e] * bf2f((unsigned short)(kv[e] & 0xffff)) + qf[2 * e + 1] * bf2f((unsigned short)(kv[e] >> 16)); }
        }
        float mx = -INFINITY;
#pragma unroll
        for (int c = 0; c < 3; ++c) { sc[c] = ok[c] ? sc[c] * 0.08838834764831845f : -INFINITY; mx = fmaxf(mx, sc[c]); }
        mx = wave_max(mx);
        float p[3]; float ps = 0.f;
#pragma unroll
        for (int c = 0; c < 3; ++c) { p[c] = ok[c] ? __expf(sc[c] - mx) : 0.f; ps += p[c]; }
        const float den = wave_sum(ps);
        float o0 = 0.f, o1 = 0.f;
#pragma unroll
        for (int c = 0; c < 3; ++c)
            for (int l = 0; l < 64; ++l) { const float pl = __shfl(p[c], l); const int ki = idx - 64 + l + 64 * c;
                if (pl != 0.f) { const unsigned vv = *(const unsigned*)(Vg + (size_t)(sb + rho * ls + ki) * 128 + 2 * F.lane); o0 += pl * bf2f((unsigned short)(vv & 0xffff)); o1 += pl * bf2f((unsigned short)(vv >> 16)); } }
        const float inv = 1.f / den;
        *(unsigned*)(Qg + (size_t)prow * 128 + 2 * F.lane) = pk2(o0 * inv, o1 * inv);
        if (F.lane == 0) LSE[((size_t)g * M + prow) * 16 + h] = mx + __logf(den);
    }
}

__device__ __forceinline__ void p_combine_odd(Frame& F) {
    const bf16* QKV = (const bf16*)(F.ws + WS_BIG); const float* LSE = (const float*)(F.ws + WS_LSE); bf16* AO = (bf16*)(F.ws + WS_XB);
#pragma unroll 4
    for (int it = F.bx * 512 + F.tid; it < M * 256; it += F.G * 512) {
        const int tok = it >> 8, h = (it >> 4) & 15, ck = it & 15;
        const int sb = pg8::seq_base_of_row(tok), L = sb == 0 ? 16384 : 4096, pos = tok - sb;
        float l[3]; int pr[3];
#pragma unroll
        for (int g = 0; g < 3; ++g) { const int dsh = 2 * g; pr[g] = sb + (pos & ((1 << dsh) - 1)) * (L >> dsh) + (pos >> dsh); l[g] = LSE[((size_t)g * M + pr[g]) * 16 + h]; }
        const float mx = fmaxf(l[0], fmaxf(l[1], l[2]));
        float w[3]; float ws = 0.f;
#pragma unroll
        for (int g = 0; g < 3; ++g) { w[g] = __expf(l[g] - mx); ws += w[g]; }
        const float inv = 1.f / ws;
        float acc[8];
#pragma unroll
        for (int e = 0; e < 8; ++e) acc[e] = 0.f;
#pragma unroll
        for (int g = 0; g < 3; ++g) { const v4u ov = *(const v4u*)(QKV + ((size_t)(g * 16 + h) * M + pr[g]) * 128 + 8 * ck); const float wg = w[g] * inv;
#pragma unroll
            for (int e = 0; e < 4; ++e) { acc[2 * e] += wg * bf2f((unsigned short)(ov[e] & 0xffff)); acc[2 * e + 1] += wg * bf2f((unsigned short)(ov[e] >> 16)); } }
        v4u o; o.x = pk2(acc[0], acc[1]); o.y = pk2(acc[2], acc[3]); o.z = pk2(acc[4], acc[5]); o.w = pk2(acc[6], acc[7]);
        *(v4u*)(AO + (size_t)tok * D + h * 128 + 8 * ck) = o;
    }
}

template <int L> __device__ __forceinline__ void hyena_unit_naive(Frame& F, int j, int s, int ch) {
    constexpr int NQ = L / 512, cls = (L == 4096) ? 1 : 0, NT = L / 64;
    const int sb = seq_base(s);
    LAS bf16* tp = (LAS bf16*)(F.lds + RING_OFF); LAS bf16* vb = tp + 2 * L; LAS bf16* zb = vb + L;
    LAS float* red = (LAS float*)(F.lds + LDSCTL_OFF + 64);
    const bf16* HYT = (const bf16*)(F.ws + WS_BIG + B_HYT); bf16* ZT = (bf16*)(F.ws + WS_BIG + B_ZT);
    const bf16* TAPS = (const bf16*)(F.ws + WS_BIG + (cls ? B_TAP1 : B_TAP0));
    const float* PS = (const float*)(F.ws + WS_BIG + B_PSUM) + (cls ? (size_t)256 * 4096 : 0);
    const float* cw = F.in[4] + (size_t)j * 3 * 3072; const float* cb = F.in[5] + (size_t)j * 3072; const float* hb = F.in[14] + (size_t)j * 2 * 1024;
    if (F.wave < 2) { const int o = F.wave; float a = 0.f;
        for (int t = F.lane; t < NT; t += 64) a += PS[(size_t)t * 4096 + (0 * 2 + o) * 1024 + ch] + PS[(size_t)t * 4096 + (1 * 2 + o) * 1024 + ch];
        a = wave_sum(a); if (F.lane == 0) red[o] = a; }
    { const bf16* hr = HYT + (size_t)ch * M + sb; const float w0 = cw[0 * 3072 + ch], w1 = cw[1 * 3072 + ch], w2 = cw[2 * 3072 + ch], b = cb[ch];
      for (int i = F.tid; i < L; i += 512) { const float xm = i > 0 ? bf2f(hr[i - 1]) : 0.f, x0 = bf2f(hr[i]), xp = i < L - 1 ? bf2f(hr[i + 1]) : 0.f; vb[i] = (bf16)f2bf(b + w0 * xm + w1 * x0 + w2 * xp); } }
    __syncthreads();
#pragma unroll 1
    for (int o = 0; o < 2; ++o) {
        const bf16* tg = TAPS + (size_t)(o * 1024 + ch) * (2 * L);
        for (int i = F.tid; i < 2 * L / 8; i += 512) ((LAS v4u*)tp)[i] = ((const v4u*)tg)[i];
        __syncthreads();
        const LAS bf16* src = o == 0 ? vb : zb;
        float acc[NQ];
#pragma unroll
        for (int q = 0; q < NQ; ++q) acc[q] = 0.f;
        for (int jj = 0; jj < L; ++jj) { const float uj = bf2f(src[jj]); const LAS bf16* tq = tp + (L - F.tid + jj);
#pragma unroll
            for (int q = 0; q < NQ; ++q) acc[q] += bf2f(tq[-512 * q]) * uj; }
        const float invS = 1.f / red[o]; const float bias = hb[o * 1024 + ch];
        const int gch = (o == 0 ? 1024 : 2048) + ch;
        const bf16* hr = HYT + (size_t)gch * M + sb; const float w0 = cw[0 * 3072 + gch], w1 = cw[1 * 3072 + gch], w2 = cw[2 * 3072 + gch], b = cb[gch];
#pragma unroll
        for (int q = 0; q < NQ; ++q) { const int i = 512 * q + F.tid;
            const float xm = i > 0 ? bf2f(hr[i - 1]) : 0.f, x0 = bf2f(hr[i]), xp = i < L - 1 ? bf2f(hr[i + 1]) : 0.f; const float xg = b + w0 * xm + w1 * x0 + w2 * xp;
            const float y = acc[q] * invS + bias * bf2f(src[i]); const float z = xg * y;
            if (o == 0) zb[i] = (bf16)f2bf(z); else ZT[(size_t)ch * M + sb + i] = (bf16)f2bf(z); }
        __syncthreads();
    }
}


template <int L, int NCH> __device__ __forceinline__ void warm_taps(Frame& F, const bf16* taps0, int ch0, LAS float* sink) {
    constexpr int NLD = (NCH * 2 * L * 2 / 128) / 512 > 0 ? (NCH * 2 * L * 2 / 128) / 512 : 1;
    unsigned acc = 0u;
#pragma unroll
    for (int it = 0; it < NLD; ++it) { const int ln = F.tid + 512 * it; if (ln < NCH * 2 * L * 2 / 128) { const int cc = ln / (2 * L * 2 / 128), l2 = ln % (2 * L * 2 / 128);
        acc ^= *(const unsigned*)((const unsigned char*)(taps0 + (size_t)(ch0 + cc) * (2 * L)) + (size_t)l2 * 128); } }
    if (acc == 0x7fc12345u) sink[0] = 1.f;
}

typedef float f32x16 __attribute__((ext_vector_type(16)));
typedef short s16x4 __attribute__((ext_vector_type(4)));
typedef unsigned u32x4_t __attribute__((ext_vector_type(4)));
template <int L, int TPW> __device__ __forceinline__ void hyena_unit_mfma(Frame& F, int j, int s, int ch0) {
    constexpr int NB = L / 32, NT = NB / 32, WPC = NT / TPW, NCH = NWAVES / WPC, cls = (L == 4096) ? 1 : 0, NTL = L / 64;
    constexpr int UBYTES = (NB + 64) * 80, TSTG = TPW * 2304;
    static_assert(NCH * UBYTES + NWAVES * TSTG <= RING_BYTES, "hyena LDS");
    const int sb = seq_base(s);
    const int w = F.wave, cidx = w / WPC, wl = w % WPC, lane = F.lane, i0 = lane & 31, h = lane >> 5;
    const int ch = ch0 + cidx;
    LAS unsigned char* Ub = F.lds + RING_OFF + cidx * UBYTES;
    LAS unsigned char* Tb = F.lds + RING_OFF + NCH * UBYTES + w * TSTG;
    LAS float* red = (LAS float*)(F.lds + LDSCTL_OFF + 64);
    const bf16* HYT = (const bf16*)(F.ws + WS_BIG + B_HYT); bf16* ZT = (bf16*)(F.ws + WS_BIG + B_ZT);
    const bf16* TAPS = (const bf16*)(F.ws + WS_BIG + (cls ? B_TAP1 : B_TAP0));
    const float* PS = (const float*)(F.ws + WS_BIG + B_PSUM) + (cls ? (size_t)256 * 4096 : 0);
    const float* cw = F.in[4] + (size_t)j * 3 * 3072; const float* cb = F.in[5] + (size_t)j * 3072; const float* hb = F.in[14] + (size_t)j * 2 * 1024;
    if (w < 2 * NCH) { const int cc = w >> 1, o = w & 1, chh = ch0 + cc; float a = 0.f;
        for (int t = lane; t < NTL; t += 64) a += PS[(size_t)t * 4096 + (0 * 2 + o) * 1024 + chh] + PS[(size_t)t * 4096 + (1 * 2 + o) * 1024 + chh];
        a = wave_sum(a); if (lane == 0) red[w] = a; }
    warm_taps<L, NCH>(F, TAPS, ch0, red + 8);
    constexpr int GOFF = NCH * UBYTES + NWAVES * TSTG;
    static_assert(GOFF + NCH * L * 2 <= RING_BYTES, "hyena LDS (gate rows)");
    constexpr int NU = (NCH * L / 8) / 512;
    {   v4u raw[NU], gr[NU]; unsigned short xm[NU], xp[NU];
#pragma unroll
        for (int it = 0; it < NU; ++it) { const int idx = F.tid + 512 * it, cc = idx / (L / 8), p8 = 8 * (idx % (L / 8)); const bf16* hr = HYT + (size_t)(ch0 + cc) * M + sb;
            raw[it] = *(const v4u*)(hr + p8); xm[it] = p8 > 0 ? hr[p8 - 1] : (unsigned short)0; xp[it] = p8 + 8 < L ? hr[p8 + 8] : (unsigned short)0;
            gr[it] = *(const v4u*)(HYT + (size_t)(1024 + ch0 + cc) * M + sb + p8); }
        for (int z = F.tid; z < NCH * 320; z += 512) { const int cc = z / 320, zz = z % 320, blk = zz < 160 ? zz / 5 : NB + 32 + (zz - 160) / 5, part = zz % 5;
            *(LAS v4u*)(F.lds + RING_OFF + cc * UBYTES + blk * 80 + part * 16) = (v4u){0u, 0u, 0u, 0u}; }
#pragma unroll
        for (int it = 0; it < NU; ++it) { const int idx = F.tid + 512 * it, cc = idx / (L / 8), p8 = 8 * (idx % (L / 8)); const int chh = ch0 + cc;
            const float w0 = cw[0 * 3072 + chh], w1 = cw[1 * 3072 + chh], w2 = cw[2 * 3072 + chh], b = cb[chh];
            float x[10]; x[0] = bf2f(xm[it]); x[9] = bf2f(xp[it]);
#pragma unroll
            for (int q = 0; q < 4; ++q) { x[1 + 2 * q] = bf2f((unsigned short)(raw[it][q] & 0xffff)); x[2 + 2 * q] = bf2f((unsigned short)(raw[it][q] >> 16)); }
            v4u o;
#pragma unroll
            for (int q = 0; q < 4; ++q) o[q] = pk2(b + w0 * x[2 * q] + w1 * x[2 * q + 1] + w2 * x[2 * q + 2], b + w0 * x[2 * q + 1] + w1 * x[2 * q + 2] + w2 * x[2 * q + 3]);
            *(LAS v4u*)(F.lds + RING_OFF + cc * UBYTES + ((p8 >> 5) + 32) * 80 + (p8 & 31) * 2) = o;
            *(LAS v4u*)(F.lds + RING_OFF + GOFF + cc * (L * 2) + p8 * 2) = gr[it]; }
    }
    __syncthreads();
    const int c4 = i0 & 3;
    int o8 = 8, o32 = 32, o40 = 40; asm volatile("" : "+v"(o8), "+v"(o32), "+v"(o40));
    const int abase = c4 * 576 + 16 * h - 2 * (i0 & ~3);
    const int bbase = (i0 + 32) * 80 + 16 * h;
    unsigned zpk[TPW][4][2];
#pragma unroll 1
    for (int o = 0; o < 2; ++o) {
        f32x16 acc[TPW];
        const bf16* TRg = TAPS + (size_t)(o * 1024 + ch) * (2 * L);
#pragma unroll 1
        for (int rp = 0; rp < (MK_PROBE_REP == 40 ? 2 : 1); ++rp) {
#pragma unroll
        for (int t = 0; t < TPW; ++t)
#pragma unroll
            for (int r = 0; r < 16; ++r) acc[t][r] = 0.f;
        v4u Xr[TPW], Pr[TPW];
#pragma unroll
        for (int t = 0; t < TPW; ++t) { const int n0 = 32 * (wl * TPW + t), wbase = L - 32 * (n0 - NB + 8);
            int xi = wbase + 8 * lane, pi = xi - 8; xi = xi < 0 ? 0 : (xi > 2 * L - 8 ? 2 * L - 8 : xi); pi = pi < 0 ? 0 : (pi > 2 * L - 8 ? 2 * L - 8 : pi);
            if (lane < 36) { Xr[t] = *(const v4u*)(TRg + xi); Pr[t] = *(const v4u*)(TRg + pi); } }
#pragma unroll 1
        for (int e0 = -NB; e0 < 32; e0 += 8) {
#pragma unroll
            for (int t = 0; t < TPW; ++t) {
                if (lane < 36) { const v4u X = Xr[t], P = Pr[t];
                    const unsigned a0 = __builtin_amdgcn_alignbit(X.x, P.w, 16), a1 = __builtin_amdgcn_alignbit(X.y, X.x, 16), a2 = __builtin_amdgcn_alignbit(X.z, X.y, 16), a3 = __builtin_amdgcn_alignbit(X.w, X.z, 16), a4 = __builtin_amdgcn_alignbit(P.w, P.z, 16);
                    LAS unsigned char* dst = Tb + t * 2304 + 16 * lane;
                    *(LAS v4u*)(dst) = X;
                    *(LAS v4u*)(dst + 576) = (v4u){a0, a1, a2, a3};
                    *(LAS v4u*)(dst + 1152) = (v4u){P.w, X.x, X.y, X.z};
                    *(LAS v4u*)(dst + 1728) = (v4u){a4, a0, a1, a2}; } }
            if (e0 + 8 < 32) {
#pragma unroll
                for (int t = 0; t < TPW; ++t) { const int n0 = 32 * (wl * TPW + t), wbase = L - 32 * (n0 + e0 + 16);
                    int xi = wbase + 8 * lane, pi = xi - 8; xi = xi < 0 ? 0 : (xi > 2 * L - 8 ? 2 * L - 8 : xi); pi = pi < 0 ? 0 : (pi > 2 * L - 8 ? 2 * L - 8 : pi);
                    if (lane < 36) { Xr[t] = *(const v4u*)(TRg + xi); Pr[t] = *(const v4u*)(TRg + pi); } } }
            const LAS unsigned char* bp = Ub + bbase - (e0 + 7) * 80;
            bf16x8 Bf[2][2]; s16x4 Al[2][TPW][2], Ah[2][TPW][2];
#define HY_LOAD(buf, dl) do { _Pragma("unroll") for (int ks = 0; ks < 2; ++ks) Bf[buf][ks] = *(const LAS bf16x8*)(bp + 80 * (7 - (dl)) + 32 * ks); \
                _Pragma("unroll") for (int t = 0; t < TPW; ++t) { const LAS unsigned char* ap = Tb + t * 2304 + abase + 64 * (8 - (dl)); \
                    Al[buf][t][0] = *(const LAS s16x4*)ap; Ah[buf][t][0] = *(const LAS s16x4*)(ap + o8); Al[buf][t][1] = *(const LAS s16x4*)(ap + o32); Ah[buf][t][1] = *(const LAS s16x4*)(ap + o40); } \
                asm volatile("" ::: "memory"); } while (0)
            HY_LOAD(0, 0);
#pragma unroll
            for (int dl = 0; dl < 8; ++dl) {
                if (dl < 7) HY_LOAD((dl + 1) & 1, dl + 1);
#pragma unroll
                for (int ks = 0; ks < 2; ++ks)
#pragma unroll
                    for (int t = 0; t < TPW; ++t) { const bf16x8 Af = __builtin_shufflevector(Al[dl & 1][t][ks], Ah[dl & 1][t][ks], 0, 1, 2, 3, 4, 5, 6, 7);
                        acc[t] = __builtin_amdgcn_mfma_f32_32x32x16_bf16(Af, Bf[dl & 1][ks], acc[t], 0, 0, 0); }
            }
#undef HY_LOAD
        }
        }
        int i0e = i0, he = h; asm volatile("" : "+v"(i0e), "+v"(he));
        const float invS = 1.f / red[2 * cidx + o]; const float bias = hb[o * 1024 + ch];
        const int gch = (o == 0 ? 1024 : 2048) + ch;
        const LAS bf16* Gr = (const LAS bf16*)(F.lds + RING_OFF + GOFF + cidx * (L * 2)); const float w0 = cw[0 * 3072 + gch], w1 = cw[1 * 3072 + gch], w2 = cw[2 * 3072 + gch], b = cb[gch];
#pragma unroll
        for (int t = 0; t < TPW; ++t) { const int n0 = 32 * (wl * TPW + t);
#pragma unroll
            for (int rg = 0; rg < 4; ++rg) { const int p = 32 * (n0 + i0e) + 8 * rg + 4 * he;
                const s16x4 uu = *(const LAS s16x4*)(Ub + ((p >> 5) + 32) * 80 + (p & 31) * 2);
                const s16x4 gm = *(const LAS s16x4*)(Gr + p);
                float hx[6]; hx[0] = p > 0 ? bf2f(Gr[p - 1]) : 0.f; hx[5] = p + 4 < L ? bf2f(Gr[p + 4]) : 0.f;
#pragma unroll
                for (int q = 0; q < 4; ++q) hx[1 + q] = bf2f((unsigned short)gm[q]);
                float z[4];
#pragma unroll
                for (int q = 0; q < 4; ++q) { const float gate = b + w0 * hx[q] + w1 * hx[q + 1] + w2 * hx[q + 2];
                    const float y = acc[t][4 * rg + q] * invS + bias * bf2f((unsigned short)uu[q]); z[q] = gate * y; }
                if (o == 0) { zpk[t][rg][0] = pk2(z[0], z[1]); zpk[t][rg][1] = pk2(z[2], z[3]); }
                else { unsigned long long wv = (unsigned long long)pk2(z[0], z[1]) | ((unsigned long long)pk2(z[2], z[3]) << 32); *(unsigned long long*)(ZT + (size_t)ch * M + sb + p) = wv; }
                asm volatile("" ::: "memory"); }
        }
        __syncthreads();
        if (o == 0) {
#pragma unroll
            for (int t = 0; t < TPW; ++t) { const int n0 = 32 * (wl * TPW + t);
#pragma unroll
                for (int rg = 0; rg < 4; ++rg) { const int p = 32 * (n0 + i0e) + 8 * rg + 4 * he;
                    *(LAS unsigned long long*)(Ub + ((p >> 5) + 32) * 80 + (p & 31) * 2) = (unsigned long long)zpk[t][rg][0] | ((unsigned long long)zpk[t][rg][1] << 32); } }
            warm_taps<L, NCH>(F, TAPS + (size_t)1024 * (2 * L), ch0, red + 8);
            {   v4u gr[NU];
#pragma unroll
                for (int it = 0; it < NU; ++it) { const int idx = F.tid + 512 * it, cc = idx / (L / 8), p8 = 8 * (idx % (L / 8)); gr[it] = *(const v4u*)(HYT + (size_t)(2048 + ch0 + cc) * M + sb + p8); }
#pragma unroll
                for (int it = 0; it < NU; ++it) { const int idx = F.tid + 512 * it, cc = idx / (L / 8), p8 = 8 * (idx % (L / 8)); *(LAS v4u*)(F.lds + RING_OFF + GOFF + cc * (L * 2) + p8 * 2) = gr[it]; } }
            __syncthreads();
        }
    }
}


typedef short v4i16_t __attribute__((ext_vector_type(4)));
typedef float f32x2_t __attribute__((ext_vector_type(2))); typedef __bf16 bf16x2_t __attribute__((ext_vector_type(2)));
__device__ __forceinline__ unsigned cvtpk_rne(float lo, float hi) { f32x2_t v = {lo, hi}; bf16x2_t b = __builtin_convertvector(v, bf16x2_t); return __builtin_bit_cast(unsigned, b); }
__device__ __forceinline__ s16x4 vtr_read(const LAS unsigned char* p) { return __builtin_bit_cast(s16x4, __builtin_amdgcn_ds_read_tr16_b64_v4i16((LAS v4i16_t*)p)); }
__device__ __forceinline__ int crow32(int r, int h) { return (r & 3) + 8 * (r >> 2) + 4 * h; }
template <int NR, int CPR> struct StageRegs { static constexpr int NIT = (NR * CPR + 511) / 512; v4u v[NIT]; };
template <int NR, int CPR> __device__ __forceinline__ void stage_load(StageRegs<NR, CPR>& S, const bf16* base, size_t gp, int wr0, int lo, int hi, int tid) {
#pragma unroll
    for (int it = 0; it < StageRegs<NR, CPR>::NIT; ++it) { const int idx = tid + 512 * it, r = idx / CPR, ck = idx % CPR, grow = wr0 + r;
        S.v[it] = (v4u){0u, 0u, 0u, 0u}; if (idx < NR * CPR && grow >= lo && grow < hi) S.v[it] = *(const v4u*)(base + (size_t)grow * gp + ck * 8); }
}
template <int NR, int CPR, int LP> __device__ __forceinline__ void stage_store(const StageRegs<NR, CPR>& S, LAS unsigned char* dst, int tid) {
#pragma unroll
    for (int it = 0; it < StageRegs<NR, CPR>::NIT; ++it) { const int idx = tid + 512 * it, r = idx / CPR, ck = idx % CPR;
        if (idx < NR * CPR) *(LAS v4u*)(dst + r * LP + ck * 16) = S.v[it]; }
}
template <int NR, int CPR, int LP> __device__ __forceinline__ void stage_rows(LAS unsigned char* dst, const bf16* base, size_t gp, int wr0, int lo, int hi, int tid) {
    StageRegs<NR, CPR> S; stage_load<NR, CPR>(S, base, gp, wr0, lo, hi, tid); stage_store<NR, CPR, LP>(S, dst, tid);
}
template <int HD, int NT, int RAD, int KP> __device__ __forceinline__ void attn_scores(f32x16 (&S)[NT], const LAS unsigned char* Kw, const bf16x8 (&Qf)[HD / 16], int q, int h, int ki0, int lo, int hi, float scale_l2, float sink_l2, bool has_sink, float& m_out, float& den_out) {
    constexpr int KH = HD / 32;
    bf16x8 Kf[2][KH];
#define QK_LOAD(buf, st) do { _Pragma("unroll") for (int kk = 0; kk < KH; ++kk) Kf[buf][kk] = *(const LAS bf16x8*)(Kw + (32 * ((st) >> 1) + q) * KP + 32 * (KH * ((st) & 1) + kk) + 16 * h); } while (0)
    QK_LOAD(0, 0);
#pragma unroll
    for (int st = 0; st < 2 * NT; ++st) { const int t = st >> 1;
        if (st + 1 < 2 * NT) QK_LOAD((st + 1) & 1, st + 1);
        __builtin_amdgcn_sched_barrier(0);
        if ((st & 1) == 0) {
#pragma unroll
            for (int r = 0; r < 16; ++r) S[t][r] = 0.f; }
#pragma unroll
        for (int kk = 0; kk < KH; ++kk) S[t] = __builtin_amdgcn_mfma_f32_32x32x16_bf16(Kf[st & 1][kk], Qf[KH * (st & 1) + kk], S[t], 0, 0, 0);
        __builtin_amdgcn_sched_barrier(0);
    }
#undef QK_LOAD
    float m = has_sink ? sink_l2 : -1e30f;
#pragma unroll
    for (int t = 0; t < NT; ++t)
#pragma unroll
        for (int r = 0; r < 16; ++r) { const int kv = 32 * t + crow32(r, h); const int rel = kv - RAD - q; const int ki = ki0 + kv;
            const bool ok = (rel >= -RAD) && (rel <= RAD) && (ki >= lo) && (ki < hi);
            const float sv = ok ? S[t][r] * scale_l2 : -1e30f; S[t][r] = sv; m = fmaxf(m, sv); }
    m = fmaxf(m, __shfl_xor(m, 32));
    float den = 0.f;
#pragma unroll
    for (int t = 0; t < NT; ++t)
#pragma unroll
        for (int r = 0; r < 16; ++r) { const float p = __builtin_amdgcn_exp2f(S[t][r] - m); S[t][r] = p; den += p; }
    den += __shfl_xor(den, 32);
    if (has_sink) den += __builtin_amdgcn_exp2f(sink_l2 - m);
    m_out = m; den_out = den;
}
template <int HD, int NT, int VP> __device__ __forceinline__ void attn_pv(f32x16 (&O)[HD / 32], const f32x16 (&S)[NT], const LAS unsigned char* Vw, int lane) {
    constexpr int NDB = HD / 32, NST = 2 * NT;
    const int G = lane >> 4, i = lane & 15, h = lane >> 5;
    const LAS unsigned char* vb = Vw + (4 * h + (i >> 2)) * VP + (16 * (G & 1) + 4 * (i & 3)) * 2;
#pragma unroll
    for (int db = 0; db < NDB; ++db)
#pragma unroll
        for (int r = 0; r < 16; ++r) O[db][r] = 0.f;
    s16x4 Vl[2][NDB], Vh[2][NDB];
#define PV_LOAD(buf, st) do { _Pragma("unroll") for (int db = 0; db < NDB; ++db) { const LAS unsigned char* vp = vb + (16 * (st)) * VP + 64 * db; Vl[buf][db] = vtr_read(vp); Vh[buf][db] = vtr_read(vp + 8 * VP); } } while (0)
    PV_LOAD(0, 0);
#pragma unroll
    for (int st = 0; st < NST; ++st) { const int t = st >> 1, s2 = st & 1;
        if (st + 1 < NST) PV_LOAD((st + 1) & 1, st + 1);
        __builtin_amdgcn_sched_barrier(0);
        u32x4_t pw; pw.x = cvtpk_rne(S[t][8 * s2 + 0], S[t][8 * s2 + 1]); pw.y = cvtpk_rne(S[t][8 * s2 + 2], S[t][8 * s2 + 3]); pw.z = cvtpk_rne(S[t][8 * s2 + 4], S[t][8 * s2 + 5]); pw.w = cvtpk_rne(S[t][8 * s2 + 6], S[t][8 * s2 + 7]);
        const bf16x8 Pf = __builtin_bit_cast(bf16x8, pw);
#pragma unroll
        for (int db = 0; db < NDB; ++db) { const bf16x8 Af = __builtin_shufflevector(Vl[st & 1][db], Vh[st & 1][db], 0, 1, 2, 3, 4, 5, 6, 7);
            O[db] = __builtin_amdgcn_mfma_f32_32x32x16_bf16(Af, Pf, O[db], 0, 0, 0); }
        __builtin_amdgcn_sched_barrier(0);
    }
#undef PV_LOAD
}

template <int HD, int NT, int RAD, int KP, int VP> __device__ __forceinline__ void attn_online(f32x16 (&O)[HD / 32], const LAS unsigned char* Kw, const LAS unsigned char* Vw, const bf16x8 (&Qf)[HD / 16], int lane, int ki0, int lo, int hi, float scale_l2, float m0, float& m_out, float& den_out) {
    const int q = lane & 31, h = lane >> 5, G = lane >> 4, i = lane & 15;
    const LAS unsigned char* vb = Vw + (4 * h + (i >> 2)) * VP + (16 * (G & 1) + 4 * (i & 3)) * 2;
    float m = m0, den = 0.f;
#pragma unroll
    for (int db = 0; db < HD / 32; ++db)
#pragma unroll
        for (int r = 0; r < 16; ++r) O[db][r] = 0.f;
#pragma unroll
    for (int t = 0; t < NT; ++t) {
        f32x16 St;
#pragma unroll
        for (int r = 0; r < 16; ++r) St[r] = 0.f;
#pragma unroll
        for (int ks = 0; ks < HD / 16; ++ks) { const bf16x8 Af = *(const LAS bf16x8*)(Kw + (32 * t + q) * KP + 32 * ks + 16 * h); St = __builtin_amdgcn_mfma_f32_32x32x16_bf16(Af, Qf[ks], St, 0, 0, 0); }
        float tm = -1e30f;
#pragma unroll
        for (int r = 0; r < 16; ++r) { const int kv = 32 * t + crow32(r, h); const int rel = kv - RAD - q; const int ki = ki0 + kv;
            const bool ok = (rel >= -RAD) && (rel <= RAD) && (ki >= lo) && (ki < hi);
            const float sv = ok ? St[r] * scale_l2 : -1e30f; St[r] = sv; tm = fmaxf(tm, sv); }
        tm = fmaxf(tm, __shfl_xor(tm, 32));
        const float mn = fmaxf(m, tm), alpha = __builtin_amdgcn_exp2f(m - mn); m = mn;
        float ps = 0.f;
#pragma unroll
        for (int r = 0; r < 16; ++r) { const float p = __builtin_amdgcn_exp2f(St[r] - m); St[r] = p; ps += p; }
        den = den * alpha + ps;
#pragma unroll
        for (int db = 0; db < HD / 32; ++db)
#pragma unroll
            for (int r = 0; r < 16; ++r) O[db][r] *= alpha;
#pragma unroll
        for (int s2 = 0; s2 < 2; ++s2) {
            u32x4_t pw; pw.x = cvtpk_rne(St[8 * s2 + 0], St[8 * s2 + 1]); pw.y = cvtpk_rne(St[8 * s2 + 2], St[8 * s2 + 3]); pw.z = cvtpk_rne(St[8 * s2 + 4], St[8 * s2 + 5]); pw.w = cvtpk_rne(St[8 * s2 + 6], St[8 * s2 + 7]);
            const bf16x8 Pf = __builtin_bit_cast(bf16x8, pw);
#pragma unroll
            for (int db = 0; db < HD / 32; ++db) { const LAS unsigned char* vp = vb + (32 * t + 16 * s2) * VP + 64 * db;
                const s16x4 lo4 = vtr_read(vp), hi4 = vtr_read(vp + 8 * VP);
                const bf16x8 Af = __builtin_shufflevector(lo4, hi4, 0, 1, 2, 3, 4, 5, 6, 7);
                O[db] = __builtin_amdgcn_mfma_f32_32x32x16_bf16(Af, Pf, O[db], 0, 0, 0); }
        }
    }
    den += __shfl_xor(den, 32);
    m_out = m; den_out = den;
}

__device__ __forceinline__ void attn_odd_unit(Frame& F, int g, int head, int R0, bool dummy) {
    constexpr int KP = 272, VP = 320, NT = 5, RAD = 64;
    bf16* QKV = (bf16*)(F.ws + WS_BIG); float* LSE = (float*)(F.ws + WS_LSE);
    bf16* Qg = QKV + ((size_t)((0 * 3 + g) * 16 + head) * M) * 128; const bf16* Kg = QKV + ((size_t)((1 * 3 + g) * 16 + head) * M) * 128; const bf16* Vg = QKV + ((size_t)((2 * 3 + g) * 16 + head) * M) * 128;
    const int sb = pg8::seq_base_of_row(R0), L = sb == 0 ? 16384 : 4096, ls = L >> (2 * g);
    const int seglo = sb + ((R0 - sb) / ls) * ls, seghi = seglo + ls;
    LAS unsigned char* img = F.lds + RING_OFF;
    int lane = F.lane, tid = F.tid; asm volatile("" : "+v"(lane), "+v"(tid));
    const int q = lane & 31, h = lane >> 5, w = F.wave;
    const int qrow = R0 + 32 * w + q;
    bf16x8 Qf[8];
#pragma unroll
    for (int ks = 0; ks < 8; ++ks) Qf[ks] = *(const bf16x8*)(Qg + (size_t)qrow * 128 + 16 * ks + 8 * h);
    stage_rows<384, 16, KP>(img, Kg, 128, R0 - 64, seglo, seghi, tid);

    __syncthreads();
    f32x16 S[NT]; float m, den;
    attn_scores<128, NT, RAD, KP>(S, img + (32 * w) * KP, Qf, q, h, R0 + 32 * w - 64, seglo, seghi, 0.08838834764831845f * 1.4426950408889634f, 0.f, false, m, den);
    __syncthreads();
    stage_rows<384, 16, VP>(img, Vg, 128, R0 - 64, seglo, seghi, tid);
    __syncthreads();
    f32x16 O[4];
    attn_pv<128, NT, VP>(O, S, img + (32 * w) * VP, lane);
    const float inv = 1.f / den;
#pragma unroll
    for (int db = 0; db < 4; ++db)
#pragma unroll
        for (int rg = 0; rg < 4; ++rg) { const unsigned long long wv = (unsigned long long)cvtpk_rne(O[db][4 * rg] * inv, O[db][4 * rg + 1] * inv) | ((unsigned long long)cvtpk_rne(O[db][4 * rg + 2] * inv, O[db][4 * rg + 3] * inv) << 32);
            bf16* od = dummy ? (bf16*)(F.ws + WS_XB) + ((((size_t)(g * 16 + head) * M + qrow) * 128) & (size_t)0x1FFFFFF) : Qg + (size_t)qrow * 128;
            *(unsigned long long*)(od + 32 * db + 8 * rg + 4 * h) = wv; }
    if (h == 0 && !dummy) LSE[((size_t)g * M + qrow) * 16 + head] = (m + __builtin_amdgcn_logf(den)) * 0.6931471805599453f;
    __syncthreads();
}
__device__ __forceinline__ void p_attn_odd_mfma(Frame& F, bool dummy) {
    for (int u = F.bx; u < 3 * 16 * (M / 256); u += F.G) { const int rb = u % (M / 256), gh = u / (M / 256); attn_odd_unit(F, gh >> 4, gh & 15, rb * 256, dummy); }
}

__device__ __forceinline__ void attn_even_unit(Frame& F, int j, int kvh, int R0) {
    constexpr int KP = 144, VP = 192, NT = 9, RAD = 128;
    const bf16* Q = (const bf16*)(F.ws + WS_BIG + B_Q); const bf16* Kb = (const bf16*)(F.ws + WS_BIG + B_K); const bf16* Vb = (const bf16*)(F.ws + WS_BIG + B_V);
    bf16* AO = (bf16*)(F.ws + WS_XB);
    const int sb = pg8::seq_base_of_row(R0), L = sb == 0 ? 16384 : 4096;
    LAS unsigned char* kimg = F.lds + RING_OFF; LAS unsigned char* vimg = kimg + 288 * KP;
    int lane = F.lane, tid = F.tid; asm volatile("" : "+v"(lane), "+v"(tid));
    const int q = lane & 31, h = lane >> 5, w = F.wave, head = kvh * 8 + w;
    stage_rows<288, 8, KP>(kimg, Kb + kvh * 64, 128, R0 - 128, sb, sb + L, tid);
    stage_rows<288, 8, VP>(vimg, Vb + kvh * 64, 128, R0 - 128, sb, sb + L, tid);
    const int qrow = R0 + q;
    bf16x8 Qf[4];
#pragma unroll
    for (int ks = 0; ks < 4; ++ks) Qf[ks] = *(const bf16x8*)(Q + (size_t)qrow * 1024 + head * 64 + 16 * ks + 8 * h);
    const float sink_l2 = (F.in[3] + j * 16)[head] * 1.4426950408889634f;
    __syncthreads();
    float m, den; f32x16 O[2];
    attn_online<64, NT, RAD, KP, VP>(O, kimg, vimg, Qf, lane, R0 - 128, sb, sb + L, 0.125f * 1.4426950408889634f, sink_l2, m, den);
    den += __builtin_amdgcn_exp2f(sink_l2 - m);
    const float inv = 1.f / den;
#pragma unroll
    for (int db = 0; db < 2; ++db)
#pragma unroll
        for (int rg = 0; rg < 4; ++rg) { const unsigned long long wv = (unsigned long long)cvtpk_rne(O[db][4 * rg] * inv, O[db][4 * rg + 1] * inv) | ((unsigned long long)cvtpk_rne(O[db][4 * rg + 2] * inv, O[db][4 * rg + 3] * inv) << 32);
            *(unsigned long long*)(AO + (size_t)qrow * D + head * 64 + 32 * db + 8 * rg + 4 * h) = wv; }
    __syncthreads();
}
__device__ __forceinline__ void p_attn_even_mfma(Frame& F, int j) {
    for (int u = F.bx; u < 2 * (M / 32); u += F.G) attn_even_unit(F, j, u & 1, (u >> 1) * 32);
}


template <int L> __device__ __forceinline__ void hyena_unit_mfma64(Frame& F, int j, int s, int ch) {
    constexpr int NB = L / 64, NT = NB / 32, NTL = L / 64, cls = (L == 4096) ? 1 : 0;
    static_assert(NT == NWAVES, "one tile per wave");
    constexpr int UBYTES = (NB + 64) * 144, DC = 4, CP = 704, TSTG = 4 * CP, GOFF = UBYTES + NWAVES * TSTG;
    static_assert(GOFF + L * 2 <= RING_BYTES, "hyena64 LDS");
    const int sb = seq_base(s);
    const int w = F.wave, lane = F.lane, i0 = lane & 31, h = lane >> 5, n0 = 32 * w;
    LAS unsigned char* Ub = F.lds + RING_OFF;
    LAS unsigned char* Tb = F.lds + RING_OFF + UBYTES + w * TSTG;
    LAS float* red = (LAS float*)(F.lds + LDSCTL_OFF + 64);
    const bf16* HYT = (const bf16*)(F.ws + WS_BIG + B_HYT); bf16* ZT = (bf16*)(F.ws + WS_BIG + B_ZT);
    const bf16* TAPS = (const bf16*)(F.ws + WS_BIG + (cls ? B_TAP1 : B_TAP0));
    const float* PS = (const float*)(F.ws + WS_BIG + B_PSUM) + (cls ? (size_t)256 * 4096 : 0);
    const float* cw = F.in[4] + (size_t)j * 3 * 3072; const float* cb = F.in[5] + (size_t)j * 3072; const float* hb = F.in[14] + (size_t)j * 2 * 1024;
    if (w < 2) { const int o = w; float a = 0.f;
        for (int t = lane; t < NTL; t += 64) a += PS[(size_t)t * 4096 + (0 * 2 + o) * 1024 + ch] + PS[(size_t)t * 4096 + (1 * 2 + o) * 1024 + ch];
        a = wave_sum(a); if (lane == 0) red[w] = a; }
    constexpr int NU = (L / 8) / 512;
    {   v4u raw[NU], gr[NU]; unsigned short xm[NU], xp[NU];
        const bf16* hr = HYT + (size_t)ch * M + sb;
#pragma unroll
        for (int it = 0; it < NU; ++it) { const int p8 = 8 * (F.tid + 512 * it);
            raw[it] = *(const v4u*)(hr + p8); xm[it] = p8 > 0 ? hr[p8 - 1] : (unsigned short)0; xp[it] = p8 + 8 < L ? hr[p8 + 8] : (unsigned short)0;
            gr[it] = *(const v4u*)(HYT + (size_t)(1024 + ch) * M + sb + p8); }
        for (int z = F.tid; z < 576; z += 512) { const int blk = z < 288 ? z / 9 : NB + 32 + (z - 288) / 9, part = z % 9;
            *(LAS v4u*)(Ub + blk * 144 + part * 16) = (v4u){0u, 0u, 0u, 0u}; }
        const float w0 = cw[0 * 3072 + ch], w1 = cw[1 * 3072 + ch], w2 = cw[2 * 3072 + ch], b = cb[ch];
#pragma unroll
        for (int it = 0; it < NU; ++it) { const int p8 = 8 * (F.tid + 512 * it);
            float x[10]; x[0] = bf2f(xm[it]); x[9] = bf2f(xp[it]);
#pragma unroll
            for (int q = 0; q < 4; ++q) { x[1 + 2 * q] = bf2f((unsigned short)(raw[it][q] & 0xffff)); x[2 + 2 * q] = bf2f((unsigned short)(raw[it][q] >> 16)); }
            v4u o;
#pragma unroll
            for (int q = 0; q < 4; ++q) o[q] = pk2(b + w0 * x[2 * q] + w1 * x[2 * q + 1] + w2 * x[2 * q + 2], b + w0 * x[2 * q + 1] + w1 * x[2 * q + 2] + w2 * x[2 * q + 3]);
            *(LAS v4u*)(Ub + ((p8 >> 6) + 32) * 144 + (p8 & 63) * 2) = o;
            *(LAS v4u*)(F.lds + RING_OFF + GOFF + p8 * 2) = gr[it]; }
    }
    __syncthreads();
    const int c4 = i0 & 3;
    int o8 = 8; asm volatile("" : "+v"(o8));
    const int abase = c4 * CP + 2 * (64 * DC + 8 * h - (i0 & ~3));
    const int bbase = (i0 + 32) * 144 + 16 * h;
    unsigned zpk[2][4][2];
#pragma unroll 1
    for (int o = 0; o < 2; ++o) {
        f32x16 acc[2];
#pragma unroll
        for (int mi = 0; mi < 2; ++mi)
#pragma unroll
            for (int r = 0; r < 16; ++r) acc[mi][r] = 0.f;
        const bf16* TRg = TAPS + (size_t)(o * 1024 + ch) * (2 * L);
        v4u Xr, Pr;
        { const int wbase = L - 64 * (n0 - NB) - 64 * DC; int xi = wbase + 8 * lane, pi = xi - 8; xi = xi < 0 ? 0 : (xi > 2 * L - 8 ? 2 * L - 8 : xi); pi = pi < 0 ? 0 : (pi > 2 * L - 8 ? 2 * L - 8 : pi);
          if (lane < 8 * DC + 8) { Xr = *(const v4u*)(TRg + xi); Pr = *(const v4u*)(TRg + pi); } }
#pragma unroll 1
        for (int e0 = -NB; e0 < 32; e0 += DC) {
            if (lane < 8 * DC + 8) { const v4u X = Xr, P = Pr;
                const unsigned a0 = __builtin_amdgcn_alignbit(X.x, P.w, 16), a1 = __builtin_amdgcn_alignbit(X.y, X.x, 16), a2 = __builtin_amdgcn_alignbit(X.z, X.y, 16), a3 = __builtin_amdgcn_alignbit(X.w, X.z, 16), a4 = __builtin_amdgcn_alignbit(P.w, P.z, 16);
                LAS unsigned char* dst = Tb + 16 * lane;
                *(LAS v4u*)(dst) = X;
                *(LAS v4u*)(dst + CP) = (v4u){a0, a1, a2, a3};
                *(LAS v4u*)(dst + 2 * CP) = (v4u){P.w, X.x, X.y, X.z};
                *(LAS v4u*)(dst + 3 * CP) = (v4u){a4, a0, a1, a2}; }
            if (e0 + DC < 32) { const int wbase = L - 64 * (n0 + e0 + DC) - 64 * DC; int xi = wbase + 8 * lane, pi = xi - 8; xi = xi < 0 ? 0 : (xi > 2 * L - 8 ? 2 * L - 8 : xi); pi = pi < 0 ? 0 : (pi > 2 * L - 8 ? 2 * L - 8 : pi);
                if (lane < 8 * DC + 8) { Xr = *(const v4u*)(TRg + xi); Pr = *(const v4u*)(TRg + pi); } }
            const LAS unsigned char* bp = Ub + bbase - e0 * 144;
#pragma unroll
            for (int dd = 0; dd < DC; ++dd) {
                bf16x8 Bf[4];
#pragma unroll
                for (int ks = 0; ks < 4; ++ks) Bf[ks] = *(const LAS bf16x8*)(bp - 144 * dd + 32 * ks);
                bf16x8 Fq[6];
#pragma unroll
                for (int qi = 0; qi < 6; ++qi) { const LAS unsigned char* ap = Tb + abase - 128 * dd - 32 * (qi - 3);
                    const s16x4 lo = *(const LAS s16x4*)ap, hi = *(const LAS s16x4*)(ap + o8);
                    Fq[qi] = __builtin_shufflevector(lo, hi, 0, 1, 2, 3, 4, 5, 6, 7); }
#pragma unroll
                for (int ks = 0; ks < 4; ++ks)
#pragma unroll
                    for (int mi = 0; mi < 2; ++mi) acc[mi] = __builtin_amdgcn_mfma_f32_32x32x16_bf16(Fq[2 * mi - ks + 3], Bf[ks], acc[mi], 0, 0, 0);
            }
        }
        int i0e = i0, he = h; asm volatile("" : "+v"(i0e), "+v"(he));
        const float invS = 1.f / red[o]; const float bias = hb[o * 1024 + ch];
        const int gch = (o == 0 ? 1024 : 2048) + ch;
        const LAS bf16* Gr = (const LAS bf16*)(F.lds + RING_OFF + GOFF); const float w0 = cw[0 * 3072 + gch], w1 = cw[1 * 3072 + gch], w2 = cw[2 * 3072 + gch], b = cb[gch];
#pragma unroll
        for (int mi = 0; mi < 2; ++mi) {
#pragma unroll
            for (int rg = 0; rg < 4; ++rg) { const int p = 64 * (n0 + i0e) + 32 * mi + 8 * rg + 4 * he;
                const s16x4 uu = *(const LAS s16x4*)(Ub + ((p >> 6) + 32) * 144 + (p & 63) * 2);
                const s16x4 gm = *(const LAS s16x4*)(Gr + p);
                float hx[6]; hx[0] = p > 0 ? bf2f(Gr[p - 1]) : 0.f; hx[5] = p + 4 < L ? bf2f(Gr[p + 4]) : 0.f;
#pragma unroll
                for (int q = 0; q < 4; ++q) hx[1 + q] = bf2f((unsigned short)gm[q]);
                float z[4];
#pragma unroll
                for (int q = 0; q < 4; ++q) { const float gate = b + w0 * hx[q] + w1 * hx[q + 1] + w2 * hx[q + 2];
                    const float y = acc[mi][4 * rg + q] * invS + bias * bf2f((unsigned short)uu[q]); z[q] = gate * y; }
                if (o == 0) { zpk[mi][rg][0] = pk2(z[0], z[1]); zpk[mi][rg][1] = pk2(z[2], z[3]); }
                else { unsigned long long wv = (unsigned long long)pk2(z[0], z[1]) | ((unsigned long long)pk2(z[2], z[3]) << 32); *(unsigned long long*)(ZT + (size_t)ch * M + sb + p) = wv; } }
        }
        __syncthreads();
        if (o == 0) {
#pragma unroll
            for (int mi = 0; mi < 2; ++mi)
#pragma unroll
                for (int rg = 0; rg < 4; ++rg) { const int p = 64 * (n0 + i0e) + 32 * mi + 8 * rg + 4 * he;
                    *(LAS unsigned long long*)(Ub + ((p >> 6) + 32) * 144 + (p & 63) * 2) = (unsigned long long)zpk[mi][rg][0] | ((unsigned long long)zpk[mi][rg][1] << 32); }
            {   v4u gr[NU];
#pragma unroll
                for (int it = 0; it < NU; ++it) { const int p8 = 8 * (F.tid + 512 * it); gr[it] = *(const v4u*)(HYT + (size_t)(2048 + ch) * M + sb + p8); }
#pragma unroll
                for (int it = 0; it < NU; ++it) { const int p8 = 8 * (F.tid + 512 * it); *(LAS v4u*)(F.lds + RING_OFF + GOFF + p8 * 2) = gr[it]; } }
            __syncthreads();
        }
    }
}


template <int L> __device__ __forceinline__ void hyena_unit_mfma128(Frame& F, int j, int s, int ch) {
    constexpr int NB = L / 128, NTL = L / 64, cls = (L == 4096) ? 1 : 0, DC = 2, CP = 832;
    static_assert(NB == 128, "four tiles, two waves each");
    constexpr int UBYTES = (NB + 64) * 272, XOFF = UBYTES, TSTG = 4 * CP, GOFF = XOFF + NWAVES * TSTG, XBYTES = 65536;
    static_assert(GOFF + L * 2 <= XOFF + XBYTES && XOFF + XBYTES <= RING_BYTES, "hyena128 LDS");
    const int sb = seq_base(s);
    const int w = F.wave, lane = F.lane, i0 = lane & 31, h = lane >> 5, tile = w >> 1, half = w & 1, n0 = 32 * tile;
    LAS unsigned char* Ub = F.lds + RING_OFF;
    LAS unsigned char* Tb = F.lds + RING_OFF + XOFF + w * TSTG;
    LAS float* red = (LAS float*)(F.lds + LDSCTL_OFF + 64);
    const bf16* HYT = (const bf16*)(F.ws + WS_BIG + B_HYT); bf16* ZT = (bf16*)(F.ws + WS_BIG + B_ZT);
    const bf16* TAPS = (const bf16*)(F.ws + WS_BIG + (cls ? B_TAP1 : B_TAP0));
    const float* PS = (const float*)(F.ws + WS_BIG + B_PSUM) + (cls ? (size_t)256 * 4096 : 0);
    const float* cw = F.in[4] + (size_t)j * 3 * 3072; const float* cb = F.in[5] + (size_t)j * 3072; const float* hb = F.in[14] + (size_t)j * 2 * 1024;
    if (w < 2) { const int o = w; float a = 0.f;
        for (int t = lane; t < NTL; t += 64) a += PS[(size_t)t * 4096 + (0 * 2 + o) * 1024 + ch] + PS[(size_t)t * 4096 + (1 * 2 + o) * 1024 + ch];
        a = wave_sum(a); if (lane == 0) red[w] = a; }
    constexpr int NU = (L / 8) / 512;
    {   v4u raw[NU]; unsigned short xm[NU], xp[NU];
        const bf16* hr = HYT + (size_t)ch * M + sb;
#pragma unroll
        for (int it = 0; it < NU; ++it) { const int p8 = 8 * (F.tid + 512 * it);
            raw[it] = *(const v4u*)(hr + p8); xm[it] = p8 > 0 ? hr[p8 - 1] : (unsigned short)0; xp[it] = p8 + 8 < L ? hr[p8 + 8] : (unsigned short)0; }
        for (int z = F.tid; z < 64 * 17; z += 512) { const int b = z / 17, part = z % 17, blk = b < 32 ? b : NB + b;
            *(LAS v4u*)(Ub + blk * 272 + part * 16) = (v4u){0u, 0u, 0u, 0u}; }
        const float w0 = cw[0 * 3072 + ch], w1 = cw[1 * 3072 + ch], w2 = cw[2 * 3072 + ch], b = cb[ch];
#pragma unroll
        for (int it = 0; it < NU; ++it) { const int p8 = 8 * (F.tid + 512 * it);
            float x[10]; x[0] = bf2f(xm[it]); x[9] = bf2f(xp[it]);
#pragma unroll
            for (int q = 0; q < 4; ++q) { x[1 + 2 * q] = bf2f((unsigned short)(raw[it][q] & 0xffff)); x[2 + 2 * q] = bf2f((unsigned short)(raw[it][q] >> 16)); }
            v4u o;
#pragma unroll
            for (int q = 0; q < 4; ++q) o[q] = pk2(b + w0 * x[2 * q] + w1 * x[2 * q + 1] + w2 * x[2 * q + 2], b + w0 * x[2 * q + 1] + w1 * x[2 * q + 2] + w2 * x[2 * q + 3]);
            *(LAS v4u*)(Ub + ((p8 >> 7) + 32) * 272 + (p8 & 127) * 2) = o; }
    }
    __syncthreads();
    const int c4 = i0 & 3;
    int o8 = 8; asm volatile("" : "+v"(o8));
    const int abase = c4 * CP + 2 * (128 * DC + 8 * h - (i0 & ~3));
    const int bbase = (i0 + 32) * 272 + 16 * h;
    const int elo = half ? -48 : -128;
    unsigned zpk[2][4][2];
#pragma unroll 1
    for (int o = 0; o < 2; ++o) {
        f32x16 acc[4];
#pragma unroll
        for (int mi = 0; mi < 4; ++mi)
#pragma unroll
            for (int r = 0; r < 16; ++r) acc[mi][r] = 0.f;
        const bf16* TRg = TAPS + (size_t)(o * 1024 + ch) * (2 * L);
        v4u Xr, Pr;
        { const int wbase = L - 128 * (n0 + elo) - 128 * DC; int xi = wbase + 8 * lane, pi = xi - 8; xi = xi < 0 ? 0 : (xi > 2 * L - 8 ? 2 * L - 8 : xi); pi = pi < 0 ? 0 : (pi > 2 * L - 8 ? 2 * L - 8 : pi);
          if (lane < 48) { Xr = *(const v4u*)(TRg + xi); Pr = *(const v4u*)(TRg + pi); } }
#pragma unroll 1
        for (int ec = 0; ec < 80; ec += DC) { const int e0 = elo + ec;
            if (lane < 48) { const v4u X = Xr, P = Pr;
                const unsigned a0 = __builtin_amdgcn_alignbit(X.x, P.w, 16), a1 = __builtin_amdgcn_alignbit(X.y, X.x, 16), a2 = __builtin_amdgcn_alignbit(X.z, X.y, 16), a3 = __builtin_amdgcn_alignbit(X.w, X.z, 16), a4 = __builtin_amdgcn_alignbit(P.w, P.z, 16);
                LAS unsigned char* dst = Tb + 16 * lane;
                *(LAS v4u*)(dst) = X;
                *(LAS v4u*)(dst + CP) = (v4u){a0, a1, a2, a3};
                *(LAS v4u*)(dst + 2 * CP) = (v4u){P.w, X.x, X.y, X.z};
                *(LAS v4u*)(dst + 3 * CP) = (v4u){a4, a0, a1, a2}; }
            if (ec + DC < 80) { const int wbase = L - 128 * (n0 + e0 + DC) - 128 * DC; int xi = wbase + 8 * lane, pi = xi - 8; xi = xi < 0 ? 0 : (xi > 2 * L - 8 ? 2 * L - 8 : xi); pi = pi < 0 ? 0 : (pi > 2 * L - 8 ? 2 * L - 8 : pi);
                if (lane < 48) { Xr = *(const v4u*)(TRg + xi); Pr = *(const v4u*)(TRg + pi); } }
            const LAS unsigned char* bp = Ub + bbase - e0 * 272;
#pragma unroll
            for (int dd = 0; dd < DC; ++dd) {
                bf16x8 Bf[8];
#pragma unroll
                for (int ks = 0; ks < 8; ++ks) Bf[ks] = *(const LAS bf16x8*)(bp - 272 * dd + 32 * ks);
                bf16x8 Fq[14];
#pragma unroll
                for (int qi = 0; qi < 14; ++qi) { const LAS unsigned char* ap = Tb + abase - 256 * dd - 32 * (qi - 7);
                    const s16x4 lo = *(const LAS s16x4*)ap, hi = *(const LAS s16x4*)(ap + o8);
                    Fq[qi] = __builtin_shufflevector(lo, hi, 0, 1, 2, 3, 4, 5, 6, 7); }
#pragma unroll
                for (int ks = 0; ks < 8; ++ks)
#pragma unroll
                    for (int mi = 0; mi < 4; ++mi) acc[mi] = __builtin_amdgcn_mfma_f32_32x32x16_bf16(Fq[2 * mi - ks + 7], Bf[ks], acc[mi], 0, 0, 0);
            }
        }
        int i0e = i0, he = h; asm volatile("" : "+v"(i0e), "+v"(he));
        __syncthreads();
        {   LAS unsigned char* mine = F.lds + RING_OFF + XOFF + (tile * 2 + half) * 8192 + (i0e + 32 * he) * 16;
#pragma unroll
            for (int ml = 0; ml < 2; ++ml)
#pragma unroll
                for (int rg = 0; rg < 4; ++rg) { const int mo = 2 * (1 - half) + ml;
                    f32x4 v; v[0] = half ? acc[0 + ml][4 * rg + 0] : acc[2 + ml][4 * rg + 0]; v[1] = half ? acc[0 + ml][4 * rg + 1] : acc[2 + ml][4 * rg + 1];
                    v[2] = half ? acc[0 + ml][4 * rg + 2] : acc[2 + ml][4 * rg + 2]; v[3] = half ? acc[0 + ml][4 * rg + 3] : acc[2 + ml][4 * rg + 3]; (void)mo;
                    *(LAS f32x4*)(mine + (ml * 4 + rg) * 1024) = v; } }
        v4u gr[NU];
        const int gch = (o == 0 ? 1024 : 2048) + ch;
#pragma unroll
        for (int it = 0; it < NU; ++it) gr[it] = *(const v4u*)(HYT + (size_t)gch * M + sb + 8 * (F.tid + 512 * it));
        __syncthreads();
        f32x16 fin[2];
        {   const LAS unsigned char* theirs = F.lds + RING_OFF + XOFF + (tile * 2 + (1 - half)) * 8192 + (i0e + 32 * he) * 16;
#pragma unroll
            for (int ml = 0; ml < 2; ++ml)
#pragma unroll
                for (int rg = 0; rg < 4; ++rg) { const f32x4 v = *(const LAS f32x4*)(theirs + (ml * 4 + rg) * 1024);
#pragma unroll
                    for (int q = 0; q < 4; ++q) fin[ml][4 * rg + q] = (half ? acc[2 + ml][4 * rg + q] : acc[0 + ml][4 * rg + q]) + v[q]; } }
        __syncthreads();
#pragma unroll
        for (int it = 0; it < NU; ++it) *(LAS v4u*)(F.lds + RING_OFF + GOFF + 16 * (F.tid + 512 * it)) = gr[it];
        __syncthreads();
        const float invS = 1.f / red[o]; const float bias = hb[o * 1024 + ch];
        const LAS bf16* Gr = (const LAS bf16*)(F.lds + RING_OFF + GOFF); const float w0 = cw[0 * 3072 + gch], w1 = cw[1 * 3072 + gch], w2 = cw[2 * 3072 + gch], b = cb[gch];
#pragma unroll
        for (int ml = 0; ml < 2; ++ml) { const int mi = 2 * half + ml;
#pragma unroll
            for (int rg = 0; rg < 4; ++rg) { const int p = 128 * (n0 + i0e) + 32 * mi + 8 * rg + 4 * he;
                const s16x4 uu = *(const LAS s16x4*)(Ub + ((p >> 7) + 32) * 272 + (p & 127) * 2);
                const s16x4 gm = *(const LAS s16x4*)(Gr + p);
                float hx[6]; hx[0] = p > 0 ? bf2f(Gr[p - 1]) : 0.f; hx[5] = p + 4 < L ? bf2f(Gr[p + 4]) : 0.f;
#pragma unroll
                for (int q = 0; q < 4; ++q) hx[1 + q] = bf2f((unsigned short)gm[q]);
                float z[4];
#pragma unroll
                for (int q = 0; q < 4; ++q) { const float gate = b + w0 * hx[q] + w1 * hx[q + 1] + w2 * hx[q + 2];
                    const float y = fin[ml][4 * rg + q] * invS + bias * bf2f((unsigned short)uu[q]); z[q] = gate * y; }
                if (o == 0) { zpk[ml][rg][0] = pk2(z[0], z[1]); zpk[ml][rg][1] = pk2(z[2], z[3]); }
                else { unsigned long long wv = (unsigned long long)pk2(z[0], z[1]) | ((unsigned long long)pk2(z[2], z[3]) << 32); *(unsigned long long*)(ZT + (size_t)ch * M + sb + p) = wv; } }
        }
        __syncthreads();
        if (o == 0) {
#pragma unroll
            for (int ml = 0; ml < 2; ++ml) { const int mi = 2 * half + ml;
#pragma unroll
                for (int rg = 0; rg < 4; ++rg) { const int p = 128 * (n0 + i0e) + 32 * mi + 8 * rg + 4 * he;
                    *(LAS unsigned long long*)(Ub + ((p >> 7) + 32) * 272 + (p & 127) * 2) = (unsigned long long)zpk[ml][rg][0] | ((unsigned long long)zpk[ml][rg][1] << 32); } }
            __syncthreads();
        }
    }
}

__device__ __forceinline__ void taps_unit_mfma(Frame& F, int j, int cls, int tile, int cq) {
    const int L = cls ? 4096 : 16384; const int i0 = tile * 64;
    const int dir = cq >> 1, shift = dir == 0 ? 1 : 0;
    LAS float* zf = (LAS float*)(F.lds + RING_OFF);
    LAS float* h1 = zf + 64 * 35;
    LAS unsigned char* h2b = (LAS unsigned char*)(h1 + 64 * 65);
    LAS float* w1s = (LAS float*)(h2b + 64 * 144);
    LAS float* w2s = w1s + 34 * 64 + 128;
    LAS unsigned char* timg = (LAS unsigned char*)(w2s + 64 * 64 + 128) + F.wave * 4608;
    static_assert(((64 * 35 + 64 * 65) * 4) % 16 == 0, "h2b alignment");
    const float* w1 = F.in[6] + (size_t)j * 33 * 64; const float* b1 = F.in[7] + j * 64; const float* f1 = F.in[8] + j * 64;
    const float* w2 = F.in[9] + (size_t)j * 64 * 64; const float* b2 = F.in[10] + j * 64; const float* f2 = F.in[11] + j * 64;
    const float* w3 = F.in[12] + (size_t)j * 64 * 4096; const float* b3 = F.in[13] + (size_t)j * 4096;
    for (int idx = F.tid; idx < 34 * 64; idx += 512) w1s[idx] = idx < 33 * 64 ? w1[idx] : 0.f;
    for (int idx = F.tid; idx < 64 * 64; idx += 512) w2s[idx] = w2[idx];
    if (F.tid < 64) { w1s[34 * 64 + F.tid] = b1[F.tid]; w1s[34 * 64 + 64 + F.tid] = f1[F.tid]; w2s[64 * 64 + F.tid] = b2[F.tid]; w2s[64 * 64 + 64 + F.tid] = f2[F.tid]; }
    for (int idx = F.tid; idx < 64 * 34; idx += 512) { const int p = idx / 34, f = idx % 34, i = i0 + shift + p; float val;
        if (f == 0) val = (float)i / (float)(L - 1);
        else if (f == 33) val = 0.f;
        else { const int mm = (f - 1) & 15; const float band = 1e-4f + (float)mm * ((15.0f - 1e-4f) / 15.0f); const float w = 6.283185307179586f * (float)i / (float)L;
            float sn, cs; sincos_f(band * w, sn, cs); val = f <= 16 ? cs : -sn; }
        zf[p * 35 + f] = val; }
    __syncthreads();
    {   int lane = F.lane; asm volatile("" : "+v"(lane)); const int li = lane & 31, lh = lane >> 5, pt = F.wave >> 1, ct = F.wave & 1;
        if (F.wave < 4) { f32x16 c;
#pragma unroll
            for (int r = 0; r < 16; ++r) c[r] = 0.f;
#pragma unroll
            for (int kk = 0; kk < 17; ++kk) c = __builtin_amdgcn_mfma_f32_32x32x2f32(zf[(32 * pt + li) * 35 + 2 * kk + lh], w1s[(2 * kk + lh) * 64 + 32 * ct + li], c, 0, 0, 0);
            const float bb1 = w1s[34 * 64 + 32 * ct + li], ff1 = w1s[34 * 64 + 64 + 32 * ct + li];
#pragma unroll
            for (int r = 0; r < 16; ++r) h1[(32 * pt + crow32(r, lh)) * 65 + 32 * ct + li] = sin_f(ff1 * (c[r] + bb1)); }
        __syncthreads();
        if (F.wave < 4) { f32x16 c;
#pragma unroll
            for (int r = 0; r < 16; ++r) c[r] = 0.f;
#pragma unroll
            for (int kk = 0; kk < 32; ++kk) c = __builtin_amdgcn_mfma_f32_32x32x2f32(h1[(32 * pt + li) * 65 + 2 * kk + lh], w2s[(2 * kk + lh) * 64 + 32 * ct + li], c, 0, 0, 0);
            const float bb2 = w2s[64 * 64 + 32 * ct + li], ff2 = w2s[64 * 64 + 64 + 32 * ct + li];
#pragma unroll
            for (int r = 0; r < 16; ++r) *(LAS bf16*)(h2b + (32 * pt + crow32(r, lh)) * 144 + (32 * ct + li) * 2) = (bf16)f2bf(sin_f(ff2 * (c[r] + bb2))); }
    }
    __syncthreads();
    int lane = F.lane; asm volatile("" : "+v"(lane));
    const int cl = lane & 31, h = lane >> 5;
    bf16* TAPS = (bf16*)(F.ws + WS_BIG + (cls ? B_TAP1 : B_TAP0));
    float* PS = (float*)(F.ws + WS_BIG + B_PSUM) + (cls ? (size_t)256 * 4096 : 0) + (size_t)tile * 4096;
    const float dmin = -3.0701134573253943f, dmax = -15.350567286626973f;
    const int colw = cq * 1024 + F.wave * 128;
    float wv[2][32];
    const float* w3p = w3 + (size_t)(8 * h) * 4096 + colw + cl;
#pragma unroll
    for (int ks = 0; ks < 4; ++ks)
#pragma unroll
        for (int q = 0; q < 8; ++q) wv[0][8 * ks + q] = w3p[(size_t)(16 * ks + q) * 4096];
#pragma unroll
    for (int cbi = 0; cbi < 4; ++cbi) { const int col0 = colw + cbi * 32, col = col0 + cl;
        if (cbi < 3) {
#pragma unroll
            for (int ks = 0; ks < 4; ++ks)
#pragma unroll
                for (int q = 0; q < 8; ++q) wv[(cbi + 1) & 1][8 * ks + q] = w3p[(size_t)(16 * ks + q) * 4096 + (cbi + 1) * 32]; }
        bf16x8 Wf[4];
#pragma unroll
        for (int ks = 0; ks < 4; ++ks) { const float* v = &wv[cbi & 1][8 * ks];
            u32x4_t pw; pw.x = cvtpk_rne(v[0], v[1]); pw.y = cvtpk_rne(v[2], v[3]); pw.z = cvtpk_rne(v[4], v[5]); pw.w = cvtpk_rne(v[6], v[7]); Wf[ks] = __builtin_bit_cast(bf16x8, pw); }
        const int o = (col >> 10) & 1, ch = col & 1023;
        const float dl2 = -1.4426950408889634f * fabsf(dmin + (dmax - dmin) * ((float)ch * (1.0f / 1023.0f))), bb = b3[col];
        float v0 = 0.f;
        if (dir == 1 && tile == 0) { float a = b3[col - 2048];
            for (int k = 0; k < 64; ++k) a += bf2f(*(const LAS bf16*)(h2b + k * 2)) * w3[(size_t)k * 4096 + col - 2048];
            v0 = a; }
        float asum = 0.f;
#pragma unroll
        for (int pt = 0; pt < 2; ++pt) { f32x16 acc;
#pragma unroll
            for (int r = 0; r < 16; ++r) acc[r] = 0.f;
#pragma unroll
            for (int ks = 0; ks < 4; ++ks) { const bf16x8 Hf = *(const LAS bf16x8*)(h2b + (pt * 32 + cl) * 144 + 32 * ks + 16 * h); acc = __builtin_amdgcn_mfma_f32_32x32x16_bf16(Hf, Wf[ks], acc, 0, 0, 0); }
#pragma unroll
            for (int rg = 0; rg < 4; ++rg) { const int pp = 32 * pt + 8 * rg + 4 * h; float val[4];
#pragma unroll
                for (int q = 0; q < 4; ++q) { const int i = i0 + shift + pp + q; const float ti = (float)i / (float)(L - 1);
                    float x = (acc[4 * rg + q] + bb) * __builtin_amdgcn_exp2f(ti * dl2);
                    if (i >= L) x = 0.f;
                    if (dir == 1 && i == 0) x = v0;
                    val[q] = x; asum += fabsf(x); }
                if (dir == 0) *(LAS unsigned long long*)(timg + cl * 144 + (60 - pp) * 2) = (unsigned long long)pk2(val[3], val[2]) | ((unsigned long long)pk2(val[1], val[0]) << 32);
                else *(LAS unsigned long long*)(timg + cl * 144 + pp * 2) = (unsigned long long)pk2(val[0], val[1]) | ((unsigned long long)pk2(val[2], val[3]) << 32); }
        }
        asum += __shfl_xor(asum, 32);
        if (h == 0) PS[col] = asum;
        const size_t ibase = dir == 0 ? (size_t)(L - i0 - 64) : (size_t)(L + i0);
#pragma unroll
        for (int ps = 0; ps < 4; ++ps) { const int cc = (lane >> 3) + 8 * ps, ck = lane & 7; const int colc = col0 + cc;
            const v4u vv = *(const LAS v4u*)(timg + cc * 144 + ck * 16);
            *(v4u*)(TAPS + ((size_t)(((colc >> 10) & 1) * 1024 + (colc & 1023))) * (2 * L) + ibase + 8 * ck) = vv; }
    }
    __syncthreads();
}

__device__ __forceinline__ void p_zt_transpose(Frame& F) {
    const bf16* ZT = (const bf16*)(F.ws + WS_BIG + B_ZT); bf16* AO = (bf16*)(F.ws + WS_XB);
#pragma unroll 4
    for (int it = F.bx * 512 + F.tid; it < M * 128; it += F.G * 512) {
        const int tok = it % M, cg = it / M;
        unsigned short v[8];
#pragma unroll
        for (int e = 0; e < 8; ++e) v[e] = ZT[(size_t)(cg * 8 + e) * M + tok];
        v4u o; o.x = v[0] | ((unsigned)v[1] << 16); o.y = v[2] | ((unsigned)v[3] << 16); o.z = v[4] | ((unsigned)v[5] << 16); o.w = v[6] | ((unsigned)v[7] << 16);
        *(v4u*)(AO + (size_t)tok * D + 1024 + cg * 8) = o;
    }
}

#ifndef MK_HYENA32
#define MK_HYENA32 1
#endif
#ifndef MK_TAPS_NAIVE
#define MK_TAPS_NAIVE 0
#endif
#ifndef MK_PROBE_REP
#define MK_PROBE_REP -1
#endif
#ifndef MK_ATTN_NAIVE
#define MK_ATTN_NAIVE 0
#endif
#ifndef MK_HYENA_NAIVE
#define MK_HYENA_NAIVE 0
#endif
#ifndef MK_MASK
#define MK_MASK 0xFFFFF
#endif
#define HAS(b) ((MK_MASK >> (b)) & 1)
struct Args { const float* in[25]; float* out; unsigned char* ws; int ph_lo, ph_hi; };
__global__ void __launch_bounds__(NWAVES * 64, 2) mk_fwd(Args args) {
    extern __shared__ __attribute__((aligned(16))) unsigned char lds[];
    Frame F;
    F.lds = (LAS unsigned char*)lds;
    F.MISC = (volatile LAS unsigned*)(F.lds + MISC_OFF);
    F.tid = threadIdx.x; F.lane = F.tid & 63; F.wave = __builtin_amdgcn_readfirstlane(F.tid >> 6);
    F.G = gridDim.x; F.bx = blockIdx.x;
    F.ws = args.ws; F.ctl = (gu32*)(args.ws + WS_CTL); F.X = args.out;
    for (int u = F.tid; u < (LDS_BYTES - LDSCTL_OFF) / 4; u += NWAVES * 64) ((LAS unsigned*)(F.lds + LDSCTL_OFF))[u] = 0u;
    __syncthreads();
    const int lo = args.ph_lo, hi = args.ph_hi;
    XcdBarrier bar; bar.bar = (unsigned*)(F.ctl + CW_BAR); bar.x = 0; bar.st = nullptr;
    if (hi - lo > 1) bar = xcd_barrier_post((unsigned*)(F.ctl + CW_BAR), F.MISC + 8);
#define IN(k) (lo <= (k) && (k) < hi)
#define SEAM(k) do { if ((k) + 1 < hi) { xcd_barrier(bar); if (MK_PROBE_REP == 50) xcd_barrier(bar); } } while (0)
#define XB ((bf16*)(F.ws + WS_XB))
#define Wb ((bf16*)(F.ws + WS_W))
#define BIG (F.ws + WS_BIG)

    if (HAS(0) && IN(0)) p_input(F);
    for (int layer = 0; layer < DEPTH; ++layer) {
        const int pb = layer * PH_PER_LAYER; const bool even = !(layer & 1); const int j = layer >> 1;
#define FRESH() do { int l_; asm volatile("v_mbcnt_lo_u32_b32 %0, -1, 0\n\tv_mbcnt_hi_u32_b32 %0, -1, %0" : "=v"(l_)); int bx_ = blockIdx.x; asm volatile("" : "+s"(bx_)); F.bx = bx_; F.lane = l_; F.tid = F.wave * 64 + l_; unsigned char* w_ = args.ws; float* x_ = args.out; asm volatile("" : "+s"(w_), "+s"(x_)); F.ws = w_; F.X = x_; } while (0)
#define BODY0 do { p_convert_weights(F, layer); __syncthreads(); if (MK_PROBE_REP == 30) { p_convert_weights(F, layer); __syncthreads(); } \
            if (even) { if (MK_TAPS_NAIVE) { for (int t = F.bx; t < 320; t += F.G) { if (t < 256) taps_tile(F, j, 0, t); else taps_tile(F, j, 1, t - 256); } } \
                        else { for (int rp = 0; rp < (MK_PROBE_REP == 31 ? 2 : 1); ++rp) for (int u = F.bx; u < 1280; u += F.G) { const int t = u >> 2; if (t < 256) taps_unit_mfma(F, j, 0, t, u & 3); else taps_unit_mfma(F, j, 1, t - 256, u & 3); } } } } while (0)
#define BODY1 do { if (even) { \
                { pg8::Gemm g{XB, (const bf16*)((unsigned char*)Wb + W_IN), M, 1280, D}; pg8::StaticOrder S; S.init(M, 1280, F.G, F.bx); \
                  pg8::EpiEvenQKV E{(bf16*)(BIG + B_Q), (bf16*)(BIG + B_K), (bf16*)(BIG + B_V), (const float*)(F.ws + WS_COSE), (const float*)(F.ws + WS_SINE)}; \
                  pg8::gemm_phase<pg8::EpiEvenQKV, pg8::StaticOrder, true, true>(F.lds + RING_OFF, g, S, E, F.wave); } \
                { pg8::Gemm g{(const bf16*)((unsigned char*)Wb + W_IN) + (size_t)1280 * D, XB, 3072, M, D}; pg8::StaticOrder S; S.init(3072, M, F.G, (int)(((unsigned)F.bx + 128u) % (unsigned)F.G)); \
                  pg8::EpiPlainBf16 E{(bf16*)(BIG + B_HYT), M}; \
                  pg8::gemm_phase<pg8::EpiPlainBf16, pg8::StaticOrder, true, true>(F.lds + RING_OFF, g, S, E, F.wave); } \
            } else { \
                pg8::Gemm g{XB, (const bf16*)((unsigned char*)Wb + W_IN), M, O_PROJ, D}; pg8::StaticOrder S; S.init(M, O_PROJ, F.G, F.bx); \
                pg8::EpiOddQKV E{(bf16*)BIG, (const float*)(F.ws + WS_COSO), (const float*)(F.ws + WS_SINO), M}; \
                pg8::gemm_phase<pg8::EpiOddQKV, pg8::StaticOrder, true, true>(F.lds + RING_OFF, g, S, E, F.wave); } } while (0)
#define BODY2 do { if (even) { \
                if (MK_HYENA_NAIVE) { for (int u = F.bx; u < 3072; u += F.G) { if (u < 1024) hyena_unit_naive<16384>(F, j, 0, u); else hyena_unit_naive<4096>(F, j, 1 + ((u - 1024) >> 10), (u - 1024) & 1023); } } \
                else { for (int u = F.bx; u < 2048; u += F.G) { if (u < 1024) { if (MK_HYENA32 == 1) hyena_unit_mfma<16384, 2>(F, j, 0, u); else if (MK_HYENA32 == 2) hyena_unit_mfma64<16384>(F, j, 0, u); else hyena_unit_mfma128<16384>(F, j, 0, u); } else hyena_unit_mfma<4096, 1>(F, j, 1 + ((u - 1024) >> 9), 2 * ((u - 1024) & 511)); } } \
                if (MK_ATTN_NAIVE & 1) p_attn_even_naive(F, j); else p_attn_even_mfma(F, j); \
            } else { if (MK_ATTN_NAIVE & 2) p_attn_odd_naive(F); else { if (MK_PROBE_REP == 20) { p_attn_odd_mfma(F, true); __syncthreads(); } p_attn_odd_mfma(F, false); } } } while (0)
#define BODY3 do { if (even) p_zt_transpose(F); else p_combine_odd(F); } while (0)
#define BODY4 do { pg8::Gemm g{XB, (const bf16*)((unsigned char*)Wb + W_OUT), M, D, D}; pg8::StaticOrder S; S.init(M, D, F.G, F.bx); \
            pg8::EpiResid E{F.X, D, ALPHA, layer > 0 ? (const float*)(F.ws + WS_STAT) : nullptr, F.in[23] + (size_t)(layer > 0 ? layer - 1 : 0) * D, F.in[24] + (size_t)(layer > 0 ? layer - 1 : 0) * D, F.X}; \
            if (MK_PROBE_REP == 60) { pg8::EpiResid E2 = E; E2.Xout = (float*)(BIG + 300 * MiB); pg8::gemm_phase<pg8::EpiResid, pg8::StaticOrder, true, true>(F.lds + RING_OFF, g, S, E2, F.wave); __syncthreads(); } \
            pg8::gemm_phase<pg8::EpiResid, pg8::StaticOrder, true, true>(F.lds + RING_OFF, g, S, E, F.wave); } while (0)
#define BODY5 do { p_layernorm(F, F.in[21] + (size_t)layer * D, F.in[22] + (size_t)layer * D, false); } while (0)
#define BODY6 do { pg8::Gemm g{XB, (const bf16*)((unsigned char*)Wb + W_GU), M, 2 * DFF, D}; pg8::StaticOrder S; S.init(M, 2 * DFF, F.G, F.bx); \
            pg8::EpiSwiGLU E{(bf16*)BIG, DFF}; \
            pg8::gemm_phase<pg8::EpiSwiGLU, pg8::StaticOrder, true, true>(F.lds + RING_OFF, g, S, E, F.wave); } while (0)
#define BODY7 do { pg8::Gemm g{(const bf16*)BIG, (const bf16*)((unsigned char*)Wb + W_DN), M, D, DFF}; pg8::StaticOrder S; S.init(M, D, F.G, F.bx); \
            pg8::EpiResid E{F.X, D, ALPHA, (const float*)(F.ws + WS_STAT), F.in[21] + (size_t)layer * D, F.in[22] + (size_t)layer * D, F.X}; \
            if (MK_PROBE_REP == 61) { pg8::EpiResid E2 = E; E2.Xout = (float*)(BIG + 300 * MiB); pg8::gemm_phase<pg8::EpiResid, pg8::StaticOrder, true, true>(F.lds + RING_OFF, g, S, E2, F.wave); __syncthreads(); } \
            pg8::gemm_phase<pg8::EpiResid, pg8::StaticOrder, true, true>(F.lds + RING_OFF, g, S, E, F.wave); } while (0)
#define BODY8 do { p_layernorm(F, F.in[23] + (size_t)layer * D, F.in[24] + (size_t)layer * D, layer == DEPTH - 1); } while (0)
#define SITE(k, BODY) if (HAS(k) && IN(pb + (k))) { FRESH(); BODY; if (MK_PROBE_REP == (k) && ((k) != 2 || even)) { __syncthreads(); FRESH(); BODY; } SEAM(pb + (k)); }
        SITE(0, BODY0)
        SITE(1, BODY1)
        SITE(2, BODY2)
        SITE(3, BODY3)
        SITE(4, BODY4)
        SITE(5, BODY5)
        SITE(6, BODY6)
        SITE(7, BODY7)
        SITE(8, BODY8)
    }
#undef IN
#undef SEAM
#undef FRESH
#undef XB
#undef Wb
#undef BIG
}

#ifndef MK_ONE_LAUNCH
#define MK_ONE_LAUNCH 1
#endif
extern "C" void kernel_launch(void* const* d_in, const int* in_sizes, int n_in, void* d_out, int out_size, void* d_ws, size_t ws_size, hipStream_t stream) {
    static int grid = 0;
    if (grid == 0) {
        if (n_in != 25 || out_size != M * D || ws_size < WS_END) { fprintf(stderr, "kernel_launch: unexpected shapes (n_in %d, out %d, ws %zu < %zu)\n", n_in, out_size, ws_size, (size_t)WS_END); grid = -1; return; }
        int dev = 0, cus = 0, per_cu = 0;
        if (hipGetDevice(&dev) != hipSuccess || hipDeviceGetAttribute(&cus, hipDeviceAttributeMultiprocessorCount, dev) != hipSuccess) { grid = -1; return; }
        if (hipFuncSetAttribute((const void*)mk_fwd, hipFuncAttributeMaxDynamicSharedMemorySize, LDS_BYTES) != hipSuccess) { fprintf(stderr, "kernel_launch: hipFuncSetAttribute failed\n"); grid = -1; return; }
        if (hipOccupancyMaxActiveBlocksPerMultiprocessor(&per_cu, (const void*)mk_fwd, NWAVES * 64, LDS_BYTES) != hipSuccess || per_cu < 1) { fprintf(stderr, "kernel_launch: occupancy query says %d\n", per_cu); }
        (void)hipGetLastError();
        grid = cus;
    }
    if (grid < 0) return;
    (void)hipMemsetAsync((char*)d_ws + WS_CTL, 0, CTL_ZERO_BYTES, stream);
    Args a{};
    for (int i = 0; i < 25; ++i) a.in[i] = (const float*)d_in[i];
    a.out = (float*)d_out; a.ws = (unsigned char*)d_ws;
#if MK_ONE_LAUNCH
    a.ph_lo = 0; a.ph_hi = NPHASE;
    hipLaunchKernelGGL(mk_fwd, dim3(grid), dim3(NWAVES * 64), LDS_BYTES, stream, a);
#else
    for (int ph = 0; ph < NPHASE; ++ph) { a.ph_lo = ph; a.ph_hi = ph + 1; hipLaunchKernelGGL(mk_fwd, dim3(grid), dim3(NWAVES * 64), LDS_BYTES, stream, a); }
#endif
}
```

```cpp
#include <hip/hip_runtime.h>
#include <cstdio>
#include <cstdint>
#include <cmath>
#ifndef MK_PROBE_REP
#define MK_PROBE_REP -1
#endif
namespace pg8 {
#define PG8_LAS __attribute__((address_space(3)))
typedef unsigned short bf16_t;
typedef short bf16x8 __attribute__((ext_vector_type(8)));
typedef float f32x4 __attribute__((ext_vector_type(4)));
typedef unsigned u32x4 __attribute__((ext_vector_type(4)));
constexpr int BM = 256, BK = 64, HALF = 128, HTB = HALF * BK * 2  , STAGE_BYTES = 8 * HTB, NXCD = 8, WGM = 8;

__host__ __device__ __forceinline__ int lds_byte(int r, int c) { const int st = (r >> 4) * 2 + (c >> 5), rr = r & 15, cc = c & 31, ob = rr * 64 + cc * 2; return st * 1024 + (ob ^ (((ob >> 9) & 1) << 5)); }
__host__ __device__ __forceinline__ void stage_rc(int b, int& R, int& C) { const int st = b / 1024, sb = b % 1024, swz = sb ^ (((sb >> 9) & 1) << 5); R = (st >> 1) * 16 + swz / 64; C = (st & 1) * 32 + (swz % 64) / 2; }
__host__ __device__ __forceinline__ int perm32(int rho) { const int n = rho >> 4, i = rho & 15; return 8 * (i >> 2) + 4 * n + (i & 3); }

struct Unit { int pm, pn; };
struct Gemm { const bf16_t* A; const bf16_t* Bt; int M, N, K; };

struct StaticOrder {
    int nM, nN, nwg, G, c;
    __host__ __device__ void init(int M, int N, int G_, int c_) { nM = M / BM; nN = N / BM; nwg = nM * nN; G = G_; c = c_; }
    __host__ __device__ bool next(int i, Unit& u) const {
        const long L = (long)i * G + c; if (L >= nwg) return false;
        int wgid = (int)L; { const int q = nwg / NXCD, r = nwg % NXCD, xcd = wgid % NXCD, off = wgid / NXCD; wgid = (xcd < r ? xcd * (q + 1) : r * (q + 1) + (xcd - r) * q) + off; }
        const int nig = WGM * nN, gid = wgid / nig, fm = gid * WGM, gsz = (nM - fm) < WGM ? (nM - fm) : WGM;
        u.pm = fm + ((wgid % nig) % gsz); u.pn = (wgid % nig) / gsz; return true;
    }
    __device__ __forceinline__ void a_ready(const Unit&) const {}
    __device__ __forceinline__ void done(const Unit&) const {}
};

__device__ __forceinline__ unsigned cvt_pk_bf16(float lo, float hi) { unsigned r; asm volatile("v_cvt_pk_bf16_f32 %0, %1, %2" : "=v"(r) : "v"(lo), "v"(hi)); return r; }
typedef float f32x2 __attribute__((ext_vector_type(2)));
__device__ __forceinline__ u32x4 pack8(const f32x4& v0, const f32x4& v1) { u32x4 w; w.x = cvt_pk_bf16(v0[0], v0[1]); w.y = cvt_pk_bf16(v0[2], v0[3]); w.z = cvt_pk_bf16(v1[0], v1[1]); w.w = cvt_pk_bf16(v1[2], v1[3]); return w; }
__device__ __forceinline__ f32x4 shfl_xor4(const f32x4& v, int m) { f32x4 r; r[0] = __shfl_xor(v[0], m); r[1] = __shfl_xor(v[1], m); r[2] = __shfl_xor(v[2], m); r[3] = __shfl_xor(v[3], m); return r; }
__device__ __forceinline__ int seq_base_of_row(int row) { return row < 16384 ? 0 : (row < 20480 ? 16384 : 20480); }

struct EpiPlainBf16 {
    static constexpr bool PERM = true, AFTER_DRAIN = false;
    bf16_t* O; int ldc;
    __device__ __forceinline__ void operator()(const f32x4 (&acc)[2][2][4][2], const Unit& u, int wr, int wc, int fr_, int fq_) const {
        int fr = fr_, fq = fq_; asm volatile("" : "+v"(fr), "+v"(fq));
        const int row0 = u.pm * BM + wr * 64 + fr, col0 = u.pn * BM + wc * 32 + 8 * fq;
#pragma unroll
        for (int ai = 0; ai < 2; ++ai)
#pragma unroll
            for (int m = 0; m < 4; ++m) { bf16_t* rowp = O + (size_t)(row0 + ai * HALF + m * 16) * ldc + col0;
#pragma unroll
                for (int bj = 0; bj < 2; ++bj) *(u32x4*)(rowp + bj * HALF) = pack8(acc[ai][bj][m][0], acc[ai][bj][m][1]); }
    }
};

struct EpiEvenQKV {
    static constexpr bool PERM = true, AFTER_DRAIN = false;
    bf16_t* Q; bf16_t* Kb; bf16_t* Vb; const float* cosT; const float* sinT;
    __device__ __forceinline__ void operator()(const f32x4 (&acc)[2][2][4][2], const Unit& u, int wr, int wc, int fr_, int fq_) const {
        int fr = fr_, fq = fq_; asm volatile("" : "+v"(fr), "+v"(fq));
        const int row0 = u.pm * BM + wr * 64 + fr; const int sbase = seq_base_of_row(u.pm * BM);
        const bool ropew = ((wc & 1) == 0);
        const float sgn = (fq & 1) ? 1.f : -1.f;
#pragma unroll
        for (int ai = 0; ai < 2; ++ai)
#pragma unroll
            for (int m = 0; m < 4; ++m) { const int row = row0 + ai * HALF + m * 16; const int pos = row - sbase;
                f32x4 c0 = {1.f, 1.f, 1.f, 1.f}, c1 = c0, s0 = {0.f, 0.f, 0.f, 0.f}, s1 = s0;
                if (ropew && fq < 2) { c0 = *(const f32x4*)(cosT + (size_t)pos * 8); c1 = *(const f32x4*)(cosT + (size_t)pos * 8 + 4); s0 = *(const f32x4*)(sinT + (size_t)pos * 8); s1 = *(const f32x4*)(sinT + (size_t)pos * 8 + 4); }
#pragma unroll
                for (int bj = 0; bj < 2; ++bj) { f32x4 v0 = acc[ai][bj][m][0], v1 = acc[ai][bj][m][1];
                    const bool is_v = (u.pn == 4 && bj == 1);
                    if (ropew && !is_v) { const f32x4 p0 = shfl_xor4(v0, 16), p1 = shfl_xor4(v1, 16);
                        v0 = v0 * c0 + (p0 * s0) * sgn; v1 = v1 * c1 + (p1 * s1) * sgn; }
                    bf16_t* dst;
                    if (u.pn < 4) dst = Q + (size_t)row * 1024 + u.pn * 256 + bj * HALF + wc * 32 + 8 * fq;
                    else dst = (bj == 0 ? Kb : Vb) + (size_t)row * 128 + wc * 32 + 8 * fq;
                    *(u32x4*)dst = pack8(v0, v1); }
                asm volatile("" ::: "memory"); }
    }
};

struct EpiOddQKV {
    static constexpr bool PERM = true, AFTER_DRAIN = false;
    bf16_t* O; const float* cosT; const float* sinT; int Mtot;
    __device__ __forceinline__ void operator()(const f32x4 (&acc)[2][2][4][2], const Unit& u, int wr, int wc, int fr_, int fq_) const {
        int fr = fr_, fq = fq_; asm volatile("" : "+v"(fr), "+v"(fq));
        const int row0 = u.pm * BM + wr * 64 + fr; const int sbase = seq_base_of_row(u.pm * BM); const int L = sbase == 0 ? 16384 : 4096;
        const int sg = u.pn >> 3, s = sg / 3, g = sg - 3 * s; const int dsh = 2 * g;
        const int ls = L >> dsh;
        const bool ropew = (wc == 0) && (s < 2);
        const float sgn = (fq & 2) ? 1.f : -1.f;
        const int tb = (fq & 1) * 8;
#pragma unroll
        for (int ai = 0; ai < 2; ++ai)
#pragma unroll
            for (int m = 0; m < 4; ++m) { const int row = row0 + ai * HALF + m * 16; const int pos = row - sbase;
                const int prow = sbase + (pos & ((1 << dsh) - 1)) * ls + (pos >> dsh);
                f32x4 c0 = {1.f, 1.f, 1.f, 1.f}, c1 = c0, s0 = {0.f, 0.f, 0.f, 0.f}, s1 = s0;
                if (ropew) { const float* cp = cosT + (size_t)pos * 16 + tb; const float* sp = sinT + (size_t)pos * 16 + tb; c0 = *(const f32x4*)cp; c1 = *(const f32x4*)(cp + 4); s0 = *(const f32x4*)sp; s1 = *(const f32x4*)(sp + 4); }
#pragma unroll
                for (int bj = 0; bj < 2; ++bj) { f32x4 v0 = acc[ai][bj][m][0], v1 = acc[ai][bj][m][1];
                    if (ropew) { const f32x4 p0 = shfl_xor4(v0, 32), p1 = shfl_xor4(v1, 32);
                        v0 = v0 * c0 + (p0 * s0) * sgn; v1 = v1 * c1 + (p1 * s1) * sgn; }
                    const int head = 2 * (u.pn & 7) + bj;
                    bf16_t* dst = O + ((size_t)(sg * 16 + head) * Mtot + prow) * 128 + wc * 32 + 8 * fq;
                    *(u32x4*)dst = pack8(v0, v1); }
                asm volatile("" ::: "memory"); }
    }
};

struct EpiResid {
    static constexpr bool PERM = false, AFTER_DRAIN = false;
    float* X; int ldc; float alpha; const float* stat; const float* g; const float* bt; float* Xout;
    __device__ __forceinline__ void operator()(const f32x4 (&acc)[2][2][4][2], const Unit& u, int wr, int wc, int fr_, int fq_) const {
        int fr = fr_, fq = fq_; asm volatile("" : "+v"(fr), "+v"(fq));
        const int row0 = u.pm * BM + wr * 64 + fr, col0 = u.pn * BM + wc * 32 + 4 * fq;
        f32x4 gv[2][2], bv[2][2];
#pragma unroll
        for (int bj = 0; bj < 2; ++bj)
#pragma unroll
            for (int n = 0; n < 2; ++n) { gv[bj][n] = (f32x4){1.f, 1.f, 1.f, 1.f}; bv[bj][n] = (f32x4){0.f, 0.f, 0.f, 0.f};
                if (stat) { gv[bj][n] = *(const f32x4*)(g + col0 + bj * HALF + n * 16); bv[bj][n] = *(const f32x4*)(bt + col0 + bj * HALF + n * 16); } }
#pragma unroll
        for (int ai = 0; ai < 2; ++ai)
#pragma unroll
            for (int m = 0; m < 4; ++m) { const int row = row0 + ai * HALF + m * 16; float* rowp = X + (size_t)row * ldc + col0;
                float mean = 0.f, rstd = 1.f; if (stat) { const f32x2 st = *(const f32x2*)(stat + 2 * (size_t)row); mean = st.x; rstd = st.y; }
#pragma unroll
                for (int bj = 0; bj < 2; ++bj)
#pragma unroll
                    for (int n = 0; n < 2; ++n) { f32x4* p = (f32x4*)(rowp + bj * HALF + n * 16); const f32x4 t = *p; const f32x4 x = (t - mean) * rstd * gv[bj][n] + bv[bj][n]; *(f32x4*)((float*)p + (Xout - X)) = x * alpha + acc[ai][bj][m][n]; }
                if (m == 3) asm volatile("" ::: "memory"); }
    }
};

struct EpiSwiGLU {
    static constexpr bool PERM = true, AFTER_DRAIN = false;
    bf16_t* H; int ldh;
    static __device__ __forceinline__ float silu_mul(float g, float up) { const float e = __builtin_amdgcn_exp2f(g * -1.4426950408889634f); return g * __builtin_amdgcn_rcpf(1.0f + e) * up; }
    __device__ __forceinline__ void operator()(const f32x4 (&acc)[2][2][4][2], const Unit& u, int wr, int wc, int fr_, int fq_) const {
        int fr = fr_, fq = fq_; asm volatile("" : "+v"(fr), "+v"(fq));
        const int row0 = u.pm * BM + wr * 64 + fr, col0 = u.pn * HALF + wc * 32 + 8 * fq;
#pragma unroll
        for (int ai = 0; ai < 2; ++ai)
#pragma unroll
            for (int m = 0; m < 4; ++m) { bf16_t* dst = H + (size_t)(row0 + ai * HALF + m * 16) * ldh + col0;
                f32x4 h0, h1;
#pragma unroll
                for (int e = 0; e < 4; ++e) { h0[e] = silu_mul(acc[ai][0][m][0][e], acc[ai][1][m][0][e]); h1[e] = silu_mul(acc[ai][0][m][1][e], acc[ai][1][m][1][e]); }
                *(u32x4*)dst = pack8(h0, h1); }
    }
};

template <class Epi, class Sched, bool ALIGN_EPI = false, bool SP2 = false>
__device__ __forceinline__ void gemm_phase(PG8_LAS unsigned char* lds, const Gemm g, const Sched& S, const Epi& E, const int wave_id) {
    int tid_; asm volatile("v_mbcnt_lo_u32_b32 %0, -1, 0\n\tv_mbcnt_hi_u32_b32 %0, -1, %0" : "=v"(tid_)); tid_ += wave_id * 64;
    const int tid = tid_, wid = __builtin_amdgcn_readfirstlane(tid >> 6), lane = tid & 63, wr = wid >> 2, wc = wid & 3, fr = lane & 15, fq = lane >> 4;
    const int K = g.K, nt = K / BK;
    unsigned voffA[2], voffB[2];
#pragma unroll
    for (int i = 0; i < 2; ++i) { int R, C; stage_rc(tid * 16 + i * 8192, R, C); const int Rb = Epi::PERM ? ((R & ~31) + perm32(R & 31)) : R;
        voffA[i] = (unsigned)(R * K + C) * 2u; voffB[i] = (unsigned)(Rb * K + C) * 2u; }
    const size_t kstep = (size_t)(BK * 2);
    const size_t hstep = (size_t)HALF * K * 2;
    const size_t tstep = 2 * hstep;
    const unsigned ldsw = (unsigned)wid * 1024u;
    const int aoff = lds_byte(wr * 64 + fr, fq * 8), boff = lds_byte(wc * 32 + fr, fq * 8);
#define PG8_SA(b, h) (((b) * 2 + (h)) * HTB)
#define PG8_SB(b, h) ((4 + (b) * 2 + (h)) * HTB)
#define PG8_STAGE(bufoff, gbase, voff) do { _Pragma("unroll") for (int _i = 0; _i < 2; ++_i) \
        __builtin_amdgcn_global_load_lds((const unsigned*)((const char*)(gbase) + (voff)[_i]), (PG8_LAS unsigned*)(lds + (bufoff) + ldsw + _i * 8192), 16, 0, 0); } while (0)
#define PG8_LDA(dst, b, h) do { _Pragma("unroll") for (int m = 0; m < 4; ++m) _Pragma("unroll") for (int k = 0; k < 2; ++k) dst[m][k] = *(const PG8_LAS bf16x8*)(lds + PG8_SA(b, h) + aoff + m * 2048 + k * 1024); } while (0)
#define PG8_LDB(dst, b, h) do { _Pragma("unroll") for (int n = 0; n < 2; ++n) _Pragma("unroll") for (int k = 0; k < 2; ++k) dst[n][k] = *(const PG8_LAS bf16x8*)(lds + PG8_SB(b, h) + boff + n * 2048 + k * 1024); } while (0)
#define PG8_MMA(ai, bj, At, Bt) do { __builtin_amdgcn_s_setprio(1); _Pragma("unroll") for (int m = 0; m < 4; ++m) _Pragma("unroll") for (int n = 0; n < 2; ++n) _Pragma("unroll") for (int k = 0; k < 2; ++k) \
        acc[ai][bj][m][n] = __builtin_amdgcn_mfma_f32_16x16x32_bf16(Bt[n][k], At[m][k], acc[ai][bj][m][n], 0, 0, 0); __builtin_amdgcn_s_setprio(0); } while (0)
#define PG8_WAIT_V(n) asm volatile("s_waitcnt vmcnt(" #n ")" ::: "memory")
#define PG8_WAIT_L(n) asm volatile("s_waitcnt lgkmcnt(" #n ")" ::: "memory")
#define PG8_BAR __builtin_amdgcn_s_barrier()
#define PG8_SCHED __builtin_amdgcn_sched_barrier(0)
    Unit cur, nxt; int ui = 0;
    if (!S.next(0, cur)) return;
    f32x4 acc[2][2][4][2];
#pragma unroll
    for (int a = 0; a < 2; ++a)
#pragma unroll
        for (int b = 0; b < 2; ++b)
#pragma unroll
            for (int m = 0; m < 4; ++m)
#pragma unroll
                for (int n = 0; n < 2; ++n) acc[a][b][m][n] = (f32x4){0.f, 0.f, 0.f, 0.f};
    bf16x8 At[4][2], B0[2][2], B1[2][2];
    const char* cA = (const char*)g.A + (size_t)cur.pm * tstep; const char* cB = (const char*)g.Bt + (size_t)cur.pn * tstep;
    S.a_ready(cur);
    if constexpr (SP2) {
        PG8_STAGE(PG8_SB(0, 0), cB, voffB); PG8_STAGE(PG8_SB(0, 1), cB + hstep, voffB); PG8_STAGE(PG8_SA(0, 0), cA, voffA); PG8_STAGE(PG8_SA(0, 1), cA + hstep, voffA);
        if (wr == 1) PG8_BAR;
        PG8_WAIT_V(2); PG8_BAR;
        PG8_STAGE(PG8_SB(1, 0), cB + kstep, voffB); PG8_STAGE(PG8_SA(1, 0), cA + kstep, voffA); PG8_STAGE(PG8_SB(1, 1), cB + hstep + kstep, voffB);
        PG8_WAIT_V(6); PG8_BAR;
    } else {
        PG8_STAGE(PG8_SB(0, 0), cB, voffB); PG8_STAGE(PG8_SA(0, 0), cA, voffA); PG8_STAGE(PG8_SB(0, 1), cB + hstep, voffB); PG8_STAGE(PG8_SA(0, 1), cA + hstep, voffA);
        if (wr == 1) PG8_BAR;
        PG8_WAIT_V(4); PG8_BAR;
        PG8_STAGE(PG8_SB(1, 0), cB + kstep, voffB); PG8_STAGE(PG8_SA(1, 0), cA + kstep, voffA); PG8_STAGE(PG8_SB(1, 1), cB + hstep + kstep, voffB);
        PG8_WAIT_V(6); PG8_BAR;
    }
    for (;;) {
        const bool has_next = S.next(ui + 1, nxt);
        const char* nA = has_next ? (const char*)g.A + (size_t)nxt.pm * tstep : cA; const char* nB = has_next ? (const char*)g.Bt + (size_t)nxt.pn * tstep : cB;
        for (int t = 0; t < nt; t += 2) {
            const bool last = (t == nt - 2);
            const char* a1 = cA + (size_t)(t + 1) * kstep;
            const char* a2 = last ? nA : cA + (size_t)(t + 2) * kstep; const char* b2 = last ? nB : cB + (size_t)(t + 2) * kstep;
            const char* a3 = a2 + kstep; const char* b3 = b2 + kstep;
            if (last && has_next) S.a_ready(nxt);
            if constexpr (SP2) {
            PG8_LDB(B0, 0, 0); PG8_LDB(B1, 0, 1); PG8_SCHED; PG8_LDA(At, 0, 0); PG8_STAGE(PG8_SA(1, 1), a1 + hstep, voffA);
            PG8_WAIT_V(8); PG8_WAIT_L(0); PG8_BAR; PG8_MMA(0, 0, At, B0); PG8_MMA(0, 1, At, B1); PG8_BAR; PG8_SCHED;
            PG8_LDA(At, 0, 1); PG8_STAGE(PG8_SB(0, 0), b2, voffB); PG8_STAGE(PG8_SB(0, 1), b2 + hstep, voffB); PG8_STAGE(PG8_SA(0, 0), a2, voffA);
            PG8_WAIT_V(8); PG8_WAIT_L(0); PG8_BAR; PG8_MMA(1, 0, At, B0); PG8_MMA(1, 1, At, B1); PG8_BAR; PG8_SCHED;
            PG8_LDB(B0, 1, 0); PG8_LDB(B1, 1, 1); PG8_SCHED; PG8_LDA(At, 1, 0); PG8_STAGE(PG8_SA(0, 1), a2 + hstep, voffA);
            PG8_WAIT_V(8); PG8_WAIT_L(0); PG8_BAR; PG8_MMA(0, 0, At, B0); PG8_MMA(0, 1, At, B1); PG8_BAR; PG8_SCHED;
            PG8_LDA(At, 1, 1); PG8_STAGE(PG8_SB(1, 0), b3, voffB); PG8_STAGE(PG8_SB(1, 1), b3 + hstep, voffB); PG8_STAGE(PG8_SA(1, 0), a3, voffA);
            PG8_WAIT_V(8); PG8_WAIT_L(0); PG8_BAR; PG8_MMA(1, 0, At, B0); PG8_MMA(1, 1, At, B1); PG8_BAR; PG8_SCHED;
            } else {
            PG8_LDB(B0, 0, 0); PG8_SCHED; PG8_LDA(At, 0, 0); PG8_STAGE(PG8_SA(1, 1), a1 + hstep, voffA);
            PG8_WAIT_L(8); PG8_BAR; PG8_WAIT_L(0); PG8_MMA(0, 0, At, B0); PG8_BAR; PG8_SCHED;
            PG8_LDB(B1, 0, 1); PG8_STAGE(PG8_SB(0, 0), b2, voffB);
            PG8_BAR; PG8_WAIT_L(0); PG8_MMA(0, 1, At, B1); PG8_BAR;
            PG8_LDA(At, 0, 1); PG8_STAGE(PG8_SA(0, 0), a2, voffA);
            PG8_BAR; PG8_WAIT_L(0); PG8_MMA(1, 0, At, B0); PG8_BAR; PG8_SCHED;
            PG8_STAGE(PG8_SB(0, 1), b2 + hstep, voffB);
            PG8_WAIT_V(6); PG8_BAR; PG8_MMA(1, 1, At, B1); PG8_BAR;
            PG8_LDB(B0, 1, 0); PG8_SCHED; PG8_LDA(At, 1, 0); PG8_STAGE(PG8_SA(0, 1), a2 + hstep, voffA);
            PG8_WAIT_L(8); PG8_BAR; PG8_WAIT_L(0); PG8_MMA(0, 0, At, B0); PG8_BAR; PG8_SCHED;
            PG8_LDB(B1, 1, 1); PG8_STAGE(PG8_SB(1, 0), b3, voffB);
            PG8_BAR; PG8_WAIT_L(0); PG8_MMA(0, 1, At, B1); PG8_BAR;
            PG8_LDA(At, 1, 1); PG8_STAGE(PG8_SA(1, 0), a3, voffA);
            PG8_BAR; PG8_WAIT_L(0); PG8_MMA(1, 0, At, B0); PG8_BAR; PG8_SCHED;
            PG8_STAGE(PG8_SB(1, 1), b3 + hstep, voffB);
            PG8_WAIT_V(6); PG8_BAR; PG8_MMA(1, 1, At, B1); PG8_BAR;
            }
        }
        if constexpr (ALIGN_EPI) { if (wr == 0) PG8_BAR; }
        if constexpr (!Epi::AFTER_DRAIN) { E(acc, cur, wr, wc, fr, fq); S.done(cur); }
        if (!has_next) break;
#pragma unroll
        for (int a = 0; a < 2; ++a)
#pragma unroll
            for (int b = 0; b < 2; ++b)
#pragma unroll
                for (int m = 0; m < 4; ++m)
#pragma unroll
                    for (int n = 0; n < 2; ++n) acc[a][b][m][n] = (f32x4){0.f, 0.f, 0.f, 0.f};
        cur = nxt; cA = nA; cB = nB; ++ui;
        if constexpr (ALIGN_EPI) { if (wr == 1) PG8_BAR; }
    }
    PG8_WAIT_V(0);
    if constexpr (!ALIGN_EPI) { if (wr == 0) PG8_BAR; }
    PG8_BAR;
    if constexpr (Epi::AFTER_DRAIN) { E.fused(acc, cur, wr, wc, fr, fq, lds, wid, lane); S.done(cur); }
#undef PG8_SA
#undef PG8_SB
#undef PG8_STAGE
#undef PG8_LDA
#undef PG8_LDB
#undef PG8_MMA
#undef PG8_WAIT_V
#undef PG8_WAIT_L
#undef PG8_BAR
#undef PG8_SCHED
}
}
#define GAS __attribute__((address_space(1)))
#define LAS __attribute__((address_space(3)))
typedef unsigned short bf16;
typedef unsigned v4u __attribute__((ext_vector_type(4)));
typedef float f32x4 __attribute__((ext_vector_type(4)));
typedef short bf16x8 __attribute__((ext_vector_type(8)));
typedef GAS unsigned gu32;
typedef GAS unsigned long long gu64;
#define RLX_AGENT __ATOMIC_RELAXED, __HIP_MEMORY_SCOPE_AGENT
#define LDS_WAIT() asm volatile("s_waitcnt lgkmcnt(0)" ::: "memory")
#define VM_WAIT() asm volatile("s_waitcnt vmcnt(0)" ::: "memory")
__device__ __forceinline__ unsigned long long rt() { return __builtin_amdgcn_s_memrealtime(); }
__device__ __forceinline__ unsigned f2bf(float f) { unsigned u = __builtin_bit_cast(unsigned, f); return (u + 0x7fffu + ((u >> 16) & 1u)) >> 16; }
__device__ __forceinline__ unsigned pk2(float lo, float hi) { return f2bf(lo) | (f2bf(hi) << 16); }

#define XB_TMO      128
#define XB_XCNT(j)  (256  + 64 * (j))
#define XB_XSUB(j)  (1280 + 64 * (j))
#define XB_XGEN(j)  (2304 + 64 * (j))
#define XB_TOP      3328
#define XB_TOPGEN   3392
#define XCD_BAR_WORDS 3456
#define XB_SPIN_CAP (1u << 22)

__device__ __forceinline__ unsigned xb_ld(unsigned* p)              { return __hip_atomic_load(p, __ATOMIC_RELAXED, __HIP_MEMORY_SCOPE_AGENT); }
__device__ __forceinline__ unsigned xb_add(unsigned* p, unsigned v) { return __hip_atomic_fetch_add(p, v, __ATOMIC_RELAXED, __HIP_MEMORY_SCOPE_AGENT); }
__device__ __forceinline__ unsigned xb_xcc_id() { return (unsigned)__builtin_amdgcn_s_getreg((3 << 11) | 20) & 0xFu; }
#define XB_SPIN(cond, bar) do { unsigned _sp = 0; while (cond) { __builtin_amdgcn_s_sleep(1); \
    if ((++_sp & 255u) == 0u) { if (xb_ld(&(bar)[XB_TMO])) break; if (_sp > XB_SPIN_CAP) { atomicAdd(&(bar)[XB_TMO], 1u); break; } } } } while (0)

struct XcdBarrier {
    unsigned* bar; unsigned x;
    volatile LAS unsigned* st;
};

__device__ __forceinline__ XcdBarrier xcd_barrier_post(unsigned* bar, volatile LAS unsigned* st) {
    XcdBarrier b; b.bar = bar; b.x = xb_xcc_id(); b.st = st;
    if (threadIdx.x == 0) (void)xb_add(&bar[XB_XCNT(b.x)], 1u);
    return b;
}
__device__ __forceinline__ void xcd_barrier_complete(unsigned* bar, unsigned x, unsigned& nloc, unsigned& nx) {
    const unsigned G = gridDim.x * gridDim.y * gridDim.z;
    unsigned sum, cnt, mine, sp = 0u;
    for (;;) {
        sum = 0u; cnt = 0u; mine = 0u;
#pragma unroll
        for (unsigned j = 0; j < 16; ++j) { const unsigned c = xb_ld(&bar[XB_XCNT(j)]); sum += c; cnt += (c > 0u) ? 1u : 0u; mine = (j == x) ? c : mine; }
        if (sum == G) break;
        __builtin_amdgcn_s_sleep(1);
        if ((++sp & 255u) == 0u) { if (xb_ld(&bar[XB_TMO])) break; if (sp > XB_SPIN_CAP) { atomicAdd(&bar[XB_TMO], 1u); break; } }
    }
    nloc = mine > 0u ? mine : 1u; nx = cnt > 0u ? cnt : 1u;
}

__device__ __forceinline__ void xcd_barrier(const XcdBarrier& b) {
    asm volatile("s_waitcnt vmcnt(0)" ::: "memory");
    __syncthreads();
    if (threadIdx.x == 0) {
        unsigned* bar = b.bar;
        __builtin_amdgcn_s_waitcnt(0);
        unsigned nloc = b.st[0], nx = b.st[1];
        if (nloc == 0u) { xcd_barrier_complete(bar, b.x, nloc, nx); b.st[0] = nloc; b.st[1] = nx; }
        const unsigned old = xb_add(&bar[XB_XSUB(b.x)], 1u);
        const unsigned gen = old / nloc;
        if (old + 1u == (gen + 1u) * nloc) {
            __builtin_amdgcn_fence(__ATOMIC_RELEASE, "agent");
            asm volatile("s_waitcnt vmcnt(0)" ::: "memory");
            const unsigned og = xb_add(&bar[XB_TOP], 1u);
            const unsigned tg = og / nx;
            if (og + 1u == (tg + 1u) * nx) xb_add(&bar[XB_TOPGEN], 1u);
            else XB_SPIN(xb_ld(&bar[XB_TOPGEN]) == tg, bar);
            __builtin_amdgcn_fence(__ATOMIC_ACQUIRE, "agent");
            xb_add(&bar[XB_XGEN(b.x)], 1u);
            asm volatile("s_waitcnt vmcnt(0)" ::: "memory");
        } else {
            XB_SPIN(xb_ld(&bar[XB_XGEN(b.x)]) == gen, bar);
            __builtin_amdgcn_fence(__ATOMIC_ACQUIRE, "agent");
            asm volatile("s_waitcnt vmcnt(0)" ::: "memory");
        }
    }
    __syncthreads();
}

#ifndef FFT_HOST
#define FFT_DEV __device__ __forceinline__
#define FFT_LDS LAS
#define FFT_SINCOS(rev, s, c) do { (s) = __builtin_amdgcn_sinf(rev); (c) = __builtin_amdgcn_cosf(rev); } while (0)
#else
#define FFT_DEV static inline
#define FFT_LDS
#define FFT_SINCOS(rev, s, c) do { (s) = sinf(6.283185307179586f * (rev)); (c) = cosf(6.283185307179586f * (rev)); } while (0)
#endif
namespace fftc {
typedef float cpx __attribute__((ext_vector_type(2)));
FFT_DEV cpx cadd(cpx a, cpx b) { return {a.x + b.x, a.y + b.y}; }
FFT_DEV cpx csub(cpx a, cpx b) { return {a.x - b.x, a.y - b.y}; }
FFT_DEV cpx cmul(cpx a, cpx b) { return {a.x * b.x - a.y * b.y, a.x * b.y + a.y * b.x}; }
FFT_DEV cpx cmulc(cpx a, cpx b) { return {a.x * b.x + a.y * b.y, a.y * b.x - a.x * b.y}; }
FFT_DEV cpx cconj(cpx a) { return {a.x, -a.y}; }
FFT_DEV cpx cis_neg(float rev) { float s, c; FFT_SINCOS(rev, s, c); return {c, -s}; }
FFT_DEV int fidx(int e) { return e + (e >> 4); }
FFT_DEV void r4f(cpx& a0, cpx& a1, cpx& a2, cpx& a3, cpx w) {
    const cpx t0 = cadd(a0, a2), t1 = csub(a0, a2), t2 = cadd(a1, a3), t3 = csub(a1, a3);
    const cpx y0 = cadd(t0, t2), y2 = csub(t0, t2), y1 = {t1.x + t3.y, t1.y - t3.x}, y3 = {t1.x - t3.y, t1.y + t3.x};
    const cpx w2 = cmul(w, w), w3 = cmul(w2, w);
    a0 = y0; a1 = cmul(y1, w); a2 = cmul(y2, w2); a3 = cmul(y3, w3);
}
FFT_DEV void r4i(cpx& a0, cpx& a1, cpx& a2, cpx& a3, cpx w) {
    const cpx w2 = cmul(w, w), w3 = cmul(w2, w);
    const cpx x1 = cmulc(a1, w), x2 = cmulc(a2, w2), x3 = cmulc(a3, w3);
    const cpx t0 = cadd(a0, x2), t1 = csub(a0, x2), t2 = cadd(x1, x3), t3 = csub(x1, x3);
    a0 = cadd(t0, t2); a2 = csub(t0, t2); a1 = {t1.x - t3.y, t1.y + t3.x}; a3 = {t1.x + t3.y, t1.y - t3.x};
}
#define FFT_W16_1 {0.92387953251128674f, -0.38268343236508977f}
#define FFT_W16_2 {0.70710678118654752f, -0.70710678118654752f}
#define FFT_W16_3 {0.38268343236508977f, -0.92387953251128674f}
template <int N, int TPF> struct Fft {
    static constexpr int LOG2N = (N == 16384) ? 14 : 12, ELEMS = N + N / 16;
    static_assert(N == 16384 || N == 4096, "sizes used here");
static FFT_DEV void pass_r4(FFT_LDS cpx* A, int tid, bool inv) {
#pragma unroll 2
    for (int it = 0; it < N / 4 / TPF; ++it) { const int r = tid + TPF * it;
        cpx a0 = A[fidx(r)], a1 = A[fidx(r + N / 4)], a2 = A[fidx(r + N / 2)], a3 = A[fidx(r + 3 * N / 4)];
        const cpx w = cis_neg((float)r * (1.0f / N));
        if (!inv) r4f(a0, a1, a2, a3, w); else r4i(a0, a1, a2, a3, w);
        A[fidx(r)] = a0; A[fidx(r + N / 4)] = a1; A[fidx(r + N / 2)] = a2; A[fidx(r + 3 * N / 4)] = a3; }
}
template <int NS> static FFT_DEV void pass_r16(FFT_LDS cpx* A, int tid, bool inv) {
    constexpr int QP = NS / 16;
    const cpx c1 = FFT_W16_1, c2 = FFT_W16_2, c3 = FFT_W16_3;
#pragma unroll
    for (int it = 0; it < N / 16 / TPF; ++it) { const int g = tid + TPF * it, blk = g / QP, rp = g % QP, base = blk * NS + rp;
        cpx v[16];
#pragma unroll
        for (int m = 0; m < 16; ++m) v[m] = A[fidx(base + QP * m)];
        const cpx w0 = cis_neg((float)rp * (1.0f / NS));
        const cpx w02 = cmul(w0, w0), wB = cmul(w02, w02);
        const cpx wA1 = cmul(w0, c1), wA2 = cmul(w0, c2), wA3 = cmul(w0, c3);
        if (!inv) {
            r4f(v[0], v[4], v[8], v[12], w0); r4f(v[1], v[5], v[9], v[13], wA1); r4f(v[2], v[6], v[10], v[14], wA2); r4f(v[3], v[7], v[11], v[15], wA3);
#pragma unroll
            for (int k1 = 0; k1 < 4; ++k1) r4f(v[4 * k1], v[4 * k1 + 1], v[4 * k1 + 2], v[4 * k1 + 3], wB);
        } else {
#pragma unroll
            for (int k1 = 0; k1 < 4; ++k1) r4i(v[4 * k1], v[4 * k1 + 1], v[4 * k1 + 2], v[4 * k1 + 3], wB);
            r4i(v[0], v[4], v[8], v[12], w0); r4i(v[1], v[5], v[9], v[13], wA1); r4i(v[2], v[6], v[10], v[14], wA2); r4i(v[3], v[7], v[11], v[15], wA3);
        }
#pragma unroll
        for (int m = 0; m < 16; ++m) A[fidx(base + QP * m)] = v[m]; }
}
static FFT_DEV int digitrev(int k) {
#ifndef FFT_HOST
    unsigned r = __builtin_bitreverse32((unsigned)k) >> (32 - LOG2N);
#else
    unsigned r = 0; for (int b = 0; b < LOG2N; ++b) if (k & (1 << b)) r |= 1u << (LOG2N - 1 - b);
#endif
    return (int)(((r & 0x5555u) << 1) | ((r >> 1) & 0x5555u));
}
static FFT_DEV void pair_of(int i, int& k, int& kp, int& p, int& pp) { p = 4 * (i >> 1) + (i & 1); k = digitrev(p); kp = (N - k) & (N - 1); pp = digitrev(kp); }
template <class ST> static FFT_DEV void spectrum_pair_store(cpx Zk, cpx Zkp, int k, int p, int pp, ST store) {
    if (k == 0) { store(p, cpx{Zk.x + Zk.y, 0.f}); store(N, cpx{Zk.x - Zk.y, 0.f}); return; }
    const cpx w = cis_neg((float)k * (0.5f / N));
    const cpx E = {0.5f * (Zk.x + Zkp.x), 0.5f * (Zk.y - Zkp.y)}, O = {0.5f * (Zk.y + Zkp.y), -0.5f * (Zk.x - Zkp.x)};
    const cpx wO = cmul(w, O);
    store(p, cadd(E, wO));
    if (pp != p) store(pp, csub(cconj(E), cconj(wO)));
}
template <class ST> static FFT_DEV void spectrum_store(const FFT_LDS cpx* A, int tid, ST store  ) {
    for (int i = tid; i < N / 2; i += TPF) { int k, kp, p, pp; pair_of(i, k, kp, p, pp); spectrum_pair_store(A[fidx(p)], A[fidx(pp)], k, p, pp, store); }
    if (tid == 0) { const int p = digitrev(N / 2); spectrum_pair_store(A[fidx(p)], A[fidx(p)], N / 2, p, p, store); }
}
template <class LD> static FFT_DEV void spectrum_pair_mul(FFT_LDS cpx* A, int k, int p, int pp, LD load) {
    const cpx Zk = A[fidx(p)], Zkp = A[fidx(pp)];
    if (k == 0) { const float X0 = Zk.x + Zk.y, XN = Zk.x - Zk.y, Y0 = X0 * load(p).x, YN = XN * load(N).x; A[fidx(p)] = cpx{0.5f * (Y0 + YN), 0.5f * (Y0 - YN)}; return; }
    const cpx w = cis_neg((float)k * (0.5f / N));
    const cpx E = {0.5f * (Zk.x + Zkp.x), 0.5f * (Zk.y - Zkp.y)}, O = {0.5f * (Zk.y + Zkp.y), -0.5f * (Zk.x - Zkp.x)};
    const cpx wO = cmul(w, O);
    const cpx Xk = cadd(E, wO), Xkp = csub(cconj(E), cconj(wO));
    const cpx Yk = cmul(Xk, load(p)), Ykp = cmul(Xkp, load(pp));
    const cpx Ye = {0.5f * (Yk.x + Ykp.x), 0.5f * (Yk.y - Ykp.y)};
    const cpx D = {0.5f * (Yk.x - Ykp.x), 0.5f * (Yk.y + Ykp.y)};
    const cpx Yo = cmulc(D, w);
    A[fidx(p)] = cpx{Ye.x - Yo.y, Ye.y + Yo.x};
    if (pp != p) { const cpx D2 = {-D.x, D.y};
        const cpx Yo2 = cmul(D2, cpx{-w.x, -w.y});
        A[fidx(pp)] = cpx{Ye.x - Yo2.y, -Ye.y + Yo2.x}; }
}
template <class LD> static FFT_DEV void spectrum_mul(FFT_LDS cpx* A, int tid, LD load  ) {
    for (int i = tid; i < N / 2; i += TPF) { int k, kp, p, pp; pair_of(i, k, kp, p, pp); spectrum_pair_mul(A, k, p, pp, load); }
    if (tid == 0) { const int p = digitrev(N / 2); spectrum_pair_mul(A, N / 2, p, p, load); }
}
};
#define FFT_FWD(FT, A, tid, SYNC) do { if (FT::LOG2N == 14) { FT::pass_r4(A, tid, false); SYNC; } FT::template pass_r16<4096>(A, tid, false); SYNC; FT::template pass_r16<256>(A, tid, false); SYNC; FT::template pass_r16<16>(A, tid, false); SYNC; } while (0)
#define FFT_INV(FT, A, tid, SYNC) do { FT::template pass_r16<16>(A, tid, true); SYNC; FT::template pass_r16<256>(A, tid, true); SYNC; FT::template pass_r16<4096>(A, tid, true); SYNC; if (FT::LOG2N == 14) { FT::pass_r4(A, tid, true); SYNC; } } while (0)
}

constexpr int NWAVES = 8;
constexpr int M = 24576, D = 2048, DFF = 5632, DEPTH = 4;
constexpr int NSEQ = 3;
__host__ __device__ __forceinline__ int seq_base(int s) { return s == 0 ? 0 : (s == 1 ? 16384 : 20480); }
__host__ __device__ __forceinline__ int seq_len(int s) { return s == 0 ? 16384 : 4096; }
constexpr int E_PROJ = 4352, O_PROJ = 18432;
constexpr float LN_EPS = 1e-5f;
constexpr float ALPHA = 1.6817928305074290861f;
constexpr int PH_PER_LAYER = 9, NPHASE = DEPTH * PH_PER_LAYER;

constexpr size_t MiB = 1u << 20;
constexpr size_t WS_CTL = 0, CTL_ZERO_BYTES = 1 * MiB;
constexpr size_t WS_COSE = 1 * MiB, WS_SINE = WS_COSE + 512 * 1024, WS_COSO = 2 * MiB, WS_SINO = 3 * MiB;
constexpr size_t WS_STAT = 4 * MiB;
constexpr size_t WS_LSE = 8 * MiB;
constexpr size_t WS_XB = 16 * MiB;
constexpr size_t WS_W = 112 * MiB;
constexpr size_t WS_BIG = 258 * MiB;
constexpr size_t WS_END = WS_BIG + 864 * MiB;
constexpr size_t W_IN = 0;
constexpr size_t W_OUT = 72 * MiB;
constexpr size_t W_GU = 80 * MiB;
constexpr size_t W_DN = 124 * MiB;
constexpr size_t B_KS0 = 420 * MiB, B_KS1 = 680 * MiB;
constexpr size_t B_Q = 0, B_K = 48 * MiB, B_V = 54 * MiB, B_HYT = 60 * MiB, B_TAP0 = 204 * MiB, B_TAP1 = 332 * MiB, B_ZT = 364 * MiB, B_PSUM = 412 * MiB;
constexpr int CW_BAR = 4096;

constexpr int RING_OFF = 0, RING_BYTES = 131072;
constexpr int LDSCTL_OFF = 139264, MISC_OFF = LDSCTL_OFF + 320;
constexpr int LDS_BYTES = 147456;

struct InTab { __device__ __forceinline__ const float* operator[](int i) const {
    const unsigned char __attribute__((address_space(4)))* k = (const unsigned char __attribute__((address_space(4)))*)__builtin_amdgcn_kernarg_segment_ptr();
    asm volatile("" : "+s"(k));
    return *(const float* const __attribute__((address_space(4)))*)(k + 8 * i); } };
struct Frame {
    LAS unsigned char* lds;
    volatile LAS unsigned* MISC;
    gu32* ctl;
    int tid, lane, wave;
    int G, bx;
    unsigned char* ws;
    float* X;
    InTab in;
};
__device__ __forceinline__ float bf2f(unsigned short b) { return __builtin_bit_cast(float, (unsigned)b << 16); }
__device__ __forceinline__ float wave_sum(float v) {
#pragma unroll
    for (int o = 1; o < 64; o <<= 1) v += __shfl_xor(v, o);
    return v;
}
__device__ __forceinline__ float wave_max(float v) {
#pragma unroll
    for (int o = 1; o < 64; o <<= 1) v = fmaxf(v, __shfl_xor(v, o));
    return v;
}


__device__ __forceinline__ void sincos_d(double x, double& sn, double& cs) {
    const double k = __builtin_rint(x * 0.63661977236758134308);
    double r = __builtin_fma(-k, 1.57079632679489655800, x); r = __builtin_fma(-k, 6.12323399573676603587e-17, r);
    const double r2 = r * r;
    double sp = -7.6471637318198164759e-13; sp = sp * r2 + 1.6059043836821614599e-10; sp = sp * r2 - 2.5052108385441718775e-08; sp = sp * r2 + 2.7557319223985890653e-06;
    sp = sp * r2 - 1.9841269841269841270e-04; sp = sp * r2 + 8.3333333333333333333e-03; sp = sp * r2 - 1.6666666666666666667e-01; const double s = r + r * r2 * sp;
    double cp = 4.7794773323873852974e-14; cp = cp * r2 - 1.1470745597729724714e-11; cp = cp * r2 + 2.0876756987868098979e-09; cp = cp * r2 - 2.7557319223985890653e-07;
    cp = cp * r2 + 2.4801587301587301587e-05; cp = cp * r2 - 1.3888888888888888889e-03; cp = cp * r2 + 4.1666666666666666667e-02; cp = cp * r2 - 0.5; const double c = 1.0 + r2 * cp;
    const int q = ((int)k) & 3;
    sn = (q == 0) ? s : (q == 1) ? c : (q == 2) ? -s : -c;
    cs = (q == 0) ? c : (q == 1) ? -s : (q == 2) ? -c : s;
}
__device__ __forceinline__ void sincos_f(float x, float& sn, float& cs) {
    const float k = __builtin_rintf(x * 0.636619772367581343f);
    float r = __builtin_fmaf(-k, 1.5703125f, x); r = __builtin_fmaf(-k, 4.837512969970703125e-4f, r); r = __builtin_fmaf(-k, 7.54978995489188216e-8f, r);
    const float r2 = r * r;
    float sp = 2.7557319224e-06f; sp = sp * r2 - 1.9841269841e-04f; sp = sp * r2 + 8.3333333333e-03f; sp = sp * r2 - 1.6666666667e-01f; const float s = r + r * r2 * sp;
    float cp = -2.7557319224e-07f; cp = cp * r2 + 2.4801587302e-05f; cp = cp * r2 - 1.3888888889e-03f; cp = cp * r2 + 4.1666666667e-02f; cp = cp * r2 - 0.5f; const float c = 1.0f + r2 * cp;
    const int q = ((int)k) & 3;
    sn = (q == 0) ? s : (q == 1) ? c : (q == 2) ? -s : -c;
    cs = (q == 0) ? c : (q == 1) ? -s : (q == 2) ? -c : s;
}
__device__ __forceinline__ float sin_f(float x) { float s, c; sincos_f(x, s, c); return s; }

__device__ __forceinline__ void transpose_item(const float* W, int K, int ldn, int c0, bf16* WT, int r0, LAS float* scr, int kb, int nb, int lane) {
    const int k0 = 64 * kb, n0 = 32 * nb;
    float wv[32];
    const float* wp = W + (size_t)(k0 + (lane >> 5)) * ldn + c0 + n0 + (lane & 31);
#pragma unroll
    for (int i = 0; i < 32; ++i) wv[i] = __builtin_nontemporal_load(wp + (size_t)(2 * i) * ldn);
#pragma unroll
    for (int i = 0; i < 32; ++i) { const int kk = 2 * i + (lane >> 5); scr[kk * 33 + (lane & 31)] = wv[i]; }
    LDS_WAIT(); asm volatile("" ::: "memory");
    const int c = lane & 7;
#pragma unroll
    for (int j = 0; j < 4; ++j) { const int n = (lane >> 3) + 8 * j; const LAS float* s = scr + (8 * c) * 33 + n;
        v4u o; o.x = pk2(s[0 * 33], s[1 * 33]); o.y = pk2(s[2 * 33], s[3 * 33]); o.z = pk2(s[4 * 33], s[5 * 33]); o.w = pk2(s[6 * 33], s[7 * 33]);
        *(GAS v4u*)(WT + (size_t)(r0 + n0 + n) * K + k0 + 8 * c) = o; }
    LDS_WAIT(); asm volatile("" ::: "memory");
}
__device__ __forceinline__ void convert_segment(Frame& F, const float* W, int K, int ldn, int c0, int cnt, bf16* WT, int r0) {
    LAS float* scr = (LAS float*)(F.lds + RING_OFF + F.wave * 16384);
    const int gw = F.bx * NWAVES + F.wave, NGW = F.G * NWAVES;
    const int nnb = cnt / 32, nit = (K / 64) * nnb;
    for (int it = gw; it < nit; it += NGW) transpose_item(W, K, ldn, c0, WT, r0, scr, it / nnb, it % nnb, F.lane);
}

__device__ __forceinline__ void p_input(Frame& F) {
    const float* xp = F.in[0]; const float* xs = F.in[1];
    bf16* XB = (bf16*)(F.ws + WS_XB);
    const size_t n4 = (size_t)M * D / 4, np4 = (size_t)16384 * D / 4;
    for (size_t i = (size_t)F.bx * 512 + F.tid; i < n4; i += (size_t)F.G * 512) {
        const f32x4 v = i < np4 ? ((const f32x4*)xp)[i] : ((const f32x4*)xs)[i - np4];
        ((f32x4*)F.X)[i] = v;
        unsigned long long w = (unsigned long long)pk2(v[0], v[1]) | ((unsigned long long)pk2(v[2], v[3]) << 32);
        ((unsigned long long*)XB)[i] = w;
    }
    float* cE = (float*)(F.ws + WS_COSE); float* sE = (float*)(F.ws + WS_SINE); float* cO = (float*)(F.ws + WS_COSO); float* sO = (float*)(F.ws + WS_SINO);
    for (int i = F.bx * 512 + F.tid; i < 16384 * 24; i += F.G * 512) {
        const int pos = i / 24, f = i % 24;
        const float inv16[16] = {1.f, 0.440366596f, 0.193922743f, 0.0853971019f, 0.0376060307f, 0.016560439f, 0.00729266461f, 0.00321144587f, 0.00141421356f, 0.000622772379f, 0.000274248188f, 0.000120769735f, 5.3182961e-05f, 2.34199997e-05f, 1.03133862e-05f, 4.54167048e-06f};
        const int ff = f < 8 ? 2 * f : f - 8;
        float inv = 1.f;
#pragma unroll
        for (int q = 0; q < 16; ++q) inv = (ff == q) ? inv16[q] : inv;
        const float ang = (float)pos * inv; double sn, cs; sincos_d((double)ang, sn, cs);
        if (f < 8) { cE[pos * 8 + f] = (float)cs; sE[pos * 8 + f] = (float)sn; } else { cO[pos * 16 + (f - 8)] = (float)cs; sO[pos * 16 + (f - 8)] = (float)sn; }
    }
}

__device__ __forceinline__ void p_convert_weights(Frame& F, int layer) {
    const int j = layer >> 1; const bool even = !(layer & 1);
    bf16* Wb = (bf16*)(F.ws + WS_W);
    if (even) {
        const float* w_in = F.in[2] + (size_t)j * D * E_PROJ;
        convert_segment(F, w_in, D, E_PROJ, 0, 1280, (bf16*)((unsigned char*)Wb + W_IN), 0);
        convert_segment(F, w_in, D, E_PROJ, 1280, 3072, (bf16*)((unsigned char*)Wb + W_IN) + (size_t)1280 * D, 0);
        convert_segment(F, F.in[15] + (size_t)j * D * D, D, D, 0, D, (bf16*)((unsigned char*)Wb + W_OUT), 0);
    } else {
        convert_segment(F, F.in[16] + (size_t)j * D * O_PROJ, D, O_PROJ, 0, O_PROJ, (bf16*)((unsigned char*)Wb + W_IN), 0);
        convert_segment(F, F.in[17] + (size_t)j * D * D, D, D, 0, D, (bf16*)((unsigned char*)Wb + W_OUT), 0);
    }
    const float* wg = F.in[18] + (size_t)layer * D * DFF; const float* wu = F.in[19] + (size_t)layer * D * DFF;
    bf16* WGU = (bf16*)((unsigned char*)Wb + W_GU);
    {   LAS float* scr = (LAS float*)(F.lds + RING_OFF + F.wave * 16384);
        const int gw = F.bx * NWAVES + F.wave, NGW = F.G * NWAVES;
        const int nit = (D / 64) * (2 * DFF / 32);
        for (int it = gw; it < nit; it += NGW) { const int kb = it / 352, nb = it % 352;
            const int pn = nb >> 3, half = (nb >> 2) & 1, sub = nb & 3;
            transpose_item(half ? wu : wg, D, DFF, 128 * pn + 32 * sub, WGU, 32 * nb, scr, kb, 0, F.lane); }
    }
    convert_segment(F, F.in[20] + (size_t)layer * DFF * D, DFF, D, 0, D, (bf16*)((unsigned char*)Wb + W_DN), 0);
}

__device__ __forceinline__ void taps_tile(Frame& F, int j, int cls, int tile) {
    const int L = cls ? 4096 : 16384; const int i0 = tile * 64;
    LAS float* zf = (LAS float*)(F.lds + RING_OFF);
    LAS float* h1 = zf + 64 * 33;
    LAS float* h2 = h1 + 64 * 65;
    const float* w1 = F.in[6] + (size_t)j * 33 * 64; const float* b1 = F.in[7] + j * 64; const float* f1 = F.in[8] + j * 64;
    const float* w2 = F.in[9] + (size_t)j * 64 * 64; const float* b2 = F.in[10] + j * 64; const float* f2 = F.in[11] + j * 64;
    const float* w3 = F.in[12] + (size_t)j * 64 * 4096; const float* b3 = F.in[13] + (size_t)j * 4096;
    for (int idx = F.tid; idx < 64 * 33; idx += 512) { const int p = idx / 33, f = idx % 33, i = i0 + p; float val;
        if (f == 0) val = (float)i / (float)(L - 1);
        else { const int mm = (f - 1) & 15; const float band = 1e-4f + (float)mm * ((15.0f - 1e-4f) / 15.0f); const float w = 6.283185307179586f * (float)i / (float)L;
            float sn, cs; sincos_f(band * w, sn, cs); val = f <= 16 ? cs : -sn; }
        zf[p * 33 + f] = val; }
    __syncthreads();
    for (int idx = F.tid; idx < 64 * 64; idx += 512) { const int p = idx >> 6, k = idx & 63; float a = b1[k];
        for (int f = 0; f < 33; ++f) a += zf[p * 33 + f] * w1[f * 64 + k];
        h1[p * 65 + k] = sin_f(f1[k] * a); }
    __syncthreads();
    for (int idx = F.tid; idx < 64 * 64; idx += 512) { const int p = idx >> 6, k = idx & 63; float a = b2[k];
        for (int f = 0; f < 64; ++f) a += h1[p * 65 + f] * w2[f * 64 + k];
        h2[p * 65 + k] = sin_f(f2[k] * a); }
    __syncthreads();
    const int i = i0 + F.lane; const float ti = (float)i / (float)(L - 1);
    bf16* TAPS = (bf16*)(F.ws + WS_BIG + (cls ? B_TAP1 : B_TAP0));
    float* PS = (float*)(F.ws + WS_BIG + B_PSUM) + (cls ? (size_t)256 * 4096 : 0) + (size_t)tile * 4096;
    const float dmin = -3.0701134573253943f  , dmax = -15.350567286626973f  ;
    const LAS float* hrow = h2 + F.lane * 65;
#pragma unroll 1
    for (int cb = 0; cb < 512; cb += 4) { const int col = F.wave * 512 + cb;
        asm volatile("" ::: "memory");
        f32x4 a = *(const f32x4*)(b3 + col);
#pragma unroll 8
        for (int k = 0; k < 64; ++k) { const f32x4 wv = *(const f32x4*)(w3 + (size_t)k * 4096 + col); const float hk = hrow[k]; a += wv * hk; }
        const int dir = col >> 11, o = (col >> 10) & 1, ch0 = col & 1023;
#pragma unroll
        for (int e = 0; e < 4; ++e) { const int ch = ch0 + e; const float delta = fabsf(dmin + (dmax - dmin) * ((float)ch / 1023.0f));
            float val = a[e] * __expf(-ti * delta);
            bf16* tp = TAPS + ((size_t)(o * 1024 + ch)) * (2 * L);
            if (dir == 0) tp[L - i] = (bf16)f2bf(val);
            else { if (i >= 1) tp[L + i] = (bf16)f2bf(val); else { tp[0] = 0; val = 0.f; } }
            const float s = wave_sum(fabsf(val));
            if (F.lane == 0) PS[col + e] = s; }
    }
    __syncthreads();
}

__device__ __forceinline__ void p_layernorm(Frame& F, const float* gam, const float* bet, bool final) {
    bf16* XB = (bf16*)(F.ws + WS_XB); float* STAT = (float*)(F.ws + WS_STAT);
    const int gw = F.bx * NWAVES + F.wave, NGW = F.G * NWAVES;
    f32x4 gv[8], bv[8];
#pragma unroll
    for (int q = 0; q < 8; ++q) { gv[q] = ((const f32x4*)gam)[F.lane + 64 * q]; bv[q] = ((const f32x4*)bet)[F.lane + 64 * q]; }
    for (int m = gw; m < M; m += NGW) {
        f32x4* xr = (f32x4*)(F.X + (size_t)m * D) + F.lane;
        f32x4 v[8]; float s = 0.f;
#pragma unroll
        for (int q = 0; q < 8; ++q) { v[q] = xr[64 * q]; s += (v[q][0] + v[q][1]) + (v[q][2] + v[q][3]); }
        const float mean = wave_sum(s) * (1.f / D); float s2 = 0.f;
#pragma unroll
        for (int q = 0; q < 8; ++q) { v[q] = v[q] - mean; s2 += (v[q][0] * v[q][0] + v[q][1] * v[q][1]) + (v[q][2] * v[q][2] + v[q][3] * v[q][3]); }
        const float rstd = 1.f / sqrtf(wave_sum(s2) * (1.f / D) + LN_EPS);
        unsigned long long* o8 = (unsigned long long*)(XB + (size_t)m * D) + F.lane;
        if (!final && F.lane == 0) { STAT[2 * (size_t)m] = mean; STAT[2 * (size_t)m + 1] = rstd; }
#pragma unroll
        for (int q = 0; q < 8; ++q) { const f32x4 y = v[q] * rstd * gv[q] + bv[q];
            if (final) xr[64 * q] = y;
            else o8[64 * q] = (unsigned long long)pk2(y[0], y[1]) | ((unsigned long long)pk2(y[2], y[3]) << 32); }
    }
}

__device__ __forceinline__ void p_attn_even_naive(Frame& F, int j) {
    const bf16* Q = (const bf16*)(F.ws + WS_BIG + B_Q); const bf16* Kb = (const bf16*)(F.ws + WS_BIG + B_K); const bf16* Vb = (const bf16*)(F.ws + WS_BIG + B_V);
    bf16* AO = (bf16*)(F.ws + WS_XB);
    const float* sink = F.in[3] + j * 16;
    const int gw = F.bx * NWAVES + F.wave, NGW = F.G * NWAVES;
    for (int it = gw; it < M * 16; it += NGW) {
        const int tok = it >> 4, h = it & 15, kvh = h >> 3;
        const int sb = pg8::seq_base_of_row(tok), L = sb == 0 ? 16384 : 4096, pos = tok - sb;
        float sc[5]; bool ok[5];
#pragma unroll
        for (int c = 0; c < 5; ++c) sc[c] = 0.f;
        int kr[5];
#pragma unroll
        for (int c = 0; c < 5; ++c) { const int kp = pos - 128 + F.lane + 64 * c; ok[c] = (kp <= pos + 128) && kp >= 0 && kp < L; kr[c] = ok[c] ? sb + kp : tok; }
        for (int t = 0; t < 8; ++t) {
            const v4u qv = *(const v4u*)(Q + (size_t)tok * 1024 + h * 64 + 8 * t);
            float qf[8];
#pragma unroll
            for (int e = 0; e < 4; ++e) { qf[2 * e] = bf2f((unsigned short)(qv[e] & 0xffff)); qf[2 * e + 1] = bf2f((unsigned short)(qv[e] >> 16)); }
#pragma unroll
            for (int c = 0; c < 5; ++c) { const v4u kv = *(const v4u*)(Kb + (size_t)kr[c] * 128 + kvh * 64 + 8 * t);
#pragma unroll
                for (int e = 0; e < 4; ++e) sc[c] += qf[2 * e] * bf2f((unsigned short)(kv[e] & 0xffff)) + qf[2 * e + 1] * bf2f((unsigned short)(kv[e] >> 16)); }
        }
        const float sk = sink[h];
        float mx = sk;
#pragma unroll
        for (int c = 0; c < 5; ++c) { sc[c] = ok[c] ? sc[c] * 0.125f : -INFINITY; mx = fmaxf(mx, sc[c]); }
        mx = wave_max(mx);
        float p[5]; float ps = 0.f;
#pragma unroll
        for (int c = 0; c < 5; ++c) { p[c] = ok[c] ? __expf(sc[c] - mx) : 0.f; ps += p[c]; }
        const float den = wave_sum(ps) + __expf(sk - mx);
        float o = 0.f;
#pragma unroll
        for (int c = 0; c < 5; ++c)
            for (int l = 0; l < 64; ++l) { const float pl = __shfl(p[c], l); const int kp = pos - 128 + l + 64 * c;
                if (pl != 0.f) o += pl * bf2f(Vb[(size_t)(sb + kp) * 128 + kvh * 64 + F.lane]); }
        AO[(size_t)tok * D + h * 64 + F.lane] = (bf16)f2bf(o / den);
    }
}

__device__ __forceinline__ void p_attn_odd_naive(Frame& F) {
    bf16* QKV = (bf16*)(F.ws + WS_BIG); float* LSE = (float*)(F.ws + WS_LSE);
    const int gw = F.bx * NWAVES + F.wave, NGW = F.G * NWAVES;
    for (int it = gw; it < 3 * 16 * M; it += NGW) {
        const int prow = it % M, gh = it / M, g = gh >> 4, h = gh & 15;
        const int sb = pg8::seq_base_of_row(prow), L = sb == 0 ? 16384 : 4096, ls = L >> (2 * g);
        const int pp = prow - sb, rho = pp / ls, idx = pp - rho * ls;
        bf16* Qg = QKV + ((size_t)((0 * 3 + g) * 16 + h) * M) * 128; const bf16* Kg = QKV + ((size_t)((1 * 3 + g) * 16 + h) * M) * 128; const bf16* Vg = QKV + ((size_t)((2 * 3 + g) * 16 + h) * M) * 128;
        float sc[3]; bool ok[3]; int kr[3];
#pragma unroll
        for (int c = 0; c < 3; ++c) { const int ki = idx - 64 + F.lane + 64 * c; ok[c] = (ki <= idx + 64) && ki >= 0 && ki < ls; kr[c] = ok[c] ? sb + rho * ls + ki : prow; sc[c] = 0.f; }
        for (int t = 0; t < 16; ++t) {
            const v4u qv = *(const v4u*)(Qg + (size_t)prow * 128 + 8 * t);
            float qf[8];
#pragma unroll
            for (int e = 0; e < 4; ++e) { qf[2 * e] = bf2f((unsigned short)(qv[e] & 0xffff)); qf[2 * e + 1] = bf2f((unsigned short)(qv[e] >> 16)); }
#pragma unroll
            for (int c = 0; c < 3; ++c) { const v4u kv = *(const v4u*)(Kg + (size_t)kr[c] * 128 + 8 * t);
#pragma unroll
                for (int e = 0; e < 4; ++e) sc[c] += qf[2 * e] * bf2f((unsigned short)(kv[e] & 0xffff)) + qf[2 * e + 1] * bf2f((unsigned short)(kv[e] >> 16)); }
        }
        float mx = -INFINITY;
#pragma unroll
        for (int c = 0; c < 3; ++c) { sc[c] = ok[c] ? sc[c] * 0.08838834764831845f : -INFINITY; mx = fmaxf(mx, sc[c]); }
        mx = wave_max(mx);
        float p[3]; float ps = 0.f;
#pragma unroll
        for (int c = 0; c < 3; ++c) { p[c] = ok[c] ? __expf(sc[c] - mx) : 0.f; ps += p[c]; }
        const float den = wave_sum(ps);
        float o0 = 0.f, o1 = 0.f;
#pragma unroll
        for (int c = 0; c < 3; ++c)
            for (int l = 0; l < 64; ++l) { const float pl = __shfl(p[c], l); const int ki = idx - 64 + l + 64 * c;
                if (pl != 0.f) { const unsigned vv = *(const unsigned*)(Vg + (size_t)(sb + rho * ls + ki) * 128 + 2 * F.lane); o0 += pl * bf2f((unsigned short)(vv & 0xffff)); o1 += pl * bf2f((unsigned short)(vv >> 16)); } }
        const float inv = 1.f / den;
        *(unsigned*)(Qg + (size_t)prow * 128 + 2 * F.lane) = pk2(o0 * inv, o1 * inv);
        if (F.lane == 0) LSE[((size_t)g * M + prow) * 16 + h] = mx + __logf(den);
    }
}

__device__ __forceinline__ void p_combine_odd(Frame& F) {
    const bf16* QKV = (const bf16*)(F.ws + WS_BIG); const float* LSE = (const float*)(F.ws + WS_LSE); bf16* AO = (bf16*)(F.ws + WS_XB);
#pragma unroll 4
    for (int it = F.bx * 512 + F.tid; it < M * 256; it += F.G * 512) {
        const int tok = it >> 8, h = (it >> 4) & 15, ck = it & 15;
        const int sb = pg8::seq_base_of_row(tok), L = sb == 0 ? 16384 : 4096, pos = tok - sb;
        float l[3]; int pr[3];
#pragma unroll
        for (int g = 0; g < 3; ++g) { const int dsh = 2 * g; pr[g] = sb + (pos & ((1 << dsh) - 1)) * (L >> dsh) + (pos >> dsh); l[g] = LSE[((size_t)g * M + pr[g]) * 16 + h]; }
        const float mx = fmaxf(l[0], fmaxf(l[1], l[2]));
        float w[3]; float ws = 0.f;
#pragma unroll
        for (int g = 0; g < 3; ++g) { w[g] = __expf(l[g] - mx); ws += w[g]; }
        const float inv = 1.f / ws;
        float acc[8];
#pragma unroll
        for (int e = 0; e < 8; ++e) acc[e] = 0.f;
#pragma unroll
        for (int g = 0; g < 3; ++g) { const v4u ov = *(const v4u*)(QKV + ((size_t)(g * 16 + h) * M + pr[g]) * 128 + 8 * ck); const float wg = w[g] * inv;
#pragma unroll
            for (int e = 0; e < 4; ++e) { acc[2 * e] += wg * bf2f((unsigned short)(ov[e] & 0xffff)); acc[2 * e + 1] += wg * bf2f((unsigned short)(ov[e] >> 16)); } }
        v4u o; o.x = pk2(acc[0], acc[1]); o.y = pk2(acc[2], acc[3]); o.z = pk2(acc[4], acc[5]); o.w = pk2(acc[6], acc[7]);
        *(v4u*)(AO + (size_t)tok * D + h * 128 + 8 * ck) = o;
    }
}

template <int L> __device__ __forceinline__ void hyena_unit_naive(Frame& F, int j, int s, int ch) {
    constexpr int NQ = L / 512, cls = (L == 4096) ? 1 : 0, NT = L / 64;
    const int sb = seq_base(s);
    LAS bf16* tp = (LAS bf16*)(F.lds + RING_OFF); LAS bf16* vb = tp + 2 * L; LAS bf16* zb = vb + L;
    LAS float* red = (LAS float*)(F.lds + LDSCTL_OFF + 64);
    const bf16* HYT = (const bf16*)(F.ws + WS_BIG + B_HYT); bf16* ZT = (bf16*)(F.ws + WS_BIG + B_ZT);
    const bf16* TAPS = (const bf16*)(F.ws + WS_BIG + (cls ? B_TAP1 : B_TAP0));
    const float* PS = (const float*)(F.ws + WS_BIG + B_PSUM) + (cls ? (size_t)256 * 4096 : 0);
    const float* cw = F.in[4] + (size_t)j * 3 * 3072; const float* cb = F.in[5] + (size_t)j * 3072; const float* hb = F.in[14] + (size_t)j * 2 * 1024;
    if (F.wave < 2) { const int o = F.wave; float a = 0.f;
        for (int t = F.lane; t < NT; t += 64) a += PS[(size_t)t * 4096 + (0 * 2 + o) * 1024 + ch] + PS[(size_t)t * 4096 + (1 * 2 + o) * 1024 + ch];
        a = wave_sum(a); if (F.lane == 0) red[o] = a; }
    { const bf16* hr = HYT + (size_t)ch * M + sb; const float w0 = cw[0 * 3072 + ch], w1 = cw[1 * 3072 + ch], w2 = cw[2 * 3072 + ch], b = cb[ch];
      for (int i = F.tid; i < L; i += 512) { const float xm = i > 0 ? bf2f(hr[i - 1]) : 0.f, x0 = bf2f(hr[i]), xp = i < L - 1 ? bf2f(hr[i + 1]) : 0.f; vb[i] = (bf16)f2bf(b + w0 * xm + w1 * x0 + w2 * xp); } }
    __syncthreads();
#pragma unroll 1
    for (int o = 0; o < 2; ++o) {
        const bf16* tg = TAPS + (size_t)(o * 1024 + ch) * (2 * L);
        for (int i = F.tid; i < 2 * L / 8; i += 512) ((LAS v4u*)tp)[i] = ((const v4u*)tg)[i];
        __syncthreads();
        const LAS bf16* src = o == 0 ? vb : zb;
        float acc[NQ];
#pragma unroll
        for (int q = 0; q < NQ; ++q) acc[q] = 0.f;
        for (int jj = 0; jj < L; ++jj) { const float uj = bf2f(src[jj]); const LAS bf16* tq = tp + (L - F.tid + jj);
#pragma unroll
            for (int q = 0; q < NQ; ++q) acc[q] += bf2f(tq[-512 * q]) * uj; }
        const float invS = 1.f / red[o]; const float bias = hb[o * 1024 + ch];
        const int gch = (o == 0 ? 1024 : 2048) + ch;
        const bf16* hr = HYT + (size_t)gch * M + sb; const float w0 = cw[0 * 3072 + gch], w1 = cw[1 * 3072 + gch], w2 = cw[2 * 3072 + gch], b = cb[gch];
#pragma unroll
        for (int q = 0; q < NQ; ++q) { const int i = 512 * q + F.tid;
            const float xm = i > 0 ? bf2f(hr[i - 1]) : 0.f, x0 = bf2f(hr[i]), xp = i < L - 1 ? bf2f(hr[i + 1]) : 0.f; const float xg = b + w0 * xm + w1 * x0 + w2 * xp;
            const float y = acc[q] * invS + bias * bf2f(src[i]); const float z = xg * y;
            if (o == 0) zb[i] = (bf16)f2bf(z); else ZT[(size_t)ch * M + sb + i] = (bf16)f2bf(z); }
        __syncthreads();
    }
}


template <int L, int NCH> __device__ __forceinline__ void warm_taps(Frame& F, const bf16* taps0, int ch0, LAS float* sink) {
    constexpr int NLD = (NCH * 2 * L * 2 / 128) / 512 > 0 ? (NCH * 2 * L * 2 / 128) / 512 : 1;
    unsigned acc = 0u;
#pragma unroll
    for (int it = 0; it < NLD; ++it) { const int ln = F.tid + 512 * it; if (ln < NCH * 2 * L * 2 / 128) { const int cc = ln / (2 * L * 2 / 128), l2 = ln % (2 * L * 2 / 128);
        acc ^= *(const unsigned*)((const unsigned char*)(taps0 + (size_t)(ch0 + cc) * (2 * L)) + (size_t)l2 * 128); } }
    if (acc == 0x7fc12345u) sink[0] = 1.f;
}

typedef float f32x16 __attribute__((ext_vector_type(16)));
typedef short s16x4 __attribute__((ext_vector_type(4)));
typedef unsigned u32x4_t __attribute__((ext_vector_type(4)));
template <int L, int TPW> __device__ __forceinline__ void hyena_unit_mfma(Frame& F, int j, int s, int ch0) {
    constexpr int NB = L / 32, NT = NB / 32, WPC = NT / TPW, NCH = NWAVES / WPC, cls = (L == 4096) ? 1 : 0, NTL = L / 64;
    constexpr int UBYTES = (NB + 64) * 80, TSTG = TPW * 2304;
    static_assert(NCH * UBYTES + NWAVES * TSTG <= RING_BYTES, "hyena LDS");
    const int sb = seq_base(s);
    const int w = F.wave, cidx = w / WPC, wl = w % WPC, lane = F.lane, i0 = lane & 31, h = lane >> 5;
    const int ch = ch0 + cidx;
    LAS unsigned char* Ub = F.lds + RING_OFF + cidx * UBYTES;
    LAS unsigned char* Tb = F.lds + RING_OFF + NCH * UBYTES + w * TSTG;
    LAS float* red = (LAS float*)(F.lds + LDSCTL_OFF + 64);
    const bf16* HYT = (const bf16*)(F.ws + WS_BIG + B_HYT); bf16* ZT = (bf16*)(F.ws + WS_BIG + B_ZT);
    const bf16* TAPS = (const bf16*)(F.ws + WS_BIG + (cls ? B_TAP1 : B_TAP0));
    const float* PS = (const float*)(F.ws + WS_BIG + B_PSUM) + (cls ? (size_t)256 * 4096 : 0);
    const float* cw = F.in[4] + (size_t)j * 3 * 3072; const float* cb = F.in[5] + (size_t)j * 3072; const float* hb = F.in[14] + (size_t)j * 2 * 1024;
    if (w < 2 * NCH) { const int cc = w >> 1, o = w & 1, chh = ch0 + cc; float a = 0.f;
        for (int t = lane; t < NTL; t += 64) a += PS[(size_t)t * 4096 + (0 * 2 + o) * 1024 + chh] + PS[(size_t)t * 4096 + (1 * 2 + o) * 1024 + chh];
        a = wave_sum(a); if (lane == 0) red[w] = a; }
    warm_taps<L, NCH>(F, TAPS, ch0, red + 8);
    constexpr int GOFF = NCH * UBYTES + NWAVES * TSTG;
    static_assert(GOFF + NCH * L * 2 <= RING_BYTES, "hyena LDS (gate rows)");
    constexpr int NU = (NCH * L / 8) / 512;
    {   v4u raw[NU], gr[NU]; unsigned short xm[NU], xp[NU];
#pragma unroll
        for (int it = 0; it < NU; ++it) { const int idx = F.tid + 512 * it, cc = idx / (L / 8), p8 = 8 * (idx % (L / 8)); const bf16* hr = HYT + (size_t)(ch0 + cc) * M + sb;
            raw[it] = *(const v4u*)(hr + p8); xm[it] = p8 > 0 ? hr[p8 - 1] : (unsigned short)0; xp[it] = p8 + 8 < L ? hr[p8 + 8] : (unsigned short)0;
            gr[it] = *(const v4u*)(HYT + (size_t)(1024 + ch0 + cc) * M + sb + p8); }
        for (int z = F.tid; z < NCH * 320; z += 512) { const int cc = z / 320, zz = z % 320, blk = zz < 160 ? zz / 5 : NB + 32 + (zz - 160) / 5, part = zz % 5;
            *(LAS v4u*)(F.lds + RING_OFF + cc * UBYTES + blk * 80 + part * 16) = (v4u){0u, 0u, 0u, 0u}; }
#pragma unroll
        for (int it = 0; it < NU; ++it) { const int idx = F.tid + 512 * it, cc = idx / (L / 8), p8 = 8 * (idx % (L / 8)); const int chh = ch0 + cc;
            const float w0 = cw[0 * 3072 + chh], w1 = cw[1 * 3072 + chh], w2 = cw[2 * 3072 + chh], b = cb[chh];
            float x[10]; x[0] = bf2f(xm[it]); x[9] = bf2f(xp[it]);
#pragma unroll
            for (int q = 0; q < 4; ++q) { x[1 + 2 * q] = bf2f((unsigned short)(raw[it][q] & 0xffff)); x[2 + 2 * q] = bf2f((unsigned short)(raw[it][q] >> 16)); }
            v4u o;
#pragma unroll
            for (int q = 0; q < 4; ++q) o[q] = pk2(b + w0 * x[2 * q] + w1 * x[2 * q + 1] + w2 * x[2 * q + 2], b + w0 * x[2 * q + 1] + w1 * x[2 * q + 2] + w2 * x[2 * q + 3]);
            *(LAS v4u*)(F.lds + RING_OFF + cc * UBYTES + ((p8 >> 5) + 32) * 80 + (p8 & 31) * 2) = o;
            *(LAS v4u*)(F.lds + RING_OFF + GOFF + cc * (L * 2) + p8 * 2) = gr[it]; }
    }
    __syncthreads();
    const int c4 = i0 & 3;
    int o8 = 8, o32 = 32, o40 = 40; asm volatile("" : "+v"(o8), "+v"(o32), "+v"(o40));
    const int abase = c4 * 576 + 16 * h - 2 * (i0 & ~3);
    const int bbase = (i0 + 32) * 80 + 16 * h;
    unsigned zpk[TPW][4][2];
#pragma unroll 1
    for (int o = 0; o < 2; ++o) {
        f32x16 acc[TPW];
        const bf16* TRg = TAPS + (size_t)(o * 1024 + ch) * (2 * L);
#pragma unroll 1
        for (int rp = 0; rp < (MK_PROBE_REP == 40 ? 2 : 1); ++rp) {
#pragma unroll
        for (int t = 0; t < TPW; ++t)
#pragma unroll
            for (int r = 0; r < 16; ++r) acc[t][r] = 0.f;
        v4u Xr[TPW], Pr[TPW];
#pragma unroll
        for (int t = 0; t < TPW; ++t) { const int n0 = 32 * (wl * TPW + t), wbase = L - 32 * (n0 - NB + 8);
            int xi = wbase + 8 * lane, pi = xi - 8; xi = xi < 0 ? 0 : (xi > 2 * L - 8 ? 2 * L - 8 : xi); pi = pi < 0 ? 0 : (pi > 2 * L - 8 ? 2 * L - 8 : pi);
            if (lane < 36) { Xr[t] = *(const v4u*)(TRg + xi); Pr[t] = *(const v4u*)(TRg + pi); } }
#pragma unroll 1
        for (int e0 = -NB; e0 < 32; e0 += 8) {
#pragma unroll
            for (int t = 0; t < TPW; ++t) {
                if (lane < 36) { const v4u X = Xr[t], P = Pr[t];
                    const unsigned a0 = __builtin_amdgcn_alignbit(X.x, P.w, 16), a1 = __builtin_amdgcn_alignbit(X.y, X.x, 16), a2 = __builtin_amdgcn_alignbit(X.z, X.y, 16), a3 = __builtin_amdgcn_alignbit(X.w, X.z, 16), a4 = __builtin_amdgcn_alignbit(P.w, P.z, 16);
                    LAS unsigned char* dst = Tb + t * 2304 + 16 * lane;
                    *(LAS v4u*)(dst) = X;
                    *(LAS v4u*)(dst + 576) = (v4u){a0, a1, a2, a3};
                    *(LAS v4u*)(dst + 1152) = (v4u){P.w, X.x, X.y, X.z};
                    *(LAS v4u*)(dst + 1728) = (v4u){a4, a0, a1, a2}; } }
            if (e0 + 8 < 32) {
#pragma unroll
                for (int t = 0; t < TPW; ++t) { const int n0 = 32 * (wl * TPW + t), wbase = L - 32 * (n0 + e0 + 16);
                    int xi = wbase + 8 * lane, pi = xi - 8; xi = xi < 0 ? 0 : (xi > 2 * L - 8 ? 2 * L - 8 : xi); pi = pi < 0 ? 0 : (pi > 2 * L - 8 ? 2 * L - 8 : pi);
                    if (lane < 36) { Xr[t] = *(const v4u*)(TRg + xi); Pr[t] = *(const v4u*)(TRg + pi); } } }
            const LAS unsigned char* bp = Ub + bbase - (e0 + 7) * 80;
            bf16x8 Bf[2][2]; s16x4 Al[2][TPW][2], Ah[2][TPW][2];
#define HY_LOAD(buf, dl) do { _Pragma("unroll") for (int ks = 0; ks < 2; ++ks) Bf[buf][ks] = *(const LAS bf16x8*)(bp + 80 * (7 - (dl)) + 32 * ks); \
                _Pragma("unroll") for (int t = 0; t < TPW; ++t) { const LAS unsigned char* ap = Tb + t * 2304 + abase + 64 * (8 - (dl)); \
                    Al[buf][t][0] = *(const LAS s16x4*)ap; Ah[buf][t][0] = *(const LAS s16x4*)(ap + o8); Al[buf][t][1] = *(const LAS s16x4*)(ap + o32); Ah[buf][t][1] = *(const LAS s16x4*)(ap + o40); } \
                asm volatile("" ::: "memory"); } while (0)
            HY_LOAD(0, 0);
#pragma unroll
            for (int dl = 0; dl < 8; ++dl) {
                if (dl < 7) HY_LOAD((dl + 1) & 1, dl + 1);
#pragma unroll
                for (int ks = 0; ks < 2; ++ks)
#pragma unroll
                    for (int t = 0; t < TPW; ++t) { const bf16x8 Af = __builtin_shufflevector(Al[dl & 1][t][ks], Ah[dl & 1][t][ks], 0, 1, 2, 3, 4, 5, 6, 7);
                        acc[t] = __builtin_amdgcn_mfma_f32_32x32x16_bf16(Af, Bf[dl & 1][ks], acc[t], 0, 0, 0); }
            }
#undef HY_LOAD
        }
        }
        int i0e = i0, he = h; asm volatile("" : "+v"(i0e), "+v"(he));
        const float invS = 1.f / red[2 * cidx + o]; const float bias = hb[o * 1024 + ch];
        const int gch = (o == 0 ? 1024 : 2048) + ch;
        const LAS bf16* Gr = (const LAS bf16*)(F.lds + RING_OFF + GOFF + cidx * (L * 2)); const float w0 = cw[0 * 3072 + gch], w1 = cw[1 * 3072 + gch], w2 = cw[2 * 3072 + gch], b = cb[gch];
#pragma unroll
        for (int t = 0; t < TPW; ++t) { const int n0 = 32 * (wl * TPW + t);
#pragma unroll
            for (int rg = 0; rg < 4; ++rg) { const int p = 32 * (n0 + i0e) + 8 * rg + 4 * he;
                const s16x4 uu = *(const LAS s16x4*)(Ub + ((p >> 5) + 32) * 80 + (p & 31) * 2);
                const s16x4 gm = *(const LAS s16x4*)(Gr + p);
                float hx[6]; hx[0] = p > 0 ? bf2f(Gr[p - 1]) : 0.f; hx[5] = p + 4 < L ? bf2f(Gr[p + 4]) : 0.f;
#pragma unroll
                for (int q = 0; q < 4; ++q) hx[1 + q] = bf2f((unsigned short)gm[q]);
                float z[4];
#pragma unroll
                for (int q = 0; q < 4; ++q) { const float gate = b + w0 * hx[q] + w1 * hx[q + 1] + w2 * hx[q + 2];
                    const float y = acc[t][4 * rg + q] * invS + bias * bf2f((unsigned short)uu[q]); z[q] = gate * y; }
                if (o == 0) { zpk[t][rg][0] = pk2(z[0], z[1]); zpk[t][rg][1] = pk2(z[2], z[3]); }
                else { unsigned long long wv = (unsigned long long)pk2(z[0], z[1]) | ((unsigned long long)pk2(z[2], z[3]) << 32); *(unsigned long long*)(ZT + (size_t)ch * M + sb + p) = wv; }
                asm volatile("" ::: "memory"); }
        }
        __syncthreads();
        if (o == 0) {
#pragma unroll
            for (int t = 0; t < TPW; ++t) { const int n0 = 32 * (wl * TPW + t);
#pragma unroll
                for (int rg = 0; rg < 4; ++rg) { const int p = 32 * (n0 + i0e) + 8 * rg + 4 * he;
                    *(LAS unsigned long long*)(Ub + ((p >> 5) + 32) * 80 + (p & 31) * 2) = (unsigned long long)zpk[t][rg][0] | ((unsigned long long)zpk[t][rg][1] << 32); } }
            warm_taps<L, NCH>(F, TAPS + (size_t)1024 * (2 * L), ch0, red + 8);
            {   v4u gr[NU];
#pragma unroll
                for (int it = 0; it < NU; ++it) { const int idx = F.tid + 512 * it, cc = idx / (L / 8), p8 = 8 * (idx % (L / 8)); gr[it] = *(const v4u*)(HYT + (size_t)(2048 + ch0 + cc) * M + sb + p8); }
#pragma unroll
                for (int it = 0; it < NU; ++it) { const int idx = F.tid + 512 * it, cc = idx / (L / 8), p8 = 8 * (idx % (L / 8)); *(LAS v4u*)(F.lds + RING_OFF + GOFF + cc * (L * 2) + p8 * 2) = gr[it]; } }
            __syncthreads();
        }
    }
}


typedef short v4i16_t __attribute__((ext_vector_type(4)));
typedef float f32x2_t __attribute__((ext_vector_type(2))); typedef __bf16 bf16x2_t __attribute__((ext_vector_type(2)));
__device__ __forceinline__ unsigned cvtpk_rne(float lo, float hi) { f32x2_t v = {lo, hi}; bf16x2_t b = __builtin_convertvector(v, bf16x2_t); return __builtin_bit_cast(unsigned, b); }
__device__ __forceinline__ s16x4 vtr_read(const LAS unsigned char* p) { return __builtin_bit_cast(s16x4, __builtin_amdgcn_ds_read_tr16_b64_v4i16((LAS v4i16_t*)p)); }
__device__ __forceinline__ int crow32(int r, int h) { return (r & 3) + 8 * (r >> 2) + 4 * h; }
template <int NR, int CPR> struct StageRegs { static constexpr int NIT = (NR * CPR + 511) / 512; v4u v[NIT]; };
template <int NR, int CPR> __device__ __forceinline__ void stage_load(StageRegs<NR, CPR>& S, const bf16* base, size_t gp, int wr0, int lo, int hi, int tid) {
#pragma unroll
    for (int it = 0; it < StageRegs<NR, CPR>::NIT; ++it) { const int idx = tid + 512 * it, r = idx / CPR, ck = idx % CPR, grow = wr0 + r;
        S.v[it] = (v4u){0u, 0u, 0u, 0u}; if (idx < NR * CPR && grow >= lo && grow < hi) S.v[it] = *(const v4u*)(base + (size_t)grow * gp + ck * 8); }
}
template <int NR, int CPR, int LP> __device__ __forceinline__ void stage_store(const StageRegs<NR, CPR>& S, LAS unsigned char* dst, int tid) {
#pragma unroll
    for (int it = 0; it < StageRegs<NR, CPR>::NIT; ++it) { const int idx = tid + 512 * it, r = idx / CPR, ck = idx % CPR;
        if (idx < NR * CPR) *(LAS v4u*)(dst + r * LP + ck * 16) = S.v[it]; }
}
template <int NR, int CPR, int LP> __device__ __forceinline__ void stage_rows(LAS unsigned char* dst, const bf16* base, size_t gp, int wr0, int lo, int hi, int tid) {
    StageRegs<NR, CPR> S; stage_load<NR, CPR>(S, base, gp, wr0, lo, hi, tid); stage_store<NR, CPR, LP>(S, dst, tid);
}
template <int HD, int NT, int RAD, int KP> __device__ __forceinline__ void attn_scores(f32x16 (&S)[NT], const LAS unsigned char* Kw, const bf16x8 (&Qf)[HD / 16], int q, int h, int ki0, int lo, int hi, float scale_l2, float sink_l2, bool has_sink, float& m_out, float& den_out) {
    constexpr int KH = HD / 32;
    bf16x8 Kf[2][KH];
#define QK_LOAD(buf, st) do { _Pragma("unroll") for (int kk = 0; kk < KH; ++kk) Kf[buf][kk] = *(const LAS bf16x8*)(Kw + (32 * ((st) >> 1) + q) * KP + 32 * (KH * ((st) & 1) + kk) + 16 * h); } while (0)
    QK_LOAD(0, 0);
#pragma unroll
    for (int st = 0; st < 2 * NT; ++st) { const int t = st >> 1;
        if (st + 1 < 2 * NT) QK_LOAD((st + 1) & 1, st + 1);
        __builtin_amdgcn_sched_barrier(0);
        if ((st & 1) == 0) {
#pragma unroll
            for (int r = 0; r < 16; ++r) S[t][r] = 0.f; }
#pragma unroll
        for (int kk = 0; kk < KH; ++kk) S[t] = __builtin_amdgcn_mfma_f32_32x32x16_bf16(Kf[st & 1][kk], Qf[KH * (st & 1) + kk], S[t], 0, 0, 0);
        __builtin_amdgcn_sched_barrier(0);
    }
#undef QK_LOAD
    float m = has_sink ? sink_l2 : -1e30f;
#pragma unroll
    for (int t = 0; t < NT; ++t)
#pragma unroll
        for (int r = 0; r < 16; ++r) { const int kv = 32 * t + crow32(r, h); const int rel = kv - RAD - q; const int ki = ki0 + kv;
            const bool ok = (rel >= -RAD) && (rel <= RAD) && (ki >= lo) && (ki < hi);
            const float sv = ok ? S[t][r] * scale_l2 : -1e30f; S[t][r] = sv; m = fmaxf(m, sv); }
    m = fmaxf(m, __shfl_xor(m, 32));
    float den = 0.f;
#pragma unroll
    for (int t = 0; t < NT; ++t)
#pragma unroll
        for (int r = 0; r < 16; ++r) { const float p = __builtin_amdgcn_exp2f(S[t][r] - m); S[t][r] = p; den += p; }
    den += __shfl_xor(den, 32);
    if (has_sink) den += __builtin_amdgcn_exp2f(sink_l2 - m);
    m_out = m; den_out = den;
}
template <int HD, int NT, int VP> __device__ __forceinline__ void attn_pv(f32x16 (&O)[HD / 32], const f32x16 (&S)[NT], const LAS unsigned char* Vw, int lane) {
    constexpr int NDB = HD / 32, NST = 2 * NT;
    const int G = lane >> 4, i = lane & 15, h = lane >> 5;
    const LAS unsigned char* vb = Vw + (4 * h + (i >> 2)) * VP + (16 * (G & 1) + 4 * (i & 3)) * 2;
#pragma unroll
    for (int db = 0; db < NDB; ++db)
#pragma unroll
        for (int r = 0; r < 16; ++r) O[db][r] = 0.f;
    s16x4 Vl[2][NDB], Vh[2][NDB];
#define PV_LOAD(buf, st) do { _Pragma("unroll") for (int db = 0; db < NDB; ++db) { const LAS unsigned char* vp = vb + (16 * (st)) * VP + 64 * db; Vl[buf][db] = vtr_read(vp); Vh[buf][db] = vtr_read(vp + 8 * VP); } } while (0)
    PV_LOAD(0, 0);
#pragma unroll
    for (int st = 0; st < NST; ++st) { const int t = st >> 1, s2 = st & 1;
        if (st + 1 < NST) PV_LOAD((st + 1) & 1, st + 1);
        __builtin_amdgcn_sched_barrier(0);
        u32x4_t pw; pw.x = cvtpk_rne(S[t][8 * s2 + 0], S[t][8 * s2 + 1]); pw.y = cvtpk_rne(S[t][8 * s2 + 2], S[t][8 * s2 + 3]); pw.z = cvtpk_rne(S[t][8 * s2 + 4], S[t][8 * s2 + 5]); pw.w = cvtpk_rne(S[t][8 * s2 + 6], S[t][8 * s2 + 7]);
        const bf16x8 Pf = __builtin_bit_cast(bf16x8, pw);
#pragma unroll
        for (int db = 0; db < NDB; ++db) { const bf16x8 Af = __builtin_shufflevector(Vl[st & 1][db], Vh[st & 1][db], 0, 1, 2, 3, 4, 5, 6, 7);
            O[db] = __builtin_amdgcn_mfma_f32_32x32x16_bf16(Af, Pf, O[db], 0, 0, 0); }
        __builtin_amdgcn_sched_barrier(0);
    }
#undef PV_LOAD
}

template <int HD, int NT, int RAD, int KP, int VP> __device__ __forceinline__ void attn_online(f32x16 (&O)[HD / 32], const LAS unsigned char* Kw, const LAS unsigned char* Vw, const bf16x8 (&Qf)[HD / 16], int lane, int ki0, int lo, int hi, float scale_l2, float m0, float& m_out, float& den_out) {
    const int q = lane & 31, h = lane >> 5, G = lane >> 4, i = lane & 15;
    const LAS unsigned char* vb = Vw + (4 * h + (i >> 2)) * VP + (16 * (G & 1) + 4 * (i & 3)) * 2;
    float m = m0, den = 0.f;
#pragma unroll
    for (int db = 0; db < HD / 32; ++db)
#pragma unroll
        for (int r = 0; r < 16; ++r) O[db][r] = 0.f;
#pragma unroll
    for (int t = 0; t < NT; ++t) {
        f32x16 St;
#pragma unroll
        for (int r = 0; r < 16; ++r) St[r] = 0.f;
#pragma unroll
        for (int ks = 0; ks < HD / 16; ++ks) { const bf16x8 Af = *(const LAS bf16x8*)(Kw + (32 * t + q) * KP + 32 * ks + 16 * h); St = __builtin_amdgcn_mfma_f32_32x32x16_bf16(Af, Qf[ks], St, 0, 0, 0); }
        float tm = -1e30f;
#pragma unroll
        for (int r = 0; r < 16; ++r) { const int kv = 32 * t + crow32(r, h); const int rel = kv - RAD - q; const int ki = ki0 + kv;
            const bool ok = (rel >= -RAD) && (rel <= RAD) && (ki >= lo) && (ki < hi);
            const float sv = ok ? St[r] * scale_l2 : -1e30f; St[r] = sv; tm = fmaxf(tm, sv); }
        tm = fmaxf(tm, __shfl_xor(tm, 32));
        const float mn = fmaxf(m, tm), alpha = __builtin_amdgcn_exp2f(m - mn); m = mn;
        float ps = 0.f;
#pragma unroll
        for (int r = 0; r < 16; ++r) { const float p = __builtin_amdgcn_exp2f(St[r] - m); St[r] = p; ps += p; }
        den = den * alpha + ps;
#pragma unroll
        for (int db = 0; db < HD / 32; ++db)
#pragma unroll
            for (int r = 0; r < 16; ++r) O[db][r] *= alpha;
#pragma unroll
        for (int s2 = 0; s2 < 2; ++s2) {
            u32x4_t pw; pw.x = cvtpk_rne(St[8 * s2 + 0], St[8 * s2 + 1]); pw.y = cvtpk_rne(St[8 * s2 + 2], St[8 * s2 + 3]); pw.z = cvtpk_rne(St[8 * s2 + 4], St[8 * s2 + 5]); pw.w = cvtpk_rne(St[8 * s2 + 6], St[8 * s2 + 7]);
            const bf16x8 Pf = __builtin_bit_cast(bf16x8, pw);
#pragma unroll
            for (int db = 0; db < HD / 32; ++db) { const LAS unsigned char* vp = vb + (32 * t + 16 * s2) * VP + 64 * db;
                const s16x4 lo4 = vtr_read(vp), hi4 = vtr_read(vp + 8 * VP);
                const bf16x8 Af = __builtin_shufflevector(lo4, hi4, 0, 1, 2, 3, 4, 5, 6, 7);
                O[db] = __builtin_amdgcn_mfma_f32_32x32x16_bf16(Af, Pf, O[db], 0, 0, 0); }
        }
    }
    den += __shfl_xor(den, 32);
    m_out = m; den_out = den;
}

__device__ __forceinline__ void attn_odd_unit(Frame& F, int g, int head, int R0, bool dummy) {
    constexpr int KP = 272, VP = 320, NT = 5, RAD = 64;
    bf16* QKV = (bf16*)(F.ws + WS_BIG); float* LSE = (float*)(F.ws + WS_LSE);
    bf16* Qg = QKV + ((size_t)((0 * 3 + g) * 16 + head) * M) * 128; const bf16* Kg = QKV + ((size_t)((1 * 3 + g) * 16 + head) * M) * 128; const bf16* Vg = QKV + ((size_t)((2 * 3 + g) * 16 + head) * M) * 128;
    const int sb = pg8::seq_base_of_row(R0), L = sb == 0 ? 16384 : 4096, ls = L >> (2 * g);
    const int seglo = sb + ((R0 - sb) / ls) * ls, seghi = seglo + ls;
    LAS unsigned char* img = F.lds + RING_OFF;
    int lane = F.lane, tid = F.tid; asm volatile("" : "+v"(lane), "+v"(tid));
    const int q = lane & 31, h = lane >> 5, w = F.wave;
    const int qrow = R0 + 32 * w + q;
    bf16x8 Qf[8];
#pragma unroll
    for (int ks = 0; ks < 8; ++ks) Qf[ks] = *(const bf16x8*)(Qg + (size_t)qrow * 128 + 16 * ks + 8 * h);
    stage_rows<384, 16, KP>(img, Kg, 128, R0 - 64, seglo, seghi, tid);

    __syncthreads();
    f32x16 S[NT]; float m, den;
    attn_scores<128, NT, RAD, KP>(S, img + (32 * w) * KP, Qf, q, h, R0 + 32 * w - 64, seglo, seghi, 0.08838834764831845f * 1.4426950408889634f, 0.f, false, m, den);
    __syncthreads();
    stage_rows<384, 16, VP>(img, Vg, 128, R0 - 64, seglo, seghi, tid);
    __syncthreads();
    f32x16 O[4];
    attn_pv<128, NT, VP>(O, S, img + (32 * w) * VP, lane);
    const float inv = 1.f / den;
#pragma unroll
    for (int db = 0; db < 4; ++db)
#pragma unroll
        for (int rg = 0; rg < 4; ++rg) { const unsigned long long wv = (unsigned long long)cvtpk_rne(O[db][4 * rg] * inv, O[db][4 * rg + 1] * inv) | ((unsigned long long)cvtpk_rne(O[db][4 * rg + 2] * inv, O[db][4 * rg + 3] * inv) << 32);
            bf16* od = dummy ? (bf16*)(F.ws + WS_XB) + ((((size_t)(g * 16 + head) * M + qrow) * 128) & (size_t)0x1FFFFFF) : Qg + (size_t)qrow * 128;
            *(unsigned long long*)(od + 32 * db + 8 * rg + 4 * h) = wv; }
    if (h == 0 && !dummy) LSE[((size_t)g * M + qrow) * 16 + head] = (m + __builtin_amdgcn_logf(den)) * 0.6931471805599453f;
    __syncthreads();
}
__device__ __forceinline__ void p_attn_odd_mfma(Frame& F, bool dummy) {
    for (int u = F.bx; u < 3 * 16 * (M / 256); u += F.G) { const int rb = u % (M / 256), gh = u / (M / 256); attn_odd_unit(F, gh >> 4, gh & 15, rb * 256, dummy); }
}

__device__ __forceinline__ void attn_even_unit(Frame& F, int j, int kvh, int R0) {
    constexpr int KP = 144, VP = 192, NT = 9, RAD = 128;
    const bf16* Q = (const bf16*)(F.ws + WS_BIG + B_Q); const bf16* Kb = (const bf16*)(F.ws + WS_BIG + B_K); const bf16* Vb = (const bf16*)(F.ws + WS_BIG + B_V);
    bf16* AO = (bf16*)(F.ws + WS_XB);
    const int sb = pg8::seq_base_of_row(R0), L = sb == 0 ? 16384 : 4096;
    LAS unsigned char* kimg = F.lds + RING_OFF; LAS unsigned char* vimg = kimg + 288 * KP;
    int lane = F.lane, tid = F.tid; asm volatile("" : "+v"(lane), "+v"(tid));
    const int q = lane & 31, h = lane >> 5, w = F.wave, head = kvh * 8 + w;
    stage_rows<288, 8, KP>(kimg, Kb + kvh * 64, 128, R0 - 128, sb, sb + L, tid);
    stage_rows<288, 8, VP>(vimg, Vb + kvh * 64, 128, R0 - 128, sb, sb + L, tid);
    const int qrow = R0 + q;
    bf16x8 Qf[4];
#pragma unroll
    for (int ks = 0; ks < 4; ++ks) Qf[ks] = *(const bf16x8*)(Q + (size_t)qrow * 1024 + head * 64 + 16 * ks + 8 * h);
    const float sink_l2 = (F.in[3] + j * 16)[head] * 1.4426950408889634f;
    __syncthreads();
    float m, den; f32x16 O[2];
    attn_online<64, NT, RAD, KP, VP>(O, kimg, vimg, Qf, lane, R0 - 128, sb, sb + L, 0.125f * 1.4426950408889634f, sink_l2, m, den);
    den += __builtin_amdgcn_exp2f(sink_l2 - m);
    const float inv = 1.f / den;
#pragma unroll
    for (int db = 0; db < 2; ++db)
#pragma unroll
        for (int rg = 0; rg < 4; ++rg) { const unsigned long long wv = (unsigned long long)cvtpk_rne(O[db][4 * rg] * inv, O[db][4 * rg + 1] * inv) | ((unsigned long long)cvtpk_rne(O[db][4 * rg + 2] * inv, O[db][4 * rg + 3] * inv) << 32);
            *(unsigned long long*)(AO + (size_t)qrow * D + head * 64 + 32 * db + 8 * rg + 4 * h) = wv; }
    __syncthreads();
}
__device__ __forceinline__ void p_attn_even_mfma(Frame& F, int j) {
    for (int u = F.bx; u < 2 * (M / 32); u += F.G) attn_even_unit(F, j, u & 1, (u >> 1) * 32);
}


template <int L> __device__ __forceinline__ void hyena_unit_mfma64(Frame& F, int j, int s, int ch) {
    constexpr int NB = L / 64, NT = NB / 32, NTL = L / 64, cls = (L == 4096) ? 1 : 0;
    static_assert(NT == NWAVES, "one tile per wave");
    constexpr int UBYTES = (NB + 64) * 144, DC = 4, CP = 704, TSTG = 4 * CP, GOFF = UBYTES + NWAVES * TSTG;
    static_assert(GOFF + L * 2 <= RING_BYTES, "hyena64 LDS");
    const int sb = seq_base(s);
    const int w = F.wave, lane = F.lane, i0 = lane & 31, h = lane >> 5, n0 = 32 * w;
    LAS unsigned char* Ub = F.lds + RING_OFF;
    LAS unsigned char* Tb = F.lds + RING_OFF + UBYTES + w * TSTG;
    LAS float* red = (LAS float*)(F.lds + LDSCTL_OFF + 64);
    const bf16* HYT = (const bf16*)(F.ws + WS_BIG + B_HYT); bf16* ZT = (bf16*)(F.ws + WS_BIG + B_ZT);
    const bf16* TAPS = (const bf16*)(F.ws + WS_BIG + (cls ? B_TAP1 : B_TAP0));
    const float* PS = (const float*)(F.ws + WS_BIG + B_PSUM) + (cls ? (size_t)256 * 4096 : 0);
    const float* cw = F.in[4] + (size_t)j * 3 * 3072; const float* cb = F.in[5] + (size_t)j * 3072; const float* hb = F.in[14] + (size_t)j * 2 * 1024;
    if (w < 2) { const int o = w; float a = 0.f;
        for (int t = lane; t < NTL; t += 64) a += PS[(size_t)t * 4096 + (0 * 2 + o) * 1024 + ch] + PS[(size_t)t * 4096 + (1 * 2 + o) * 1024 + ch];
        a = wave_sum(a); if (lane == 0) red[w] = a; }
    constexpr int NU = (L / 8) / 512;
    {   v4u raw[NU], gr[NU]; unsigned short xm[NU], xp[NU];
        const bf16* hr = HYT + (size_t)ch * M + sb;
#pragma unroll
        for (int it = 0; it < NU; ++it) { const int p8 = 8 * (F.tid + 512 * it);
            raw[it] = *(const v4u*)(hr + p8); xm[it] = p8 > 0 ? hr[p8 - 1] : (unsigned short)0; xp[it] = p8 + 8 < L ? hr[p8 + 8] : (unsigned short)0;
            gr[it] = *(const v4u*)(HYT + (size_t)(1024 + ch) * M + sb + p8); }
        for (int z = F.tid; z < 576; z += 512) { const int blk = z < 288 ? z / 9 : NB + 32 + (z - 288) / 9, part = z % 9;
            *(LAS v4u*)(Ub + blk * 144 + part * 16) = (v4u){0u, 0u, 0u, 0u}; }
        const float w0 = cw[0 * 3072 + ch], w1 = cw[1 * 3072 + ch], w2 = cw[2 * 3072 + ch], b = cb[ch];
#pragma unroll
        for (int it = 0; it < NU; ++it) { const int p8 = 8 * (F.tid + 512 * it);
            float x[10]; x[0] = bf2f(xm[it]); x[9] = bf2f(xp[it]);
#pragma unroll
            for (int q = 0; q < 4; ++q) { x[1 + 2 * q] = bf2f((unsigned short)(raw[it][q] & 0xffff)); x[2 + 2 * q] = bf2f((unsigned short)(raw[it][q] >> 16)); }
            v4u o;
#pragma unroll
            for (int q = 0; q < 4; ++q) o[q] = pk2(b + w0 * x[2 * q] + w1 * x[2 * q + 1] + w2 * x[2 * q + 2], b + w0 * x[2 * q + 1] + w1 * x[2 * q + 2] + w2 * x[2 * q + 3]);
            *(LAS v4u*)(Ub + ((p8 >> 6) + 32) * 144 + (p8 & 63) * 2) = o;
            *(LAS v4u*)(F.lds + RING_OFF + GOFF + p8 * 2) = gr[it]; }
    }
    __syncthreads();
    const int c4 = i0 & 3;
    int o8 = 8; asm volatile("" : "+v"(o8));
    const int abase = c4 * CP + 2 * (64 * DC + 8 * h - (i0 & ~3));
    const int bbase = (i0 + 32) * 144 + 16 * h;
    unsigned zpk[2][4][2];
#pragma unroll 1
    for (int o = 0; o < 2; ++o) {
        f32x16 acc[2];
#pragma unroll
        for (int mi = 0; mi < 2; ++mi)
#pragma unroll
            for (int r = 0; r < 16; ++r) acc[mi][r] = 0.f;
        const bf16* TRg = TAPS + (size_t)(o * 1024 + ch) * (2 * L);
        v4u Xr, Pr;
        { const int wbase = L - 64 * (n0 - NB) - 64 * DC; int xi = wbase + 8 * lane, pi = xi - 8; xi = xi < 0 ? 0 : (xi > 2 * L - 8 ? 2 * L - 8 : xi); pi = pi < 0 ? 0 : (pi > 2 * L - 8 ? 2 * L - 8 : pi);
          if (lane < 8 * DC + 8) { Xr = *(const v4u*)(TRg + xi); Pr = *(const v4u*)(TRg + pi); } }
#pragma unroll 1
        for (int e0 = -NB; e0 < 32; e0 += DC) {
            if (lane < 8 * DC + 8) { const v4u X = Xr, P = Pr;
                const unsigned a0 = __builtin_amdgcn_alignbit(X.x, P.w, 16), a1 = __builtin_amdgcn_alignbit(X.y, X.x, 16), a2 = __builtin_amdgcn_alignbit(X.z, X.y, 16), a3 = __builtin_amdgcn_alignbit(X.w, X.z, 16), a4 = __builtin_amdgcn_alignbit(P.w, P.z, 16);
                LAS unsigned char* dst = Tb + 16 * lane;
                *(LAS v4u*)(dst) = X;
                *(LAS v4u*)(dst + CP) = (v4u){a0, a1, a2, a3};
                *(LAS v4u*)(dst + 2 * CP) = (v4u){P.w, X.x, X.y, X.z};
                *(LAS v4u*)(dst + 3 * CP) = (v4u){a4, a0, a1, a2}; }
            if (e0 + DC < 32) { const int wbase = L - 64 * (n0 + e0 + DC) - 64 * DC; int xi = wbase + 8 * lane, pi = xi - 8; xi = xi < 0 ? 0 : (xi > 2 * L - 8 ? 2 * L - 8 : xi); pi = pi < 0 ? 0 : (pi > 2 * L - 8 ? 2 * L - 8 : pi);
                if (lane < 8 * DC + 8) { Xr = *(const v4u*)(TRg + xi); Pr = *(const v4u*)(TRg + pi); } }
            const LAS unsigned char* bp = Ub + bbase - e0 * 144;
#pragma unroll
            for (int dd = 0; dd < DC; ++dd) {
                bf16x8 Bf[4];
#pragma unroll
                for (int ks = 0; ks < 4; ++ks) Bf[ks] = *(const LAS bf16x8*)(bp - 144 * dd + 32 * ks);
                bf16x8 Fq[6];
#pragma unroll
                for (int qi = 0; qi < 6; ++qi) { const LAS unsigned char* ap = Tb + abase - 128 * dd - 32 * (qi - 3);
                    const s16x4 lo = *(const LAS s16x4*)ap, hi = *(const LAS s16x4*)(ap + o8);
                    Fq[qi] = __builtin_shufflevector(lo, hi, 0, 1, 2, 3, 4, 5, 6, 7); }
#pragma unroll
                for (int ks = 0; ks < 4; ++ks)
#pragma unroll
                    for (int mi = 0; mi < 2; ++mi) acc[mi] = __builtin_amdgcn_mfma_f32_32x32x16_bf16(Fq[2 * mi - ks + 3], Bf[ks], acc[mi], 0, 0, 0);
            }
        }
        int i0e = i0, he = h; asm volatile("" : "+v"(i0e), "+v"(he));
        const float invS = 1.f / red[o]; const float bias = hb[o * 1024 + ch];
        const int gch = (o == 0 ? 1024 : 2048) + ch;
        const LAS bf16* Gr = (const LAS bf16*)(F.lds + RING_OFF + GOFF); const float w0 = cw[0 * 3072 + gch], w1 = cw[1 * 3072 + gch], w2 = cw[2 * 3072 + gch], b = cb[gch];
#pragma unroll
        for (int mi = 0; mi < 2; ++mi) {
#pragma unroll
            for (int rg = 0; rg < 4; ++rg) { const int p = 64 * (n0 + i0e) + 32 * mi + 8 * rg + 4 * he;
                const s16x4 uu = *(const LAS s16x4*)(Ub + ((p >> 6) + 32) * 144 + (p & 63) * 2);
                const s16x4 gm = *(const LAS s16x4*)(Gr + p);
                float hx[6]; hx[0] = p > 0 ? bf2f(Gr[p - 1]) : 0.f; hx[5] = p + 4 < L ? bf2f(Gr[p + 4]) : 0.f;
#pragma unroll
                for (int q = 0; q < 4; ++q) hx[1 + q] = bf2f((unsigned short)gm[q]);
                float z[4];
#pragma unroll
                for (int q = 0; q < 4; ++q) { const float gate = b + w0 * hx[q] + w1 * hx[q + 1] + w2 * hx[q + 2];
                    const float y = acc[mi][4 * rg + q] * invS + bias * bf2f((unsigned short)uu[q]); z[q] = gate * y; }
                if (o == 0) { zpk[mi][rg][0] = pk2(z[0], z[1]); zpk[mi][rg][1] = pk2(z[2], z[3]); }
                else { unsigned long long wv = (unsigned long long)pk2(z[0], z[1]) | ((unsigned long long)pk2(z[2], z[3]) << 32); *(unsigned long long*)(ZT + (size_t)ch * M + sb + p) = wv; } }
        }
        __syncthreads();
        if (o == 0) {
#pragma unroll
            for (int mi = 0; mi < 2; ++mi)
#pragma unroll
                for (int rg = 0; rg < 4; ++rg) { const int p = 64 * (n0 + i0e) + 32 * mi + 8 * rg + 4 * he;
                    *(LAS unsigned long long*)(Ub + ((p >> 6) + 32) * 144 + (p & 63) * 2) = (unsigned long long)zpk[mi][rg][0] | ((unsigned long long)zpk[mi][rg][1] << 32); }
            {   v4u gr[NU];
#pragma unroll
                for (int it = 0; it < NU; ++it) { const int p8 = 8 * (F.tid + 512 * it); gr[it] = *(const v4u*)(HYT + (size_t)(2048 + ch) * M + sb + p8); }
#pragma unroll
                for (int it = 0; it < NU; ++it) { const int p8 = 8 * (F.tid + 512 * it); *(LAS v4u*)(F.lds + RING_OFF + GOFF + p8 * 2) = gr[it]; } }
            __syncthreads();
        }
    }
}


template <int L> __device__ __forceinline__ void hyena_unit_mfma128(Frame& F, int j, int s, int ch) {
    constexpr int NB = L / 128, NTL = L / 64, cls = (L == 4096) ? 1 : 0, DC = 2, CP = 832;
    static_assert(NB == 128, "four tiles, two waves each");
    constexpr int UBYTES = (NB + 64) * 272, XOFF = UBYTES, TSTG = 4 * CP, GOFF = XOFF + NWAVES * TSTG, XBYTES = 65536;
    static_assert(GOFF + L * 2 <= XOFF + XBYTES && XOFF + XBYTES <= RING_BYTES, "hyena128 LDS");
    const int sb = seq_base(s);
    const int w = F.wave, lane = F.lane, i0 = lane & 31, h = lane >> 5, tile = w >> 1, half = w & 1, n0 = 32 * tile;
    LAS unsigned char* Ub = F.lds + RING_OFF;
    LAS unsigned char* Tb = F.lds + RING_OFF + XOFF + w * TSTG;
    LAS float* red = (LAS float*)(F.lds + LDSCTL_OFF + 64);
    const bf16* HYT = (const bf16*)(F.ws + WS_BIG + B_HYT); bf16* ZT = (bf16*)(F.ws + WS_BIG + B_ZT);
    const bf16* TAPS = (const bf16*)(F.ws + WS_BIG + (cls ? B_TAP1 : B_TAP0));
    const float* PS = (const float*)(F.ws + WS_BIG + B_PSUM) + (cls ? (size_t)256 * 4096 : 0);
    const float* cw = F.in[4] + (size_t)j * 3 * 3072; const float* cb = F.in[5] + (size_t)j * 3072; const float* hb = F.in[14] + (size_t)j * 2 * 1024;
    if (w < 2) { const int o = w; float a = 0.f;
        for (int t = lane; t < NTL; t += 64) a += PS[(size_t)t * 4096 + (0 * 2 + o) * 1024 + ch] + PS[(size_t)t * 4096 + (1 * 2 + o) * 1024 + ch];
        a = wave_sum(a); if (lane == 0) red[w] = a; }
    constexpr int NU = (L / 8) / 512;
    {   v4u raw[NU]; unsigned short xm[NU], xp[NU];
        const bf16* hr = HYT + (size_t)ch * M + sb;
#pragma unroll
        for (int it = 0; it < NU; ++it) { const int p8 = 8 * (F.tid + 512 * it);
            raw[it] = *(const v4u*)(hr + p8); xm[it] = p8 > 0 ? hr[p8 - 1] : (unsigned short)0; xp[it] = p8 + 8 < L ? hr[p8 + 8] : (unsigned short)0; }
        for (int z = F.tid; z < 64 * 17; z += 512) { const int b = z / 17, part = z % 17, blk = b < 32 ? b : NB + b;
            *(LAS v4u*)(Ub + blk * 272 + part * 16) = (v4u){0u, 0u, 0u, 0u}; }
        const float w0 = cw[0 * 3072 + ch], w1 = cw[1 * 3072 + ch], w2 = cw[2 * 3072 + ch], b = cb[ch];
#pragma unroll
        for (int it = 0; it < NU; ++it) { const int p8 = 8 * (F.tid + 512 * it);
            float x[10]; x[0] = bf2f(xm[it]); x[9] = bf2f(xp[it]);
#pragma unroll
            for (int q = 0; q < 4; ++q) { x[1 + 2 * q] = bf2f((unsigned short)(raw[it][q] & 0xffff)); x[2 + 2 * q] = bf2f((unsigned short)(raw[it][q] >> 16)); }
            v4u o;
#pragma unroll
            for (int q = 0; q < 4; ++q) o[q] = pk2(b + w0 * x[2 * q] + w1 * x[2 * q + 1] + w2 * x[2 * q + 2], b + w0 * x[2 * q + 1] + w1 * x[2 * q + 2] + w2 * x[2 * q + 3]);
            *(LAS v4u*)(Ub + ((p8 >> 7) + 32) * 272 + (p8 & 127) * 2) = o; }
    }
    __syncthreads();
    const int c4 = i0 & 3;
    int o8 = 8; asm volatile("" : "+v"(o8));
    const int abase = c4 * CP + 2 * (128 * DC + 8 * h - (i0 & ~3));
    const int bbase = (i0 + 32) * 272 + 16 * h;
    const int elo = half ? -48 : -128;
    unsigned zpk[2][4][2];
#pragma unroll 1
    for (int o = 0; o < 2; ++o) {
        f32x16 acc[4];
#pragma unroll
        for (int mi = 0; mi < 4; ++mi)
#pragma unroll
            for (int r = 0; r < 16; ++r) acc[mi][r] = 0.f;
        const bf16* TRg = TAPS + (size_t)(o * 1024 + ch) * (2 * L);
        v4u Xr, Pr;
        { const int wbase = L - 128 * (n0 + elo) - 128 * DC; int xi = wbase + 8 * lane, pi = xi - 8; xi = xi < 0 ? 0 : (xi > 2 * L - 8 ? 2 * L - 8 : xi); pi = pi < 0 ? 0 : (pi > 2 * L - 8 ? 2 * L - 8 : pi);
          if (lane < 48) { Xr = *(const v4u*)(TRg + xi); Pr = *(const v4u*)(TRg + pi); } }
#pragma unroll 1
        for (int ec = 0; ec < 80; ec += DC) { const int e0 = elo + ec;
            if (lane < 48) { const v4u X = Xr, P = Pr;
                const unsigned a0 = __builtin_amdgcn_alignbit(X.x, P.w, 16), a1 = __builtin_amdgcn_alignbit(X.y, X.x, 16), a2 = __builtin_amdgcn_alignbit(X.z, X.y, 16), a3 = __builtin_amdgcn_alignbit(X.w, X.z, 16), a4 = __builtin_amdgcn_alignbit(P.w, P.z, 16);
                LAS unsigned char* dst = Tb + 16 * lane;
                *(LAS v4u*)(dst) = X;
                *(LAS v4u*)(dst + CP) = (v4u){a0, a1, a2, a3};
                *(LAS v4u*)(dst + 2 * CP) = (v4u){P.w, X.x, X.y, X.z};
                *(LAS v4u*)(dst + 3 * CP) = (v4u){a4, a0, a1, a2}; }
            if (ec + DC < 80) { const int wbase = L - 128 * (n0 + e0 + DC) - 128 * DC; int xi = wbase + 8 * lane, pi = xi - 8; xi = xi < 0 ? 0 : (xi > 2 * L - 8 ? 2 * L - 8 : xi); pi = pi < 0 ? 0 : (pi > 2 * L - 8 ? 2 * L - 8 : pi);
                if (lane < 48) { Xr = *(const v4u*)(TRg + xi); Pr = *(const v4u*)(TRg + pi); } }
            const LAS unsigned char* bp = Ub + bbase - e0 * 272;
#pragma unroll
            for (int dd = 0; dd < DC; ++dd) {
                bf16x8 Bf[8];
#pragma unroll
                for (int ks = 0; ks < 8; ++ks) Bf[ks] = *(const LAS bf16x8*)(bp - 272 * dd + 32 * ks);
                bf16x8 Fq[14];
#pragma unroll
                for (int qi = 0; qi < 14; ++qi) { const LAS unsigned char* ap = Tb + abase - 256 * dd - 32 * (qi - 7);
                    const s16x4 lo = *(const LAS s16x4*)ap, hi = *(const LAS s16x4*)(ap + o8);
                    Fq[qi] = __builtin_shufflevector(lo, hi, 0, 1, 2, 3, 4, 5, 6, 7); }
#pragma unroll
                for (int ks = 0; ks < 8; ++ks)
#pragma unroll
                    for (int mi = 0; mi < 4; ++mi) acc[mi] = __builtin_amdgcn_mfma_f32_32x32x16_bf16(Fq[2 * mi - ks + 7], Bf[ks], acc[mi], 0, 0, 0);
            }
        }
        int i0e = i0, he = h; asm volatile("" : "+v"(i0e), "+v"(he));
        __syncthreads();
        {   LAS unsigned char* mine = F.lds + RING_OFF + XOFF + (tile * 2 + half) * 8192 + (i0e + 32 * he) * 16;
#pragma unroll
            for (int ml = 0; ml < 2; ++ml)
#pragma unroll
                for (int rg = 0; rg < 4; ++rg) { const int mo = 2 * (1 - half) + ml;
                    f32x4 v; v[0] = half ? acc[0 + ml][4 * rg + 0] : acc[2 + ml][4 * rg + 0]; v[1] = half ? acc[0 + ml][4 * rg + 1] : acc[2 + ml][4 * rg + 1];
                    v[2] = half ? acc[0 + ml][4 * rg + 2] : acc[2 + ml][4 * rg + 2]; v[3] = half ? acc[0 + ml][4 * rg + 3] : acc[2 + ml][4 * rg + 3]; (void)mo;
                    *(LAS f32x4*)(mine + (ml * 4 + rg) * 1024) = v; } }
        v4u gr[NU];
        const int gch = (o == 0 ? 1024 : 2048) + ch;
#pragma unroll
        for (int it = 0; it < NU; ++it) gr[it] = *(const v4u*)(HYT + (size_t)gch * M + sb + 8 * (F.tid + 512 * it));
        __syncthreads();
        f32x16 fin[2];
        {   const LAS unsigned char* theirs = F.lds + RING_OFF + XOFF + (tile * 2 + (1 - half)) * 8192 + (i0e + 32 * he) * 16;
#pragma unroll
            for (int ml = 0; ml < 2; ++ml)
#pragma unroll
                for (int rg = 0; rg < 4; ++rg) { const f32x4 v = *(const LAS f32x4*)(theirs + (ml * 4 + rg) * 1024);
#pragma unroll
                    for (int q = 0; q < 4; ++q) fin[ml][4 * rg + q] = (half ? acc[2 + ml][4 * rg + q] : acc[0 + ml][4 * rg + q]) + v[q]; } }
        __syncthreads();
#pragma unroll
        for (int it = 0; it < NU; ++it) *(LAS v4u*)(F.lds + RING_OFF + GOFF + 16 * (F.tid + 512 * it)) = gr[it];
        __syncthreads();
        const float invS = 1.f / red[o]; const float bias = hb[o * 1024 + ch];
        const LAS bf16* Gr = (const LAS bf16*)(F.lds + RING_OFF + GOFF); const float w0 = cw[0 * 3072 + gch], w1 = cw[1 * 3072 + gch], w2 = cw[2 * 3072 + gch], b = cb[gch];
#pragma unroll
        for (int ml = 0; ml < 2; ++ml) { const int mi = 2 * half + ml;
#pragma unroll
            for (int rg = 0; rg < 4; ++rg) { const int p = 128 * (n0 + i0e) + 32 * mi + 8 * rg + 4 * he;
                const s16x4 uu = *(const LAS s16x4*)(Ub + ((p >> 7) + 32) * 272 + (p & 127) * 2);
                const s16x4 gm = *(const LAS s16x4*)(Gr + p);
                float hx[6]; hx[0] = p > 0 ? bf2f(Gr[p - 1]) : 0.f; hx[5] = p + 4 < L ? bf2f(Gr[p + 4]) : 0.f;
#pragma unroll
                for (int q = 0; q < 4; ++q) hx[1 + q] = bf2f((unsigned short)gm[q]);
                float z[4];
#pragma unroll
                for (int q = 0; q < 4; ++q) { const float gate = b + w0 * hx[q] + w1 * hx[q + 1] + w2 * hx[q + 2];
                    const float y = fin[ml][4 * rg + q] * invS + bias * bf2f((unsigned short)uu[q]); z[q] = gate * y; }
                if (o == 0) { zpk[ml][rg][0] = pk2(z[0], z[1]); zpk[ml][rg][1] = pk2(z[2], z[3]); }
                else { unsigned long long wv = (unsigned long long)pk2(z[0], z[1]) | ((unsigned long long)pk2(z[2], z[3]) << 32); *(unsigned long long*)(ZT + (size_t)ch * M + sb + p) = wv; } }
        }
        __syncthreads();
        if (o == 0) {
#pragma unroll
            for (int ml = 0; ml < 2; ++ml) { const int mi = 2 * half + ml;
#pragma unroll
                for (int rg = 0; rg < 4; ++rg) { const int p = 128 * (n0 + i0e) + 32 * mi + 8 * rg + 4 * he;
                    *(LAS unsigned long long*)(Ub + ((p >> 7) + 32) * 272 + (p & 127) * 2) = (unsigned long long)zpk[ml][rg][0] | ((unsigned long long)zpk[ml][rg][1] << 32); } }
            __syncthreads();
        }
    }
}


template <int L> struct HyFft { static constexpr int NCW = (L == 16384) ? 1 : 4, TPF = 512 / NCW, KS_STRIDE = L + 8, cls = (L == 16384) ? 0 : 1; typedef fftc::Fft<L, TPF> FT; };
template <int L> __device__ __forceinline__ void hyena_spectrum_unit(Frame& F, int o, int ch0) {
    using namespace fftc; typedef HyFft<L> H; typedef typename H::FT FT;
    int tid_ = F.tid; asm volatile("" : "+v"(tid_));
    const int sub = tid_ / H::TPF, tid = tid_ % H::TPF, ch = ch0 + sub;
    LAS cpx* A = (LAS cpx*)(F.lds + RING_OFF) + sub * FT::ELEMS;
    const bf16* TR = (const bf16*)(F.ws + WS_BIG + (H::cls ? B_TAP1 : B_TAP0)) + (size_t)(o * 1024 + ch) * (2 * L);
    cpx* KS = (cpx*)(F.ws + WS_BIG + (H::cls ? B_KS1 : B_KS0)) + (size_t)(o * 1024 + ch) * H::KS_STRIDE;
    {   v4u X[8]; unsigned short s0[8];
#pragma unroll
        for (int jj = 0; jj < 8; ++jj) { const int m0 = 4 * (tid + H::TPF * jj), idx0 = (L - 2 * m0) & (2 * L - 1); X[jj] = *(const v4u*)(TR + ((idx0 - 8) & (2 * L - 1))); s0[jj] = TR[idx0]; }
#pragma unroll
        for (int jj = 0; jj < 8; ++jj) { const int m0 = 4 * (tid + H::TPF * jj);
            const float e1 = bf2f((unsigned short)(X[jj].x >> 16)), e2 = bf2f((unsigned short)(X[jj].y & 0xffff)), e3 = bf2f((unsigned short)(X[jj].y >> 16)), e4 = bf2f((unsigned short)(X[jj].z & 0xffff)),
                        e5 = bf2f((unsigned short)(X[jj].z >> 16)), e6 = bf2f((unsigned short)(X[jj].w & 0xffff)), e7 = bf2f((unsigned short)(X[jj].w >> 16));
            A[fidx(m0)] = cpx{bf2f(s0[jj]), e7}; A[fidx(m0 + 1)] = cpx{e6, e5}; A[fidx(m0 + 2)] = cpx{e4, e3}; A[fidx(m0 + 3)] = cpx{e2, e1}; }
    }
    __syncthreads();
    FFT_FWD(FT, A, tid, __syncthreads());
    FT::spectrum_store(A, tid, [&](int p, cpx v) { KS[p] = v; });
    __syncthreads();
}
template <int L> __device__ __forceinline__ void hyena_unit_fft(Frame& F, int j, int s, int ch0) {
    using namespace fftc; typedef HyFft<L> H; typedef typename H::FT FT;
    constexpr int NTL = L / 64, TPF = H::TPF;
    const int sb = seq_base(s);
    LAS float* red = (LAS float*)(F.lds + LDSCTL_OFF + 64);
    const bf16* HYT = (const bf16*)(F.ws + WS_BIG + B_HYT) + sb; bf16* ZT = (bf16*)(F.ws + WS_BIG + B_ZT) + sb;
    const float* PS = (const float*)(F.ws + WS_BIG + B_PSUM) + (H::cls ? (size_t)256 * 4096 : 0);
    const float* cw = F.in[4] + (size_t)j * 3 * 3072; const float* cb = F.in[5] + (size_t)j * 3072; const float* hb = F.in[14] + (size_t)j * 2 * 1024;
    int tid_ = F.tid, lane = F.lane; asm volatile("" : "+v"(tid_), "+v"(lane));
    const int sub = tid_ / TPF, tid = tid_ % TPF, ch = ch0 + sub;
    LAS cpx* A = (LAS cpx*)(F.lds + RING_OFF) + sub * FT::ELEMS;
    if (F.wave < 2 * H::NCW) { const int cc = F.wave >> 1, o = F.wave & 1, chh = ch0 + cc; float a = 0.f;
        for (int t = lane; t < NTL; t += 64) a += PS[(size_t)t * 4096 + (0 * 2 + o) * 1024 + chh] + PS[(size_t)t * 4096 + (1 * 2 + o) * 1024 + chh];
        a = wave_sum(a); if (lane == 0) red[F.wave] = a; }
    float uk[4][8];
#define HY_SCONV(dst, chn) do { const bf16* hr_ = HYT + (size_t)(chn) * M; const float w0_ = cw[0 * 3072 + (chn)], w1_ = cw[1 * 3072 + (chn)], w2_ = cw[2 * 3072 + (chn)], b_ = cb[(chn)]; \
        v4u raw_[4]; unsigned short xm_[4], xp_[4]; \
        _Pragma("unroll") for (int jj = 0; jj < 4; ++jj) { const int p8 = 8 * (tid + TPF * jj); raw_[jj] = *(const v4u*)(hr_ + p8); xm_[jj] = p8 > 0 ? hr_[p8 - 1] : (unsigned short)0; xp_[jj] = p8 + 8 < L ? hr_[p8 + 8] : (unsigned short)0; } \
        _Pragma("unroll") for (int jj = 0; jj < 4; ++jj) { float x_[10]; x_[0] = bf2f(xm_[jj]); x_[9] = bf2f(xp_[jj]); \
            _Pragma("unroll") for (int q = 0; q < 4; ++q) { x_[1 + 2 * q] = bf2f((unsigned short)(raw_[jj][q] & 0xffff)); x_[2 + 2 * q] = bf2f((unsigned short)(raw_[jj][q] >> 16)); } \
            _Pragma("unroll") for (int q = 0; q < 8; ++q) dst[jj][q] = b_ + w0_ * x_[q] + w1_ * x_[q + 1] + w2_ * x_[q + 2]; } } while (0)
    HY_SCONV(uk, ch);
#pragma unroll
    for (int jj = 0; jj < 4; ++jj) { const int m0 = 4 * (tid + TPF * jj);
#pragma unroll
        for (int i = 0; i < 4; ++i) { A[fidx(m0 + i)] = cpx{uk[jj][2 * i], uk[jj][2 * i + 1]}; A[fidx(L / 2 + m0 + i)] = cpx{0.f, 0.f}; } }
    __syncthreads();
#pragma unroll 1
    for (int o = 0; o < 2; ++o) {
        const cpx* KS = (const cpx*)(F.ws + WS_BIG + (H::cls ? B_KS1 : B_KS0)) + (size_t)(o * 1024 + ch) * H::KS_STRIDE;
        int tf = tid; asm volatile("" : "+v"(tf));
        FFT_FWD(FT, A, tf, __syncthreads());
        FT::spectrum_mul(A, tf, [&](int p) { return KS[p]; });
        __syncthreads();
        asm volatile("" : "+v"(tf));
        FFT_INV(FT, A, tf, __syncthreads());
        const float sc = 1.f / ((float)L * red[2 * sub + o]); const float bias = hb[o * 1024 + ch];
        float gate[4][8];
        HY_SCONV(gate, (o == 0 ? 1024 : 2048) + ch);
#pragma unroll
        for (int jj = 0; jj < 4; ++jj) { const int m0 = 4 * (tid + TPF * jj);
#pragma unroll
            for (int i = 0; i < 4; ++i) { const cpx y = A[fidx(m0 + i)];
                uk[jj][2 * i] = gate[jj][2 * i] * (y.x * sc + bias * uk[jj][2 * i]); uk[jj][2 * i + 1] = gate[jj][2 * i + 1] * (y.y * sc + bias * uk[jj][2 * i + 1]); } }
        if (o == 0) {
#pragma unroll
            for (int jj = 0; jj < 4; ++jj) { const int m0 = 4 * (tid + TPF * jj);
#pragma unroll
                for (int i = 0; i < 4; ++i) { A[fidx(m0 + i)] = cpx{uk[jj][2 * i], uk[jj][2 * i + 1]}; A[fidx(L / 2 + m0 + i)] = cpx{0.f, 0.f}; } }
        } else {
#pragma unroll
            for (int jj = 0; jj < 4; ++jj) { const int p8 = 8 * (tid + TPF * jj); v4u ov;
#pragma unroll
                for (int q = 0; q < 4; ++q) ov[q] = pk2(uk[jj][2 * q], uk[jj][2 * q + 1]);
                *(v4u*)(ZT + (size_t)ch * M + p8) = ov; }
        }
        __syncthreads();
    }
#undef HY_SCONV
}

__device__ __forceinline__ void taps_unit_mfma(Frame& F, int j, int cls, int tile, int cq) {
    const int L = cls ? 4096 : 16384; const int i0 = tile * 64;
    const int dir = cq >> 1, shift = dir == 0 ? 1 : 0;
    LAS float* zf = (LAS float*)(F.lds + RING_OFF);
    LAS float* h1 = zf + 64 * 35;
    LAS unsigned char* h2b = (LAS unsigned char*)(h1 + 64 * 65);
    LAS float* w1s = (LAS float*)(h2b + 64 * 144);
    LAS float* w2s = w1s + 34 * 64 + 128;
    LAS unsigned char* timg = (LAS unsigned char*)(w2s + 64 * 64 + 128) + F.wave * 4608;
    static_assert(((64 * 35 + 64 * 65) * 4) % 16 == 0, "h2b alignment");
    const float* w1 = F.in[6] + (size_t)j * 33 * 64; const float* b1 = F.in[7] + j * 64; const float* f1 = F.in[8] + j * 64;
    const float* w2 = F.in[9] + (size_t)j * 64 * 64; const float* b2 = F.in[10] + j * 64; const float* f2 = F.in[11] + j * 64;
    const float* w3 = F.in[12] + (size_t)j * 64 * 4096; const float* b3 = F.in[13] + (size_t)j * 4096;
    for (int idx = F.tid; idx < 34 * 64; idx += 512) w1s[idx] = idx < 33 * 64 ? w1[idx] : 0.f;
    for (int idx = F.tid; idx < 64 * 64; idx += 512) w2s[idx] = w2[idx];
    if (F.tid < 64) { w1s[34 * 64 + F.tid] = b1[F.tid]; w1s[34 * 64 + 64 + F.tid] = f1[F.tid]; w2s[64 * 64 + F.tid] = b2[F.tid]; w2s[64 * 64 + 64 + F.tid] = f2[F.tid]; }
    for (int idx = F.tid; idx < 64 * 34; idx += 512) { const int p = idx / 34, f = idx % 34, i = i0 + shift + p; float val;
        if (f == 0) val = (float)i / (float)(L - 1);
        else if (f == 33) val = 0.f;
        else { const int mm = (f - 1) & 15; const float band = 1e-4f + (float)mm * ((15.0f - 1e-4f) / 15.0f); const float w = 6.283185307179586f * (float)i / (float)L;
            float sn, cs; sincos_f(band * w, sn, cs); val = f <= 16 ? cs : -sn; }
        zf[p * 35 + f] = val; }
    __syncthreads();
    {   int lane = F.lane; asm volatile("" : "+v"(lane)); const int li = lane & 31, lh = lane >> 5, pt = F.wave >> 1, ct = F.wave & 1;
        if (F.wave < 4) { f32x16 c;
#pragma unroll
            for (int r = 0; r < 16; ++r) c[r] = 0.f;
#pragma unroll
            for (int kk = 0; kk < 17; ++kk) c = __builtin_amdgcn_mfma_f32_32x32x2f32(zf[(32 * pt + li) * 35 + 2 * kk + lh], w1s[(2 * kk + lh) * 64 + 32 * ct + li], c, 0, 0, 0);
            const float bb1 = w1s[34 * 64 + 32 * ct + li], ff1 = w1s[34 * 64 + 64 + 32 * ct + li];
#pragma unroll
            for (int r = 0; r < 16; ++r) h1[(32 * pt + crow32(r, lh)) * 65 + 32 * ct + li] = sin_f(ff1 * (c[r] + bb1)); }
        __syncthreads();
        if (F.wave < 4) { f32x16 c;
#pragma unroll
            for (int r = 0; r < 16; ++r) c[r] = 0.f;
#pragma unroll
            for (int kk = 0; kk < 32; ++kk) c = __builtin_amdgcn_mfma_f32_32x32x2f32(h1[(32 * pt + li) * 65 + 2 * kk + lh], w2s[(2 * kk + lh) * 64 + 32 * ct + li], c, 0, 0, 0);
            const float bb2 = w2s[64 * 64 + 32 * ct + li], ff2 = w2s[64 * 64 + 64 + 32 * ct + li];
#pragma unroll
            for (int r = 0; r < 16; ++r) *(LAS bf16*)(h2b + (32 * pt + crow32(r, lh)) * 144 + (32 * ct + li) * 2) = (bf16)f2bf(sin_f(ff2 * (c[r] + bb2))); }
    }
    __syncthreads();
    int lane = F.lane; asm volatile("" : "+v"(lane));
    const int cl = lane & 31, h = lane >> 5;
    bf16* TAPS = (bf16*)(F.ws + WS_BIG + (cls ? B_TAP1 : B_TAP0));
    float* PS = (float*)(F.ws + WS_BIG + B_PSUM) + (cls ? (size_t)256 * 4096 : 0) + (size_t)tile * 4096;
    const float dmin = -3.0701134573253943f, dmax = -15.350567286626973f;
    const int colw = cq * 1024 + F.wave * 128;
    float wv[2][32];
    const float* w3p = w3 + (size_t)(8 * h) * 4096 + colw + cl;
#pragma unroll
    for (int ks = 0; ks < 4; ++ks)
#pragma unroll
        for (int q = 0; q < 8; ++q) wv[0][8 * ks + q] = w3p[(size_t)(16 * ks + q) * 4096];
#pragma unroll
    for (int cbi = 0; cbi < 4; ++cbi) { const int col0 = colw + cbi * 32, col = col0 + cl;
        if (cbi < 3) {
#pragma unroll
            for (int ks = 0; ks < 4; ++ks)
#pragma unroll
                for (int q = 0; q < 8; ++q) wv[(cbi + 1) & 1][8 * ks + q] = w3p[(size_t)(16 * ks + q) * 4096 + (cbi + 1) * 32]; }
        bf16x8 Wf[4];
#pragma unroll
        for (int ks = 0; ks < 4; ++ks) { const float* v = &wv[cbi & 1][8 * ks];
            u32x4_t pw; pw.x = cvtpk_rne(v[0], v[1]); pw.y = cvtpk_rne(v[2], v[3]); pw.z = cvtpk_rne(v[4], v[5]); pw.w = cvtpk_rne(v[6], v[7]); Wf[ks] = __builtin_bit_cast(bf16x8, pw); }
        const int o = (col >> 10) & 1, ch = col & 1023;
        const float dl2 = -1.4426950408889634f * fabsf(dmin + (dmax - dmin) * ((float)ch * (1.0f / 1023.0f))), bb = b3[col];
        float v0 = 0.f;
        if (dir == 1 && tile == 0) { float a = b3[col - 2048];
            for (int k = 0; k < 64; ++k) a += bf2f(*(const LAS bf16*)(h2b + k * 2)) * w3[(size_t)k * 4096 + col - 2048];
            v0 = a; }
        float asum = 0.f;
#pragma unroll
        for (int pt = 0; pt < 2; ++pt) { f32x16 acc;
#pragma unroll
            for (int r = 0; r < 16; ++r) acc[r] = 0.f;
#pragma unroll
            for (int ks = 0; ks < 4; ++ks) { const bf16x8 Hf = *(const LAS bf16x8*)(h2b + (pt * 32 + cl) * 144 + 32 * ks + 16 * h); acc = __builtin_amdgcn_mfma_f32_32x32x16_bf16(Hf, Wf[ks], acc, 0, 0, 0); }
#pragma unroll
            for (int rg = 0; rg < 4; ++rg) { const int pp = 32 * pt + 8 * rg + 4 * h; float val[4];
#pragma unroll
                for (int q = 0; q < 4; ++q) { const int i = i0 + shift + pp + q; const float ti = (float)i / (float)(L - 1);
                    float x = (acc[4 * rg + q] + bb) * __builtin_amdgcn_exp2f(ti * dl2);
                    if (i >= L) x = 0.f;
                    if (dir == 1 && i == 0) x = v0;
                    val[q] = x; asum += fabsf(x); }
                if (dir == 0) *(LAS unsigned long long*)(timg + cl * 144 + (60 - pp) * 2) = (unsigned long long)pk2(val[3], val[2]) | ((unsigned long long)pk2(val[1], val[0]) << 32);
                else *(LAS unsigned long long*)(timg + cl * 144 + pp * 2) = (unsigned long long)pk2(val[0], val[1]) | ((unsigned long long)pk2(val[2], val[3]) << 32); }
        }
        asum += __shfl_xor(asum, 32);
        if (h == 0) PS[col] = asum;
        const size_t ibase = dir == 0 ? (size_t)(L - i0 - 64) : (size_t)(L + i0);
#pragma unroll
        for (int ps = 0; ps < 4; ++ps) { const int cc = (lane >> 3) + 8 * ps, ck = lane & 7; const int colc = col0 + cc;
            const v4u vv = *(const LAS v4u*)(timg + cc * 144 + ck * 16);
            *(v4u*)(TAPS + ((size_t)(((colc >> 10) & 1) * 1024 + (colc & 1023))) * (2 * L) + ibase + 8 * ck) = vv; }
    }
    __syncthreads();
}

__device__ __forceinline__ void p_zt_transpose(Frame& F) {
    const bf16* ZT = (const bf16*)(F.ws + WS_BIG + B_ZT); bf16* AO = (bf16*)(F.ws + WS_XB);
#pragma unroll 4
    for (int it = F.bx * 512 + F.tid; it < M * 128; it += F.G * 512) {
        const int tok = it % M, cg = it / M;
        unsigned short v[8];
#pragma unroll
        for (int e = 0; e < 8; ++e) v[e] = ZT[(size_t)(cg * 8 + e) * M + tok];
        v4u o; o.x = v[0] | ((unsigned)v[1] << 16); o.y = v[2] | ((unsigned)v[3] << 16); o.z = v[4] | ((unsigned)v[5] << 16); o.w = v[6] | ((unsigned)v[7] << 16);
        *(v4u*)(AO + (size_t)tok * D + 1024 + cg * 8) = o;
    }
}

#ifndef MK_HYENA32
#define MK_HYENA32 0
#endif
#ifndef MK_TAPS_NAIVE
#define MK_TAPS_NAIVE 0
#endif
#ifndef MK_PROBE_REP
#define MK_PROBE_REP -1
#endif
#ifndef MK_ATTN_NAIVE
#define MK_ATTN_NAIVE 0
#endif
#ifndef MK_HYENA_NAIVE
#define MK_HYENA_NAIVE 0
#endif
#ifndef MK_MASK
#define MK_MASK 0xFFFFF
#endif
#define HAS(b) ((MK_MASK >> (b)) & 1)
struct Args { const float* in[25]; float* out; unsigned char* ws; int ph_lo, ph_hi; };
__global__ void __launch_bounds__(NWAVES * 64, 2) mk_fwd(Args args) {
    extern __shared__ __attribute__((aligned(16))) unsigned char lds[];
    Frame F;
    F.lds = (LAS unsigned char*)lds;
    F.MISC = (volatile LAS unsigned*)(F.lds + MISC_OFF);
    F.tid = threadIdx.x; F.lane = F.tid & 63; F.wave = __builtin_amdgcn_readfirstlane(F.tid >> 6);
    F.G = gridDim.x; F.bx = blockIdx.x;
    F.ws = args.ws; F.ctl = (gu32*)(args.ws + WS_CTL); F.X = args.out;
    for (int u = F.tid; u < (LDS_BYTES - LDSCTL_OFF) / 4; u += NWAVES * 64) ((LAS unsigned*)(F.lds + LDSCTL_OFF))[u] = 0u;
    __syncthreads();
    const int lo = args.ph_lo, hi = args.ph_hi;
    XcdBarrier bar; bar.bar = (unsigned*)(F.ctl + CW_BAR); bar.x = 0; bar.st = nullptr;
    if (hi - lo > 1) bar = xcd_barrier_post((unsigned*)(F.ctl + CW_BAR), F.MISC + 8);
#define IN(k) (lo <= (k) && (k) < hi)
#define SEAM(k) do { if ((k) + 1 < hi) { xcd_barrier(bar); if (MK_PROBE_REP == 50) xcd_barrier(bar); } } while (0)
#define XB ((bf16*)(F.ws + WS_XB))
#define Wb ((bf16*)(F.ws + WS_W))
#define BIG (F.ws + WS_BIG)

    if (HAS(0) && IN(0)) p_input(F);
    for (int layer = 0; layer < DEPTH; ++layer) {
        const int pb = layer * PH_PER_LAYER; const bool even = !(layer & 1); const int j = layer >> 1;
#define FRESH() do { int l_; asm volatile("v_mbcnt_lo_u32_b32 %0, -1, 0\n\tv_mbcnt_hi_u32_b32 %0, -1, %0" : "=v"(l_)); int bx_ = blockIdx.x; asm volatile("" : "+s"(bx_)); F.bx = bx_; F.lane = l_; F.tid = F.wave * 64 + l_; unsigned char* w_ = args.ws; float* x_ = args.out; asm volatile("" : "+s"(w_), "+s"(x_)); F.ws = w_; F.X = x_; } while (0)
#define BODY0 do { p_convert_weights(F, layer); __syncthreads(); if (MK_PROBE_REP == 30) { p_convert_weights(F, layer); __syncthreads(); } \
            if (even) { if (MK_TAPS_NAIVE) { for (int t = F.bx; t < 320; t += F.G) { if (t < 256) taps_tile(F, j, 0, t); else taps_tile(F, j, 1, t - 256); } } \
                        else { for (int rp = 0; rp < (MK_PROBE_REP == 31 ? 2 : 1); ++rp) for (int u = F.bx; u < 1280; u += F.G) { const int t = u >> 2; if (t < 256) taps_unit_mfma(F, j, 0, t, u & 3); else taps_unit_mfma(F, j, 1, t - 256, u & 3); } } } } while (0)
#define BODY1 do { if (even) { \
                if (MK_HYENA32 == 0) { for (int u = F.bx; u < 2560; u += F.G) { if (u < 2048) hyena_spectrum_unit<16384>(F, u >> 10, u & 1023); else hyena_spectrum_unit<4096>(F, (u - 2048) >> 8, 4 * ((u - 2048) & 255)); } } \
                { pg8::Gemm g{XB, (const bf16*)((unsigned char*)Wb + W_IN), M, 1280, D}; pg8::StaticOrder S; S.init(M, 1280, F.G, F.bx); \
                  pg8::EpiEvenQKV E{(bf16*)(BIG + B_Q), (bf16*)(BIG + B_K), (bf16*)(BIG + B_V), (const float*)(F.ws + WS_COSE), (const float*)(F.ws + WS_SINE)}; \
                  pg8::gemm_phase<pg8::EpiEvenQKV, pg8::StaticOrder, true, true>(F.lds + RING_OFF, g, S, E, F.wave); } \
                { pg8::Gemm g{(const bf16*)((unsigned char*)Wb + W_IN) + (size_t)1280 * D, XB, 3072, M, D}; pg8::StaticOrder S; S.init(3072, M, F.G, (int)(((unsigned)F.bx + 128u) % (unsigned)F.G)); \
                  pg8::EpiPlainBf16 E{(bf16*)(BIG + B_HYT), M}; \
                  pg8::gemm_phase<pg8::EpiPlainBf16, pg8::StaticOrder, true, true>(F.lds + RING_OFF, g, S, E, F.wave); } \
            } else { \
                pg8::Gemm g{XB, (const bf16*)((unsigned char*)Wb + W_IN), M, O_PROJ, D}; pg8::StaticOrder S; S.init(M, O_PROJ, F.G, F.bx); \
                pg8::EpiOddQKV E{(bf16*)BIG, (const float*)(F.ws + WS_COSO), (const float*)(F.ws + WS_SINO), M}; \
                pg8::gemm_phase<pg8::EpiOddQKV, pg8::StaticOrder, true, true>(F.lds + RING_OFF, g, S, E, F.wave); } } while (0)
#define BODY2 do { if (even) { \
                if (MK_HYENA_NAIVE) { for (int u = F.bx; u < 3072; u += F.G) { if (u < 1024) hyena_unit_naive<16384>(F, j, 0, u); else hyena_unit_naive<4096>(F, j, 1 + ((u - 1024) >> 10), (u - 1024) & 1023); } } \
                else { for (int u = F.bx; u < 2048; u += F.G) { if (u < 1024) { if (MK_HYENA32 == 1) hyena_unit_mfma<16384, 2>(F, j, 0, u); else if (MK_HYENA32 == 2) hyena_unit_mfma64<16384>(F, j, 0, u); else if (MK_HYENA32 == 3) hyena_unit_mfma128<16384>(F, j, 0, u); else hyena_unit_fft<16384>(F, j, 0, u); } else { if (MK_HYENA32 == 0) { if (u < 1536) hyena_unit_fft<4096>(F, j, 1 + ((u - 1024) >> 8), 4 * ((u - 1024) & 255)); } else hyena_unit_mfma<4096, 1>(F, j, 1 + ((u - 1024) >> 9), 2 * ((u - 1024) & 511)); } } } \
                if (MK_ATTN_NAIVE & 1) p_attn_even_naive(F, j); else p_attn_even_mfma(F, j); \
            } else { if (MK_ATTN_NAIVE & 2) p_attn_odd_naive(F); else { if (MK_PROBE_REP == 20) { p_attn_odd_mfma(F, true); __syncthreads(); } p_attn_odd_mfma(F, false); } } } while (0)
#define BODY3 do { if (even) p_zt_transpose(F); else p_combine_odd(F); } while (0)
#define BODY4 do { pg8::Gemm g{XB, (const bf16*)((unsigned char*)Wb + W_OUT), M, D, D}; pg8::StaticOrder S; S.init(M, D, F.G, F.bx); \
            pg8::EpiResid E{F.X, D, ALPHA, layer > 0 ? (const float*)(F.ws + WS_STAT) : nullptr, F.in[23] + (size_t)(layer > 0 ? layer - 1 : 0) * D, F.in[24] + (size_t)(layer > 0 ? layer - 1 : 0) * D, F.X}; \
            if (MK_PROBE_REP == 60) { pg8::EpiResid E2 = E; E2.Xout = (float*)(BIG + 300 * MiB); pg8::gemm_phase<pg8::EpiResid, pg8::StaticOrder, true, true>(F.lds + RING_OFF, g, S, E2, F.wave); __syncthreads(); } \
            pg8::gemm_phase<pg8::EpiResid, pg8::StaticOrder, true, true>(F.lds + RING_OFF, g, S, E, F.wave); } while (0)
#define BODY5 do { p_layernorm(F, F.in[21] + (size_t)layer * D, F.in[22] + (size_t)layer * D, false); } while (0)
#define BODY6 do { pg8::Gemm g{XB, (const bf16*)((unsigned char*)Wb + W_GU), M, 2 * DFF, D}; pg8::StaticOrder S; S.init(M, 2 * DFF, F.G, F.bx); \
            pg8::EpiSwiGLU E{(bf16*)BIG, DFF}; \
            pg8::gemm_phase<pg8::EpiSwiGLU, pg8::StaticOrder, true, true>(F.lds + RING_OFF, g, S, E, F.wave); } while (0)
#define BODY7 do { pg8::Gemm g{(const bf16*)BIG, (const bf16*)((unsigned char*)Wb + W_DN), M, D, DFF}; pg8::StaticOrder S; S.init(M, D, F.G, F.bx); \
            pg8::EpiResid E{F.X, D, ALPHA, (const float*)(F.ws + WS_STAT), F.in[21] + (size_t)layer * D, F.in[22] + (size_t)layer * D, F.X}; \
            if (MK_PROBE_REP == 61) { pg8::EpiResid E2 = E; E2.Xout = (float*)(BIG + 300 * MiB); pg8::gemm_phase<pg8::EpiResid, pg8::StaticOrder, true, true>(F.lds + RING_OFF, g, S, E2, F.wave); __syncthreads(); } \
            pg8::gemm_phase<pg8::EpiResid, pg8::StaticOrder, true, true>(F.lds + RING_OFF, g, S, E, F.wave); } while (0)
#define BODY8 do { p_layernorm(F, F.in[23] + (size_t)layer * D, F.in[24] + (size_t)layer * D, layer == DEPTH - 1); } while (0)
#define SITE(k, BODY) if (HAS(k) && IN(pb + (k))) { FRESH(); BODY; if (MK_PROBE_REP == (k) && ((k) != 2 || even)) { __syncthreads(); FRESH(); BODY; } SEAM(pb + (k)); }
        SITE(0, BODY0)
        SITE(1, BODY1)
        SITE(2, BODY2)
        SITE(3, BODY3)
        SITE(4, BODY4)
        SITE(5, BODY5)
        SITE(6, BODY6)
        SITE(7, BODY7)
        SITE(8, BODY8)
    }
#undef IN
#undef SEAM
#undef FRESH
#undef XB
#undef Wb
#undef BIG
}

#ifndef MK_ONE_LAUNCH
#define MK_ONE_LAUNCH 1
#endif
extern "C" void kernel_launch(void* const* d_in, const int* in_sizes, int n_in, void* d_out, int out_size, void* d_ws, size_t ws_size, hipStream_t stream) {
    static int grid = 0;
    if (grid == 0) {
        if (n_in != 25 || out_size != M * D || ws_size < WS_END) { fprintf(stderr, "kernel_launch: unexpected shapes (n_in %d, out %d, ws %zu < %zu)\n", n_in, out_size, ws_size, (size_t)WS_END); grid = -1; return; }
        int dev = 0, cus = 0, per_cu = 0;
        if (hipGetDevice(&dev) != hipSuccess || hipDeviceGetAttribute(&cus, hipDeviceAttributeMultiprocessorCount, dev) != hipSuccess) { grid = -1; return; }
        if (hipFuncSetAttribute((const void*)mk_fwd, hipFuncAttributeMaxDynamicSharedMemorySize, LDS_BYTES) != hipSuccess) { fprintf(stderr, "kernel_launch: hipFuncSetAttribute failed\n"); grid = -1; return; }
        if (hipOccupancyMaxActiveBlocksPerMultiprocessor(&per_cu, (const void*)mk_fwd, NWAVES * 64, LDS_BYTES) != hipSuccess || per_cu < 1) { fprintf(stderr, "kernel_launch: occupancy query says %d\n", per_cu); }
        (void)hipGetLastError();
        grid = cus;
    }
    if (grid < 0) return;
    (void)hipMemsetAsync((char*)d_ws + WS_CTL, 0, CTL_ZERO_BYTES, stream);
    Args a{};
    for (int i = 0; i < 25; ++i) a.in[i] = (const float*)d_in[i];
    a.out = (float*)d_out; a.ws = (unsigned char*)d_ws;
#if MK_ONE_LAUNCH
    a.ph_lo = 0; a.ph_hi = NPHASE;
    hipLaunchKernelGGL(mk_fwd, dim3(grid), dim3(NWAVES * 64), LDS_BYTES, stream, a);
#else
    for (int ph = 0; ph < NPHASE; ++ph) { a.ph_lo = ph; a.ph_hi = ph + 1; hipLaunchKernelGGL(mk_fwd, dim3(grid), dim3(NWAVES * 64), LDS_BYTES, stream, a); }
#endif
}
```
